# Optimizing an MI355X kernel written in HIP

```python
import jax, jax.numpy as jnp
from jax import lax
import numpy as np

D_MODEL = 1024
BATCH = 8
SEQ = 4096
DEPTH = 2

LRU_WIDTH = D_MODEL // 2
LRU_BLOCKS = 8
LRU_BLOCK = LRU_WIDTH // LRU_BLOCKS
CONV_WIDTH = 4
LRU_C = 8.0
RET_HEADS = 8
RET_DIM = 64
RET_WIDTH = RET_HEADS * RET_DIM
RET_CHUNK = 128
RET_THETA = 10000.0
AB_IN = 2 * LRU_WIDTH + 4 * RET_WIDTH
AB_OUT = LRU_WIDTH + RET_WIDTH

NSA_HEADS = 16
NSA_KV_GROUPS = 4
NSA_HEAD_DIM = 64
NSA_REP = NSA_HEADS // NSA_KV_GROUPS
KV_WIDTH = NSA_KV_GROUPS * NSA_HEAD_DIM
CMP_LEN = 32
CMP_STRIDE = 16
SLC_LEN = 64
SLC_TOPK = 16
WINDOW = 512
NSA_QBLOCK = 32
ROPE_THETA = 500000.0
ROT_DIM = NSA_HEAD_DIM // 4
NSA_IN = NSA_HEADS * NSA_HEAD_DIM + 6 * KV_WIDTH + 3 * NSA_HEADS

FFN_HIDDEN = ((8 * D_MODEL // 3 + 255) // 256) * 256

EPS = 1e-6
NEG = -1e30
BIG = 1e30
N_EVEN = (DEPTH + 1) // 2
N_ODD = DEPTH // 2

kernel_name = 'hybrid_rglru_retention_nsa'


def rmsnorm(x, g):
    xf = x.astype(jnp.float32)
    y = xf * lax.rsqrt(jnp.mean(xf * xf, axis=-1, keepdims=True) + EPS)
    return (y * g.astype(jnp.float32)).astype(x.dtype)


def rotary(x, pos, rot_dim, theta):
    half = rot_dim // 2
    inv = theta ** (-jnp.arange(0, rot_dim, 2, dtype=jnp.float32) / rot_dim)
    ang = jnp.asarray(pos).astype(jnp.float32)[:, None] * inv
    cos = jnp.cos(ang)[:, None, :]
    sin = jnp.sin(ang)[:, None, :]
    x1 = x[..., :half].astype(jnp.float32)
    x2 = x[..., half:rot_dim].astype(jnp.float32)
    rot = jnp.concatenate([x1 * cos - x2 * sin, x2 * cos + x1 * sin], axis=-1).astype(x.dtype)
    return jnp.concatenate([rot, x[..., rot_dim:]], axis=-1)


def swiglu(x, w1, w3, w2):
    return (jax.nn.silu(x @ w1) * (x @ w3)) @ w2


def causal_depthwise_conv(x, w, b):
    S = x.shape[1]
    xp = jnp.pad(x, ((0, 0), (CONV_WIDTH - 1, 0), (0, 0)))
    out = b
    for k in range(CONV_WIDTH):
        out = out + xp[:, k:k + S] * w[k]
    return out


def block_diag_linear(x, w, b):
    B, S, _ = x.shape
    xb = x.reshape(B, S, LRU_BLOCKS, LRU_BLOCK)
    return jnp.einsum('bsni,nij->bsnj', xb, w).reshape(B, S, LRU_WIDTH) + b


def rg_lru(x, ga_w, ga_b, gx_w, gx_b, lam):
    r = jax.nn.sigmoid(block_diag_linear(x, ga_w, ga_b)).astype(jnp.float32)
    i = jax.nn.sigmoid(block_diag_linear(x, gx_w, gx_b))
    log_a = -LRU_C * r * jax.nn.softplus(-lam.astype(jnp.float32))
    a = jnp.exp(log_a)
    mult = jnp.sqrt(-jnp.expm1(2.0 * log_a))
    u = mult * (i * x).astype(jnp.float32)

    def combine(left, right):
        a1, b1 = left
        a2, b2 = right
        return a1 * a2, a2 * b1 + b2

    _, h = lax.associative_scan(combine, (a, u), axis=1)
    return h.astype(x.dtype)


def retention(q, k, v):
    B, S, H, d = q.shape
    C = RET_CHUNK
    N = S // C
    pos = jnp.arange(S)
    q = rotary(q, pos, d, RET_THETA)
    k = rotary(k, pos, d, RET_THETA) * (d ** -0.5)
    log_g = jnp.log1p(-(2.0 ** (-5.0 - jnp.arange(H, dtype=jnp.float32))))
    ci = jnp.arange(C, dtype=jnp.float32)
    diff = ci[:, None] - ci[None, :]
    inner_decay = jnp.where(diff >= 0, jnp.exp(jnp.maximum(diff, 0.0) * log_g[:, None, None]), 0.0)
    q_decay = jnp.exp((ci + 1.0) * log_g[:, None])
    k_decay = jnp.exp((C - 1.0 - ci) * log_g[:, None])
    chunk_decay = jnp.exp(C * log_g)

    def to_chunks(t):
        return t.reshape(B, N, C, H, d).transpose(1, 0, 3, 2, 4)

    def step(state, inp):
        qi, ki, vi = inp
        qf, kf, vf = qi.astype(jnp.float32), ki.astype(jnp.float32), vi.astype(jnp.float32)
        s = jnp.einsum('bhid,bhjd->bhij', qf, kf) * inner_decay
        o = jnp.einsum('bhij,bhjd->bhid', s, vf) + jnp.einsum('bhid,bhde->bhie', qf * q_decay[..., None], state)
        state = state * chunk_decay[:, None, None] + jnp.einsum('bhjd,bhje->bhde', kf * k_decay[..., None], vf)
        return state, o

    state0 = jnp.zeros((B, H, d, d), jnp.float32)
    _, o = lax.scan(step, state0, (to_chunks(q), to_chunks(k), to_chunks(v)))
    o = o.transpose(1, 0, 3, 2, 4).reshape(B, S, H, d)
    mu = jnp.mean(o, axis=-1, keepdims=True)
    var = jnp.mean(jnp.square(o - mu), axis=-1, keepdims=True)
    return ((o - mu) * lax.rsqrt(var + EPS)).astype(v.dtype)


def hybrid_ab(h, w_in, conv_w, conv_b, ga_w, ga_b, gx_w, gx_b, lam, w_out):
    B, S, _ = h.shape
    proj = h @ w_in
    L, R = LRU_WIDTH, RET_WIDTH
    y, xr, q, k, v, g = jnp.split(proj, [L, 2 * L, 2 * L + R, 2 * L + 2 * R, 2 * L + 3 * R], axis=-1)
    xr = causal_depthwise_conv(xr, conv_w, conv_b)
    lru_out = rg_lru(xr, ga_w, ga_b, gx_w, gx_b, lam) * jax.nn.gelu(y)
    shp = (B, S, RET_HEADS, RET_DIM)
    ret = retention(q.reshape(shp), k.reshape(shp), v.reshape(shp)).reshape(B, S, R)
    ret_out = ret * jax.nn.silu(g)
    return jnp.concatenate([lru_out, ret_out], axis=-1) @ w_out


def nsa(h, w_in, pe_k, k_w1, k_w2, pe_v, v_w1, v_w2, w_out):
    B, S, _ = h.shape
    H, G, Rr, dh, QB = NSA_HEADS, NSA_KV_GROUPS, NSA_REP, NSA_HEAD_DIM, NSA_QBLOCK
    HD = H * dh
    proj = h @ w_in
    q = proj[..., :HD].reshape(B, S, H, dh)
    kv = proj[..., HD:HD + 6 * KV_WIDTH].reshape(B, S, 6, G, dh)
    k_cmp, v_cmp, k_slc, v_slc, k_win, v_win = [kv[:, :, j] for j in range(6)]
    gates = jax.nn.sigmoid(proj[..., HD + 6 * KV_WIDTH:].reshape(B, S, H, 3))
    pos = jnp.arange(S)
    q = rotary(q, pos, ROT_DIM, ROPE_THETA) * (dh ** -0.5)
    k_slc = rotary(k_slc, pos, ROT_DIM, ROPE_THETA)
    k_win = rotary(k_win, pos, ROT_DIM, ROPE_THETA)

    n_cmp = (S - CMP_LEN) // CMP_STRIDE + 1
    blk_idx = np.arange(n_cmp)[:, None] * CMP_STRIDE + np.arange(CMP_LEN)[None, :]
    cmp_end_np = blk_idx[:, -1]
    cmp_end = jnp.asarray(cmp_end_np)

    def compress(t, pe, w1, w2):
        blocks = t[:, blk_idx] + pe[:, None, :]
        blocks = blocks.transpose(0, 1, 3, 2, 4).reshape(B, n_cmp, G, CMP_LEN * dh)
        return jax.nn.gelu(blocks @ w1) @ w2

    kc = rotary(compress(k_cmp, pe_k, k_w1, k_w2), cmp_end_np, ROT_DIM, ROPE_THETA)
    vc = compress(v_cmp, pe_v, v_w1, v_w2)

    n_slc = S // SLC_LEN
    c_start = blk_idx[:, 0][:, None]
    s_start = np.arange(n_slc)[None, :] * SLC_LEN
    overlap = np.clip(np.minimum(c_start + CMP_LEN, s_start + SLC_LEN) - np.maximum(c_start, s_start), 0, None) / CMP_LEN
    cmp_to_slc = jnp.asarray(overlap, jnp.float32)
    top_k = min(SLC_TOPK, n_slc)
    ks_blocks = k_slc.reshape(B, n_slc, SLC_LEN, G, dh).transpose(0, 3, 1, 2, 4)
    vs_blocks = v_slc.reshape(B, n_slc, SLC_LEN, G, dh).transpose(0, 3, 1, 2, 4)
    gather = jax.vmap(jax.vmap(lambda blocks, idx: blocks[idx]))
    kw_pad = jnp.pad(k_win, ((0, 0), (WINDOW, 0), (0, 0), (0, 0)))
    vw_pad = jnp.pad(v_win, ((0, 0), (WINDOW, 0), (0, 0), (0, 0)))
    blk = jnp.arange(n_slc)

    def attend_block(qi):
        t0 = qi * QB
        qpos = t0 + jnp.arange(QB)
        qb = lax.dynamic_slice_in_dim(q, t0, QB, axis=1).reshape(B, QB, G, Rr, dh)
        s = jnp.einsum('bqgrd,bngd->bgrqn', qb, kc).astype(jnp.float32)
        vis = cmp_end[None, :] <= qpos[:, None]
        p_cmp = jnp.where(vis, jax.nn.softmax(jnp.where(vis, s, NEG), axis=-1), 0.0)
        o_cmp = jnp.einsum('bgrqn,bngd->bqgrd', p_cmp.astype(vc.dtype), vc)
        imp = jnp.einsum('bgrqn,nj->bgqj', p_cmp, cmp_to_slc)
        cur = qpos[:, None] // SLC_LEN
        forced = (blk[None, :] == 0) | (blk[None, :] == cur) | (blk[None, :] == cur - 1)
        causal_blk = blk[None, :] * SLC_LEN <= qpos[:, None]
        imp = jnp.where(forced, BIG, jnp.where(causal_blk, imp, NEG))
        _, sel = lax.top_k(imp, top_k)
        kg = gather(ks_blocks, sel)
        vg = gather(vs_blocks, sel)
        s = jnp.einsum('bqgrd,bgqkld->bgrqkl', qb, kg).astype(jnp.float32)
        tok = sel[..., None] * SLC_LEN + jnp.arange(SLC_LEN)
        ok = tok <= qpos[:, None, None]
        s = jnp.where(ok[:, :, None], s, NEG).reshape(B, G, Rr, QB, top_k * SLC_LEN)
        p_slc = jax.nn.softmax(s, axis=-1).reshape(B, G, Rr, QB, top_k, SLC_LEN)
        o_slc = jnp.einsum('bgrqkl,bgqkld->bqgrd', p_slc.astype(vg.dtype), vg)
        kw = lax.dynamic_slice_in_dim(kw_pad, t0, WINDOW + QB, axis=1)
        vw = lax.dynamic_slice_in_dim(vw_pad, t0, WINDOW + QB, axis=1)
        kpos = t0 - WINDOW + jnp.arange(WINDOW + QB)
        dist = qpos[:, None] - kpos[None, :]
        band = (dist >= 0) & (dist < WINDOW) & (kpos[None, :] >= 0)
        s = jnp.einsum('bqgrd,bkgd->bgrqk', qb, kw).astype(jnp.float32)
        p_win = jax.nn.softmax(jnp.where(band, s, NEG), axis=-1)
        o_win = jnp.einsum('bgrqk,bkgd->bqgrd', p_win.astype(vw.dtype), vw)
        gb = lax.dynamic_slice_in_dim(gates, t0, QB, axis=1).reshape(B, QB, G, Rr, 3)
        o = gb[..., 0:1] * o_cmp + gb[..., 1:2] * o_slc + gb[..., 2:3] * o_win
        return o.reshape(B, QB, HD)

    out = lax.map(attend_block, jnp.arange(S // QB))
    out = out.transpose(1, 0, 2, 3).reshape(B, S, HD)
    return out @ w_out


def setup_inputs(seed: int = 0) -> dict:
    key = jax.random.key(seed)
    ks = jax.random.split(key, 24)
    f32 = jnp.float32

    def w(k, shape, fan_in):
        return jax.random.normal(k, shape, f32) * (fan_in ** -0.5)

    def gain(k, shape):
        return 1.0 + 0.01 * jax.random.normal(k, shape, f32)

    a_pow_c = jax.random.uniform(ks[9], (N_EVEN, LRU_WIDTH), f32, 0.9, 0.999)
    root = a_pow_c ** (1.0 / LRU_C)
    lru_lambda = jnp.log(root) - jnp.log1p(-root)
    return {
        'x': jax.random.normal(ks[0], (BATCH, SEQ, D_MODEL), f32),
        'attn_norm': gain(ks[1], (DEPTH, D_MODEL)),
        'ab_w_in': w(ks[2], (N_EVEN, D_MODEL, AB_IN), D_MODEL),
        'conv_w': w(ks[3], (N_EVEN, CONV_WIDTH, LRU_WIDTH), CONV_WIDTH),
        'conv_b': 0.01 * jax.random.normal(ks[4], (N_EVEN, LRU_WIDTH), f32),
        'gate_a_w': w(ks[5], (N_EVEN, LRU_BLOCKS, LRU_BLOCK, LRU_BLOCK), LRU_BLOCK),
        'gate_a_b': 0.01 * jax.random.normal(ks[6], (N_EVEN, LRU_WIDTH), f32),
        'gate_x_w': w(ks[7], (N_EVEN, LRU_BLOCKS, LRU_BLOCK, LRU_BLOCK), LRU_BLOCK),
        'gate_x_b': 0.01 * jax.random.normal(ks[8], (N_EVEN, LRU_WIDTH), f32),
        'lru_lambda': lru_lambda,
        'ab_w_out': w(ks[10], (N_EVEN, AB_OUT, D_MODEL), AB_OUT),
        'nsa_w_in': w(ks[11], (N_ODD, D_MODEL, NSA_IN), D_MODEL),
        'cmp_pe_k': 0.02 * jax.random.normal(ks[12], (N_ODD, CMP_LEN, NSA_HEAD_DIM), f32),
        'cmp_k_w1': w(ks[13], (N_ODD, CMP_LEN * NSA_HEAD_DIM, NSA_HEAD_DIM), CMP_LEN * NSA_HEAD_DIM),
        'cmp_k_w2': w(ks[14], (N_ODD, NSA_HEAD_DIM, NSA_HEAD_DIM), NSA_HEAD_DIM),
        'cmp_pe_v': 0.02 * jax.random.normal(ks[15], (N_ODD, CMP_LEN, NSA_HEAD_DIM), f32),
        'cmp_v_w1': w(ks[16], (N_ODD, CMP_LEN * NSA_HEAD_DIM, NSA_HEAD_DIM), CMP_LEN * NSA_HEAD_DIM),
        'cmp_v_w2': w(ks[17], (N_ODD, NSA_HEAD_DIM, NSA_HEAD_DIM), NSA_HEAD_DIM),
        'nsa_w_out': w(ks[18], (N_ODD, NSA_HEADS * NSA_HEAD_DIM, D_MODEL), NSA_HEADS * NSA_HEAD_DIM),
        'ffn_norm': gain(ks[19], (DEPTH, D_MODEL)),
        'ffn_w1': w(ks[20], (DEPTH, D_MODEL, FFN_HIDDEN), D_MODEL),
        'ffn_w3': w(ks[21], (DEPTH, D_MODEL, FFN_HIDDEN), D_MODEL),
        'ffn_w2': w(ks[22], (DEPTH, FFN_HIDDEN, D_MODEL), FFN_HIDDEN),
        'final_norm': gain(ks[23], (D_MODEL,)),
    }


def reference(x, attn_norm, ab_w_in, conv_w, conv_b, gate_a_w, gate_a_b, gate_x_w, gate_x_b,
              lru_lambda, ab_w_out, nsa_w_in, cmp_pe_k, cmp_k_w1, cmp_k_w2, cmp_pe_v, cmp_v_w1,
              cmp_v_w2, nsa_w_out, ffn_norm, ffn_w1, ffn_w3, ffn_w2, final_norm):
    h = x
    for layer in range(DEPTH):
        hn = rmsnorm(h, attn_norm[layer])
        i = layer // 2
        if layer % 2 == 0:
            h = h + hybrid_ab(hn, ab_w_in[i], conv_w[i], conv_b[i], gate_a_w[i], gate_a_b[i],
                              gate_x_w[i], gate_x_b[i], lru_lambda[i], ab_w_out[i])
        else:
            h = h + nsa(hn, nsa_w_in[i], cmp_pe_k[i], cmp_k_w1[i], cmp_k_w2[i],
                        cmp_pe_v[i], cmp_v_w1[i], cmp_v_w2[i], nsa_w_out[i])
        h = h + swiglu(rmsnorm(h, ffn_norm[layer]), ffn_w1[layer], ffn_w3[layer], ffn_w2[layer])
    return rmsnorm(h, final_norm)
```

```cpp
#include <hip/hip_runtime.h>
#include <hip/hip_cooperative_groups.h>
#include <cstdio>
#include <cstdint>
namespace cg = cooperative_groups;
namespace pg8 {
#define PG8_LAS __attribute__((address_space(3)))
typedef unsigned short bf16_t;
typedef short bf16x8 __attribute__((ext_vector_type(8)));
typedef float f32x4 __attribute__((ext_vector_type(4)));
typedef unsigned u32x4 __attribute__((ext_vector_type(4)));
constexpr int BM = 256, BK = 64, HALF = 128, HTB = HALF * BK * 2  , STAGE_BYTES = 8 * HTB, NXCD = 8, WGM = 8;

__host__ __device__ __forceinline__ int lds_byte(int r, int c) { const int st = (r >> 4) * 2 + (c >> 5), rr = r & 15, cc = c & 31, ob = rr * 64 + cc * 2; return st * 1024 + (ob ^ (((ob >> 9) & 1) << 5)); }
__host__ __device__ __forceinline__ void stage_rc(int b, int& R, int& C) { const int st = b / 1024, sb = b % 1024, swz = sb ^ (((sb >> 9) & 1) << 5); R = (st >> 1) * 16 + swz / 64; C = (st & 1) * 32 + (swz % 64) / 2; }
__host__ __device__ __forceinline__ int perm32(int rho) { const int n = rho >> 4, i = rho & 15; return 8 * (i >> 2) + 4 * n + (i & 3); }

struct Unit { int pm, pn; };
struct Gemm { const bf16_t* A; const bf16_t* Bt; int M, N, K; };

struct StaticOrder {
    int nM, nN, nwg, G, c;
    __host__ __device__ void init(int M, int N, int G_, int c_) { nM = M / BM; nN = N / BM; nwg = nM * nN; G = G_; c = c_; }
    __host__ __device__ bool next(int i, Unit& u) const {
        const long L = (long)i * G + c; if (L >= nwg) return false;
        int wgid = (int)L; { const int q = nwg / NXCD, r = nwg % NXCD, xcd = wgid % NXCD, off = wgid / NXCD; wgid = (xcd < r ? xcd * (q + 1) : r * (q + 1) + (xcd - r) * q) + off; }
        const int nig = WGM * nN, gid = wgid / nig, fm = gid * WGM, gsz = (nM - fm) < WGM ? (nM - fm) : WGM;
        u.pm = fm + ((wgid % nig) % gsz); u.pn = (wgid % nig) / gsz; return true;
    }
    __device__ __forceinline__ void a_ready(const Unit&) const {}
    __device__ __forceinline__ void done(const Unit&) const {}
};

__device__ __forceinline__ unsigned cvt_pk_bf16(float lo, float hi) { unsigned r; asm volatile("v_cvt_pk_bf16_f32 %0, %1, %2" : "=v"(r) : "v"(lo), "v"(hi)); return r; }
typedef unsigned u32x2 __attribute__((ext_vector_type(2)));
__device__ __forceinline__ float sigmoid_f(float x) { return 1.f / (1.f + __expf(-x)); }
__device__ __forceinline__ float silu_f(float x) { return x / (1.f + __expf(-x)); }
__device__ __forceinline__ u32x4 pack8(const f32x4 a, const f32x4 b) { u32x4 w; w.x = cvt_pk_bf16(a[0], a[1]); w.y = cvt_pk_bf16(a[2], a[3]); w.z = cvt_pk_bf16(b[0], b[1]); w.w = cvt_pk_bf16(b[2], b[3]); return w; }
__device__ __forceinline__ u32x2 pack4(const f32x4 a) { u32x2 w; w.x = cvt_pk_bf16(a[0], a[1]); w.y = cvt_pk_bf16(a[2], a[3]); return w; }

struct EpiProj0 {
    static constexpr bool PERM = true, AFTER_DRAIN = false;
    bf16_t* P; const float* cosT; const float* sinT;
    __device__ __forceinline__ void operator()(const f32x4 (&acc)[2][2][4][2], const Unit& u, int wr, int wc, int fr, int fq) const {
        const int row0 = u.pm * BM + wr * 64 + fr, colt = u.pn * BM + wc * 32 + 8 * fq;
        const bool rot = (u.pn >= 4 && u.pn < 8); const float sc = (u.pn >= 6 && u.pn < 8) ? 0.125f : 1.f;
#pragma unroll
        for (int ai = 0; ai < 2; ++ai)
#pragma unroll
            for (int m = 0; m < 4; ++m) { const int row = row0 + ai * HALF + m * 16, pos = row & 4095; bf16_t* rowp = P + (size_t)row * 3072;
#pragma unroll
                for (int bj = 0; bj < 2; ++bj) { const int col = colt + bj * HALF; const f32x4 v0 = acc[ai][bj][m][0], v1 = acc[ai][bj][m][1];
                    if (rot) { const int hc = col & 63, gi = hc >> 3, hb = col - hc;
                        const f32x4 c = *(const f32x4*)(cosT + pos * 32 + 4 * gi), s = *(const f32x4*)(sinT + pos * 32 + 4 * gi);
                        const f32x4 o1 = (v0 * c - v1 * s) * sc, o2 = (v1 * c + v0 * s) * sc;
                        *(u32x2*)(rowp + hb + 4 * gi) = pack4(o1); *(u32x2*)(rowp + hb + 32 + 4 * gi) = pack4(o2);
                    } else { *(u32x4*)(rowp + col) = pack8(v0, v1); } } }
    }
};
struct EpiNsaIn {
    static constexpr bool PERM = true, AFTER_DRAIN = false;
    bf16_t* Q; bf16_t* KV; float* G; const float* cosT; const float* sinT;
    __device__ __forceinline__ void operator()(const f32x4 (&acc)[2][2][4][2], const Unit& u, int wr, int wc, int fr, int fq) const {
        const int row0 = u.pm * BM + wr * 64 + fr, pn = u.pn;
#pragma unroll
        for (int ai = 0; ai < 2; ++ai)
#pragma unroll
            for (int m = 0; m < 4; ++m) { const int row = row0 + ai * HALF + m * 16, pos = row & 4095;
#pragma unroll
                for (int bj = 0; bj < 2; ++bj) { const int lc = bj * HALF + wc * 32 + 8 * fq; const f32x4 v0 = acc[ai][bj][m][0], v1 = acc[ai][bj][m][1];
                    if (pn < 10) {
                        bf16_t* dst; bool rot; float sc;
                        if (pn < 4) { dst = Q + (size_t)row * 1024 + pn * 256 + lc; rot = true; sc = 0.125f; }
                        else { const int j = pn - 4; dst = KV + (size_t)row * 1536 + j * 256 + lc; rot = (j == 2 || j == 4); sc = 1.f; }
                        const int hc = lc & 63;
                        if (rot && hc < 16) { const int gi = hc >> 3;
                            const f32x4 c = *(const f32x4*)(cosT + pos * 8 + 4 * gi), s = *(const f32x4*)(sinT + pos * 8 + 4 * gi);
                            const f32x4 o1 = (v0 * c - v1 * s) * sc, o2 = (v1 * c + v0 * s) * sc;
                            bf16_t* hbp = dst - hc; *(u32x2*)(hbp + 4 * gi) = pack4(o1); *(u32x2*)(hbp + 8 + 4 * gi) = pack4(o2);
                        } else { *(u32x4*)dst = pack8(v0 * sc, v1 * sc); }
                    } else if (lc < 48) {
                        float* gp = G + (size_t)row * 48 + lc; f32x4 a, b;
#pragma unroll
                        for (int i = 0; i < 4; ++i) { a[i] = sigmoid_f(v0[i]); b[i] = sigmoid_f(v1[i]); }
                        *(f32x4*)gp = a; *(f32x4*)(gp + 4) = b; } } }
    }
};
struct EpiFfnUp {
    static constexpr bool PERM = true, AFTER_DRAIN = false;
    bf16_t* ACT; int ld;
    __device__ __forceinline__ void operator()(const f32x4 (&acc)[2][2][4][2], const Unit& u, int wr, int wc, int fr, int fq) const {
        const int row0 = u.pm * BM + wr * 64 + fr, col = u.pn * 128 + wc * 32 + 8 * fq;
#pragma unroll
        for (int ai = 0; ai < 2; ++ai)
#pragma unroll
            for (int m = 0; m < 4; ++m) { const int row = row0 + ai * HALF + m * 16; f32x4 h0, h1;
#pragma unroll
                for (int i = 0; i < 4; ++i) { h0[i] = silu_f(acc[ai][0][m][0][i]) * acc[ai][1][m][0][i]; h1[i] = silu_f(acc[ai][0][m][1][i]) * acc[ai][1][m][1][i]; }
                *(u32x4*)(ACT + (size_t)row * ld + col) = pack8(h0, h1); }
    }
};
struct EpiResid {
    static constexpr bool PERM = false, AFTER_DRAIN = false;
    const float* base; float* out;
    __device__ __forceinline__ void operator()(const f32x4 (&acc)[2][2][4][2], const Unit& u, int wr, int wc, int fr, int fq) const {
        const int row0 = u.pm * BM + wr * 64 + fr, col0 = u.pn * BM + wc * 32 + 4 * fq;
#pragma unroll
        for (int ai = 0; ai < 2; ++ai)
#pragma unroll
            for (int m = 0; m < 4; ++m) { const size_t off = (size_t)(row0 + ai * HALF + m * 16) * 1024 + col0;
#pragma unroll
                for (int bj = 0; bj < 2; ++bj)
#pragma unroll
                    for (int n = 0; n < 2; ++n) { const size_t o = off + bj * HALF + n * 16; *(f32x4*)(out + o) = *(const f32x4*)(base + o) + acc[ai][bj][m][n]; } }
    }
};
template <class Epi, class Sched, bool ALIGN_EPI = false, bool SP2 = false>
__device__ __forceinline__ void gemm_phase(PG8_LAS unsigned char* lds, const Gemm g, const Sched& S, const Epi& E) {
    const int tid = threadIdx.x, wid = __builtin_amdgcn_readfirstlane(tid >> 6), lane = tid & 63, wr = wid >> 2, wc = wid & 3, fr = lane & 15, fq = lane >> 4;
    const int K = g.K, nt = K / BK;
    unsigned voffA[2], voffB[2];
#pragma unroll
    for (int i = 0; i < 2; ++i) { int R, C; stage_rc(tid * 16 + i * 8192, R, C); const int Rb = Epi::PERM ? ((R & ~31) + perm32(R & 31)) : R;
        voffA[i] = (unsigned)(R * K + C) * 2u; voffB[i] = (unsigned)(Rb * K + C) * 2u; }
    const size_t kstep = (size_t)(BK * 2);
    const size_t hstep = (size_t)HALF * K * 2;
    const size_t tstep = 2 * hstep;
    const unsigned ldsw = (unsigned)wid * 1024u;
    const int aoff = lds_byte(wr * 64 + fr, fq * 8), boff = lds_byte(wc * 32 + fr, fq * 8);
#define PG8_SA(b, h) (((b) * 2 + (h)) * HTB)
#define PG8_SB(b, h) ((4 + (b) * 2 + (h)) * HTB)
#define PG8_STAGE(bufoff, gbase, voff) do { _Pragma("unroll") for (int _i = 0; _i < 2; ++_i) \
        __builtin_amdgcn_global_load_lds((const unsigned*)((const char*)(gbase) + (voff)[_i]), (PG8_LAS unsigned*)(lds + (bufoff) + ldsw + _i * 8192), 16, 0, 0); } while (0)
#define PG8_LDA(dst, b, h) do { _Pragma("unroll") for (int m = 0; m < 4; ++m) _Pragma("unroll") for (int k = 0; k < 2; ++k) dst[m][k] = *(const PG8_LAS bf16x8*)(lds + PG8_SA(b, h) + aoff + m * 2048 + k * 1024); } while (0)
#define PG8_LDB(dst, b, h) do { _Pragma("unroll") for (int n = 0; n < 2; ++n) _Pragma("unroll") for (int k = 0; k < 2; ++k) dst[n][k] = *(const PG8_LAS bf16x8*)(lds + PG8_SB(b, h) + boff + n * 2048 + k * 1024); } while (0)
#define PG8_MMA(ai, bj, At, Bt) do { __builtin_amdgcn_s_setprio(1); _Pragma("unroll") for (int m = 0; m < 4; ++m) _Pragma("unroll") for (int n = 0; n < 2; ++n) _Pragma("unroll") for (int k = 0; k < 2; ++k) \
        acc[ai][bj][m][n] = __builtin_amdgcn_mfma_f32_16x16x32_bf16(Bt[n][k], At[m][k], acc[ai][bj][m][n], 0, 0, 0); __builtin_amdgcn_s_setprio(0); } while (0)
#define PG8_WAIT_V(n) asm volatile("s_waitcnt vmcnt(" #n ")" ::: "memory")
#define PG8_WAIT_L(n) asm volatile("s_waitcnt lgkmcnt(" #n ")" ::: "memory")
#define PG8_BAR __builtin_amdgcn_s_barrier()
#define PG8_SCHED __builtin_amdgcn_sched_barrier(0)
    Unit cur, nxt; int ui = 0;
    if (!S.next(0, cur)) return;
    f32x4 acc[2][2][4][2];
#pragma unroll
    for (int a = 0; a < 2; ++a)
#pragma unroll
        for (int b = 0; b < 2; ++b)
#pragma unroll
            for (int m = 0; m < 4; ++m)
#pragma unroll
                for (int n = 0; n < 2; ++n) acc[a][b][m][n] = (f32x4){0.f, 0.f, 0.f, 0.f};
    bf16x8 At[4][2], B0[2][2], B1[2][2];
    const char* cA = (const char*)g.A + (size_t)cur.pm * tstep; const char* cB = (const char*)g.Bt + (size_t)cur.pn * tstep;
    S.a_ready(cur);
    if constexpr (SP2) {
        PG8_STAGE(PG8_SB(0, 0), cB, voffB); PG8_STAGE(PG8_SB(0, 1), cB + hstep, voffB); PG8_STAGE(PG8_SA(0, 0), cA, voffA); PG8_STAGE(PG8_SA(0, 1), cA + hstep, voffA);
        if (wr == 1) PG8_BAR;
        PG8_WAIT_V(2); PG8_BAR;
        PG8_STAGE(PG8_SB(1, 0), cB + kstep, voffB); PG8_STAGE(PG8_SA(1, 0), cA + kstep, voffA); PG8_STAGE(PG8_SB(1, 1), cB + hstep + kstep, voffB);
        PG8_WAIT_V(6); PG8_BAR;
    } else {
        PG8_STAGE(PG8_SB(0, 0), cB, voffB); PG8_STAGE(PG8_SA(0, 0), cA, voffA); PG8_STAGE(PG8_SB(0, 1), cB + hstep, voffB); PG8_STAGE(PG8_SA(0, 1), cA + hstep, voffA);
        if (wr == 1) PG8_BAR;
        PG8_WAIT_V(4); PG8_BAR;
        PG8_STAGE(PG8_SB(1, 0), cB + kstep, voffB); PG8_STAGE(PG8_SA(1, 0), cA + kstep, voffA); PG8_STAGE(PG8_SB(1, 1), cB + hstep + kstep, voffB);
        PG8_WAIT_V(6); PG8_BAR;
    }
    for (;;) {
        const bool has_next = S.next(ui + 1, nxt);
        const char* nA = has_next ? (const char*)g.A + (size_t)nxt.pm * tstep : cA; const char* nB = has_next ? (const char*)g.Bt + (size_t)nxt.pn * tstep : cB;
        for (int t = 0; t < nt; t += 2) {
            const bool last = (t == nt - 2);
            const char* a1 = cA + (size_t)(t + 1) * kstep;
            const char* a2 = last ? nA : cA + (size_t)(t + 2) * kstep; const char* b2 = last ? nB : cB + (size_t)(t + 2) * kstep;
            const char* a3 = a2 + kstep; const char* b3 = b2 + kstep;
            if (last && has_next) S.a_ready(nxt);
            if constexpr (SP2) {
            PG8_LDB(B0, 0, 0); PG8_LDB(B1, 0, 1); PG8_SCHED; PG8_LDA(At, 0, 0); PG8_STAGE(PG8_SA(1, 1), a1 + hstep, voffA);
            PG8_WAIT_V(8); PG8_WAIT_L(0); PG8_BAR; PG8_MMA(0, 0, At, B0); PG8_MMA(0, 1, At, B1); PG8_BAR; PG8_SCHED;
            PG8_LDA(At, 0, 1); PG8_STAGE(PG8_SB(0, 0), b2, voffB); PG8_STAGE(PG8_SB(0, 1), b2 + hstep, voffB); PG8_STAGE(PG8_SA(0, 0), a2, voffA);
            PG8_WAIT_V(8); PG8_WAIT_L(0); PG8_BAR; PG8_MMA(1, 0, At, B0); PG8_MMA(1, 1, At, B1); PG8_BAR; PG8_SCHED;
            PG8_LDB(B0, 1, 0); PG8_LDB(B1, 1, 1); PG8_SCHED; PG8_LDA(At, 1, 0); PG8_STAGE(PG8_SA(0, 1), a2 + hstep, voffA);
            PG8_WAIT_V(8); PG8_WAIT_L(0); PG8_BAR; PG8_MMA(0, 0, At, B0); PG8_MMA(0, 1, At, B1); PG8_BAR; PG8_SCHED;
            PG8_LDA(At, 1, 1); PG8_STAGE(PG8_SB(1, 0), b3, voffB); PG8_STAGE(PG8_SB(1, 1), b3 + hstep, voffB); PG8_STAGE(PG8_SA(1, 0), a3, voffA);
            PG8_WAIT_V(8); PG8_WAIT_L(0); PG8_BAR; PG8_MMA(1, 0, At, B0); PG8_MMA(1, 1, At, B1); PG8_BAR; PG8_SCHED;
            } else {
            PG8_LDB(B0, 0, 0); PG8_SCHED; PG8_LDA(At, 0, 0); PG8_STAGE(PG8_SA(1, 1), a1 + hstep, voffA);
            PG8_WAIT_L(8); PG8_BAR; PG8_WAIT_L(0); PG8_MMA(0, 0, At, B0); PG8_BAR; PG8_SCHED;
            PG8_LDB(B1, 0, 1); PG8_STAGE(PG8_SB(0, 0), b2, voffB);
            PG8_BAR; PG8_WAIT_L(0); PG8_MMA(0, 1, At, B1); PG8_BAR;
            PG8_LDA(At, 0, 1); PG8_STAGE(PG8_SA(0, 0), a2, voffA);
            PG8_BAR; PG8_WAIT_L(0); PG8_MMA(1, 0, At, B0); PG8_BAR; PG8_SCHED;
            PG8_STAGE(PG8_SB(0, 1), b2 + hstep, voffB);
            PG8_WAIT_V(6); PG8_BAR; PG8_MMA(1, 1, At, B1); PG8_BAR;
            PG8_LDB(B0, 1, 0); PG8_SCHED; PG8_LDA(At, 1, 0); PG8_STAGE(PG8_SA(0, 1), a2 + hstep, voffA);
            PG8_WAIT_L(8); PG8_BAR; PG8_WAIT_L(0); PG8_MMA(0, 0, At, B0); PG8_BAR; PG8_SCHED;
            PG8_LDB(B1, 1, 1); PG8_STAGE(PG8_SB(1, 0), b3, voffB);
            PG8_BAR; PG8_WAIT_L(0); PG8_MMA(0, 1, At, B1); PG8_BAR;
            PG8_LDA(At, 1, 1); PG8_STAGE(PG8_SA(1, 0), a3, voffA);
            PG8_BAR; PG8_WAIT_L(0); PG8_MMA(1, 0, At, B0); PG8_BAR; PG8_SCHED;
            PG8_STAGE(PG8_SB(1, 1), b3 + hstep, voffB);
            PG8_WAIT_V(6); PG8_BAR; PG8_MMA(1, 1, At, B1); PG8_BAR;
            }
        }
        if constexpr (ALIGN_EPI) { if (wr == 0) PG8_BAR; }
        if constexpr (!Epi::AFTER_DRAIN) { E(acc, cur, wr, wc, fr, fq); S.done(cur); }
        if (!has_next) break;
#pragma unroll
        for (int a = 0; a < 2; ++a)
#pragma unroll
            for (int b = 0; b < 2; ++b)
#pragma unroll
                for (int m = 0; m < 4; ++m)
#pragma unroll
                    for (int n = 0; n < 2; ++n) acc[a][b][m][n] = (f32x4){0.f, 0.f, 0.f, 0.f};
        cur = nxt; cA = nA; cB = nB; ++ui;
        if constexpr (ALIGN_EPI) { if (wr == 1) PG8_BAR; }
    }
    PG8_WAIT_V(0);
    if constexpr (!ALIGN_EPI) { if (wr == 0) PG8_BAR; }
    PG8_BAR;
    if constexpr (Epi::AFTER_DRAIN) { E.fused(acc, cur, wr, wc, fr, fq, lds, wid, lane); S.done(cur); }
#undef PG8_SA
#undef PG8_SB
#undef PG8_STAGE
#undef PG8_LDA
#undef PG8_LDB
#undef PG8_MMA
#undef PG8_WAIT_V
#undef PG8_WAIT_L
#undef PG8_BAR
#undef PG8_SCHED
}
}
#define LAS __attribute__((address_space(3)))
typedef unsigned short bf16;
typedef unsigned v4u __attribute__((ext_vector_type(4)));
typedef unsigned v2u __attribute__((ext_vector_type(2)));
typedef float f32x4 __attribute__((ext_vector_type(4)));
typedef short bf16x8 __attribute__((ext_vector_type(8)));

constexpr int NWAVES = 8, NTHREADS = 512;
constexpr int BATCH = 8, SEQ = 4096, DM = 1024, MROWS = BATCH * SEQ;
constexpr int AB_IN = 3072, FFH = 2816, NSA_IN = 2608, NSA_INP = 2816;
constexpr float EPSF = 1e-6f, NEGF = -1e30f, BIGF = 1e30f, LOG2E = 1.4426950408889634f;

constexpr size_t MiB = 1u << 20;
constexpr size_t WS_CTL = 0;
constexpr size_t WS_TAB = 1 * MiB;
constexpr size_t TAB_RCOS = WS_TAB, TAB_RSIN = TAB_RCOS + 4096 * 32 * 4, TAB_NCOS = TAB_RSIN + 4096 * 32 * 4, TAB_NSIN = TAB_NCOS + 4096 * 8 * 4, TAB_CB = TAB_NSIN + 4096 * 8 * 4;
constexpr size_t WS_W = 4 * MiB;
constexpr size_t W_ABIN = WS_W, W_ABOUT = W_ABIN + 6 * MiB, W_NSAIN = W_ABOUT + 2 * MiB, W_NSAOUT = W_NSAIN + 6 * MiB, W_F13 = W_NSAOUT + 2 * MiB  , W_F2 = W_F13 + 22 * MiB  ,
                 W_CK1 = W_F2 + 11 * MiB  , W_CV1 = W_CK1 + 256 * 1024, W_CK2 = W_CV1 + 256 * 1024  , W_CV2 = W_CK2 + 8192, W_END = W_CV2 + 8192;
static_assert(W_END <= 64 * MiB, "weights");
constexpr size_t WS_XN = 64 * MiB;
constexpr size_t WS_CAT = 128 * MiB;
constexpr size_t WS_BIG = 192 * MiB;
constexpr size_t WS_PROJ0 = WS_BIG, WS_ACT = WS_BIG;
constexpr size_t WS_Q = WS_BIG, WS_KV6 = WS_BIG + 64 * MiB, WS_GATES = WS_KV6 + 96 * MiB, WS_KC = WS_GATES + 6 * MiB, WS_VCT = WS_KC + 1 * MiB, WS_VTS = WS_VCT + 1 * MiB, WS_VTW = WS_VTS + 16 * MiB;
constexpr size_t WS_KVT = 384 * MiB;
constexpr size_t WS_LSUM = 416 * MiB;
constexpr size_t WS_END = 420 * MiB;
static_assert(WS_VTW + 16 * MiB <= WS_END && WS_PROJ0 + (size_t)MROWS * AB_IN * 2 <= WS_KVT, "ws map");

__device__ __forceinline__ float bf2f(bf16 v) { return __uint_as_float((unsigned)v << 16); }
__device__ __forceinline__ unsigned f2bf(float f) { unsigned u = __float_as_uint(f); return (u + 0x7fffu + ((u >> 16) & 1u)) >> 16; }
__device__ __forceinline__ unsigned pk2(float lo, float hi) { return f2bf(lo) | (f2bf(hi) << 16); }
__device__ __forceinline__ float wave_sum(float v) {
#pragma unroll
    for (int o = 1; o < 64; o <<= 1) v += __shfl_xor(v, o);
    return v;
}
__device__ __forceinline__ float gelu_tanh(float x) { const float u = 0.7978845608028654f * (x + 0.044715f * x * x * x); const float e = __expf(2.f * u); const float th = 1.f - 2.f / (e + 1.f); return 0.5f * x * (1.f + th); }
__device__ __forceinline__ float sigm(float x) { return 1.f / (1.f + __expf(-x)); }
__device__ __forceinline__ f32x4 mfma16(bf16x8 a, bf16x8 b, f32x4 c) { return __builtin_amdgcn_mfma_f32_16x16x32_bf16(a, b, c, 0, 0, 0); }
__device__ __forceinline__ float gmax16(float v) { v = fmaxf(v, __shfl_xor(v, 1)); v = fmaxf(v, __shfl_xor(v, 2)); v = fmaxf(v, __shfl_xor(v, 4)); v = fmaxf(v, __shfl_xor(v, 8)); return v; }
__device__ __forceinline__ float gsum16(float v) { v += __shfl_xor(v, 1); v += __shfl_xor(v, 2); v += __shfl_xor(v, 4); v += __shfl_xor(v, 8); return v; }

struct Args { const float* in[24]; float* out; unsigned char* ws; int ph_lo, ph_hi; };
enum { I_X = 0, I_ATTN_NORM, I_AB_W_IN, I_CONV_W, I_CONV_B, I_GA_W, I_GA_B, I_GX_W, I_GX_B, I_LAM, I_AB_W_OUT, I_NSA_W_IN, I_PE_K, I_K_W1, I_K_W2, I_PE_V, I_V_W1, I_V_W2, I_NSA_W_OUT,
       I_FFN_NORM, I_FFN_W1, I_FFN_W3, I_FFN_W2, I_FINAL_NORM };

struct ColSrc { const float* p; int ld; };
template <class Map> __device__ __forceinline__ void p0_transpose_item(const Map& mp, int K, int Ndst, bf16* WT, LAS float* scr, int item, int lane) {
    const int nblk = Ndst / 32, kb = item / nblk, nb = item % nblk, k0 = 64 * kb, n0 = 32 * nb, d0 = mp.drow(n0);
    const ColSrc cs = mp(n0 + (lane & 31));
#pragma unroll 8
    for (int i = 0; i < 32; ++i) { const int kk = 2 * i + (lane >> 5); scr[kk * 33 + (lane & 31)] = cs.p ? cs.p[(size_t)(k0 + kk) * cs.ld] : 0.f; }
    asm volatile("s_waitcnt lgkmcnt(0)" ::: "memory");
    const int c = lane & 7;
#pragma unroll
    for (int j = 0; j < 4; ++j) { const int n = (lane >> 3) + 8 * j; const LAS float* s = scr + (8 * c) * 33 + n;
        v4u o; o.x = pk2(s[0 * 33], s[1 * 33]); o.y = pk2(s[2 * 33], s[3 * 33]); o.z = pk2(s[4 * 33], s[5 * 33]); o.w = pk2(s[6 * 33], s[7 * 33]);
        *(v4u*)(WT + (size_t)(d0 + n) * K + k0 + 8 * c) = o; }
    asm volatile("s_waitcnt lgkmcnt(0)" ::: "memory");
}
struct MapId { const float* W; int N; __device__ ColSrc operator()(int n) const { return ColSrc{W + n, N}; } __device__ int drow(int n0) const { return n0; } };
struct MapAbIn { const float* W; __device__ ColSrc operator()(int c) const { int s = c;
    if (c >= 1024 && c < 2048) { const int hc = c & 63, gi = hc >> 3, e = hc & 7; s = (c - hc) + (e < 4 ? 4 * gi + e : 32 + 4 * gi + (e - 4)); }
    return ColSrc{W + s, AB_IN}; } __device__ int drow(int n0) const { return n0; } };
struct MapNsaIn { const float* W; __device__ ColSrc operator()(int c) const { if (c >= NSA_IN) return ColSrc{nullptr, 0}; int s = c;
    if (c < 1024 || (c >= 1536 && c < 1792) || (c >= 2048 && c < 2304)) { const int hc = c & 63; if (hc < 16) { const int gi = hc >> 3, e = hc & 7; s = (c - hc) + (e < 4 ? 4 * gi + e : 8 + 4 * gi + (e - 4)); } }
    return ColSrc{W + s, NSA_IN}; } __device__ int drow(int n0) const { return n0; } };
struct MapF13 { const float* W; int half; __device__ ColSrc operator()(int n) const { return ColSrc{W + n, FFH}; } __device__ int drow(int n0) const { return 256 * (n0 >> 7) + (n0 & 127) + 128 * half; } };

__device__ __forceinline__ void rms_row_to_bf16(const float* xrow, const float* gain, bf16* orow, int lane) {
    const f32x4* xr = (const f32x4*)xrow + lane; const f32x4* gr = (const f32x4*)gain + lane;
    f32x4 v[4]; float s = 0.f;
#pragma unroll
    for (int j = 0; j < 4; ++j) { v[j] = xr[64 * j]; s += (v[j].x * v[j].x + v[j].y * v[j].y) + (v[j].z * v[j].z + v[j].w * v[j].w); }
    const float rs = 1.f / sqrtf(wave_sum(s) * (1.f / DM) + EPSF);
    unsigned long long* o8 = (unsigned long long*)orow + lane;
#pragma unroll
    for (int j = 0; j < 4; ++j) { const f32x4 g = gr[64 * j]; o8[64 * j] = (unsigned long long)pk2(v[j].x * rs * g.x, v[j].y * rs * g.y) | ((unsigned long long)pk2(v[j].z * rs * g.z, v[j].w * rs * g.w) << 32); }
}
__device__ __forceinline__ void rms_row_to_f32(const float* xrow, const float* gain, float* orow, int lane) {
    const f32x4* xr = (const f32x4*)xrow + lane; const f32x4* gr = (const f32x4*)gain + lane;
    f32x4 v[4]; float s = 0.f;
#pragma unroll
    for (int j = 0; j < 4; ++j) { v[j] = xr[64 * j]; s += (v[j].x * v[j].x + v[j].y * v[j].y) + (v[j].z * v[j].z + v[j].w * v[j].w); }
    const float rs = 1.f / sqrtf(wave_sum(s) * (1.f / DM) + EPSF);
    f32x4* o = (f32x4*)orow + lane;
#pragma unroll
    for (int j = 0; j < 4; ++j) { const f32x4 g = gr[64 * j]; o[64 * j] = v[j] * rs * g; }
}
__device__ __forceinline__ void norm_phase(const float* src, const float* gain, bf16* dst, int gw, int NGW, int lane) {
    for (int m = gw; m < MROWS; m += NGW) rms_row_to_bf16(src + (size_t)m * DM, gain, dst + (size_t)m * DM, lane);
}

__device__ __forceinline__ void p0_prologue(const Args& A, LAS unsigned char* lds, int wave, int lane) {
    unsigned char* ws = A.ws;
    LAS float* scr = (LAS float*)(lds + wave * 16384);
    const int gw = blockIdx.x * NWAVES + wave, NGW = gridDim.x * NWAVES;
    constexpr int I_ABIN = 16 * (AB_IN / 32), I_SQ = 16 * 32, I_NSAIN = 16 * (NSA_INP / 32), I_F13 = 16 * (FFH / 32), I_F2 = (FFH / 64) * 32, I_C1 = 32 * 2, I_C2 = 2;
    constexpr int NITEMS = I_ABIN + I_SQ + I_NSAIN + I_SQ + 4 * I_F13 + 2 * I_F2 + 2 * I_C1 + 2 * I_C2;
    for (int it = gw; it < NITEMS; it += NGW) {
        int r = it;
        if (r < I_ABIN) { p0_transpose_item(MapAbIn{A.in[I_AB_W_IN]}, 1024, AB_IN, (bf16*)(ws + W_ABIN), scr, r, lane); continue; } r -= I_ABIN;
        if (r < I_SQ) { p0_transpose_item(MapId{A.in[I_AB_W_OUT], 1024}, 1024, 1024, (bf16*)(ws + W_ABOUT), scr, r, lane); continue; } r -= I_SQ;
        if (r < I_NSAIN) { p0_transpose_item(MapNsaIn{A.in[I_NSA_W_IN]}, 1024, NSA_INP, (bf16*)(ws + W_NSAIN), scr, r, lane); continue; } r -= I_NSAIN;
        if (r < I_SQ) { p0_transpose_item(MapId{A.in[I_NSA_W_OUT], 1024}, 1024, 1024, (bf16*)(ws + W_NSAOUT), scr, r, lane); continue; } r -= I_SQ;
        if (r < 2 * I_F13) { const int L = r / I_F13; r -= L * I_F13;
            p0_transpose_item(MapF13{A.in[I_FFN_W1] + (size_t)L * 1024 * FFH, 0}, 1024, FFH, (bf16*)(ws + W_F13) + (size_t)L * 2 * FFH * 1024, scr, r, lane); continue; } r -= 2 * I_F13;
        if (r < 2 * I_F13) { const int L = r / I_F13; r -= L * I_F13;
            p0_transpose_item(MapF13{A.in[I_FFN_W3] + (size_t)L * 1024 * FFH, 1}, 1024, FFH, (bf16*)(ws + W_F13) + (size_t)L * 2 * FFH * 1024, scr, r, lane); continue; } r -= 2 * I_F13;
        if (r < 2 * I_F2) { const int L = r / I_F2; r -= L * I_F2;
            p0_transpose_item(MapId{A.in[I_FFN_W2] + (size_t)L * FFH * 1024, 1024}, FFH, 1024, (bf16*)(ws + W_F2) + (size_t)L * 1024 * FFH, scr, r, lane); continue; } r -= 2 * I_F2;
        if (r < I_C1) { p0_transpose_item(MapId{A.in[I_K_W1], 64}, 2048, 64, (bf16*)(ws + W_CK1), scr, r, lane); continue; } r -= I_C1;
        if (r < I_C1) { p0_transpose_item(MapId{A.in[I_V_W1], 64}, 2048, 64, (bf16*)(ws + W_CV1), scr, r, lane); continue; } r -= I_C1;
        if (r < I_C2) { p0_transpose_item(MapId{A.in[I_K_W2], 64}, 64, 64, (bf16*)(ws + W_CK2), scr, r, lane); continue; } r -= I_C2;
        p0_transpose_item(MapId{A.in[I_V_W2], 64}, 64, 64, (bf16*)(ws + W_CV2), scr, r, lane);
    }
    {   const int gt = blockIdx.x * NTHREADS + threadIdx.x, NT = gridDim.x * NTHREADS;
        float* rc = (float*)(ws + TAB_RCOS); float* rsn = (float*)(ws + TAB_RSIN); float* nc = (float*)(ws + TAB_NCOS); float* ns = (float*)(ws + TAB_NSIN);
        for (int e = gt; e < 4096 * 40; e += NT) {
            const int pos = e / 40, i = e % 40; double inv;
            if (i < 32) inv = exp(-9.210340371976184 * ((double)i / 32.0));
            else inv = exp(-13.122363377404328 * ((double)(i - 32) / 8.0));
            double tr = (double)pos * inv * 0.15915494309189535; tr -= floor(tr);
            const float ft = (float)tr; const float sv = __builtin_amdgcn_sinf(ft), cv = __builtin_amdgcn_cosf(ft);
            if (i < 32) { rc[pos * 32 + i] = cv; rsn[pos * 32 + i] = sv; } else { nc[pos * 8 + (i - 32)] = cv; ns[pos * 8 + (i - 32)] = sv; }
        }
    }
    for (int it = gw; it < 128; it += NGW) { const int which = it >> 6, n = it & 63; const float* pe = A.in[which ? I_PE_V : I_PE_K]; const float* w1 = A.in[which ? I_V_W1 : I_K_W1];
        float s = 0.f; for (int k = lane; k < 2048; k += 64) s += pe[k] * w1[(size_t)k * 64 + n];
        s = wave_sum(s); if (lane == 0) ((float*)(ws + TAB_CB))[it] = s; }
    norm_phase(A.in[I_X], A.in[I_ATTN_NORM], (bf16*)(ws + WS_XN), gw, NGW, lane);
}

__device__ __forceinline__ void lru_item(const Args& A, LAS unsigned char* lds, int item, int mode) {
    LAS float* Wa = (LAS float*)lds; LAS float* Wx = Wa + 4096; LAS float* RAW = Wx + 4096; LAS float* X = RAW + 68 * 64; LAS float* PH = X + 4096; LAS float* CAR = PH + 1024;
    const int tid = threadIdx.x, j = tid & 63, tg = tid >> 6;
    const int b = item >> 7, n = (item >> 4) & 7, seg = item & 15, c = n * 64 + j;
    const bf16* P0 = (const bf16*)(A.ws + WS_PROJ0); bf16* CAT = (bf16*)(A.ws + WS_CAT); float* LS = (float*)(A.ws + WS_LSUM);
    __syncthreads();
    for (int e = tid; e < 4096; e += NTHREADS) { Wa[e] = A.in[I_GA_W][n * 4096 + e]; Wx[e] = A.in[I_GX_W][n * 4096 + e]; }
    const float gab = A.in[I_GA_B][c], gxb = A.in[I_GX_B][c], lam = A.in[I_LAM][c];
    const float sp = log1pf(expf(-lam));
    const float cw0 = A.in[I_CONV_W][c], cw1 = A.in[I_CONV_W][512 + c], cw2 = A.in[I_CONV_W][1024 + c], cw3 = A.in[I_CONV_W][1536 + c], cb = A.in[I_CONV_B][c];
    float carry = 0.f, ptot = 1.f;
    if (mode == 1) { for (int s2 = 0; s2 < seg; ++s2) { const float* q = LS + ((size_t)(b * 16 + s2) * 512 + c) * 2; carry = q[0] * carry + q[1]; } }
    if (tg == 0) CAR[j] = carry;
    const bf16* xrb = P0 + (size_t)(b * SEQ) * AB_IN + 512 + c;
    for (int sub = 0; sub < 4; ++sub) {
        const int t0 = seg * 256 + sub * 64;
        for (int r = tg; r < 67; r += 8) { const int t = t0 - 3 + r; RAW[r * 64 + j] = (t >= 0) ? bf2f(xrb[(size_t)t * AB_IN]) : 0.f; }
        __syncthreads();
        float xv[8];
#pragma unroll
        for (int q = 0; q < 8; ++q) { const int tt = tg * 8 + q; const float x = cb + cw0 * RAW[tt * 64 + j] + cw1 * RAW[(tt + 1) * 64 + j] + cw2 * RAW[(tt + 2) * 64 + j] + cw3 * RAW[(tt + 3) * 64 + j]; xv[q] = x; X[tt * 64 + j] = x; }
        __syncthreads();
        float ra[8], ri[8];
#pragma unroll
        for (int q = 0; q < 8; ++q) { ra[q] = gab; ri[q] = gxb; }
        for (int i = 0; i < 64; i += 4) {
            const float wa0 = Wa[i * 64 + j], wa1 = Wa[(i + 1) * 64 + j], wa2 = Wa[(i + 2) * 64 + j], wa3 = Wa[(i + 3) * 64 + j];
            const float wx0 = Wx[i * 64 + j], wx1 = Wx[(i + 1) * 64 + j], wx2 = Wx[(i + 2) * 64 + j], wx3 = Wx[(i + 3) * 64 + j];
#pragma unroll
            for (int q = 0; q < 8; ++q) { const f32x4 xq = *(const LAS f32x4*)(X + (tg * 8 + q) * 64 + i);
                ra[q] += xq.x * wa0 + xq.y * wa1 + xq.z * wa2 + xq.w * wa3; ri[q] += xq.x * wx0 + xq.y * wx1 + xq.z * wx2 + xq.w * wx3; }
        }
        float av[8], uv[8]; float Pl = 1.f, Hl = 0.f;
#pragma unroll
        for (int q = 0; q < 8; ++q) { const float r = sigm(ra[q]), ig = sigm(ri[q]); const float la = -8.f * r * sp; const float a = expf(la); const float mult = sqrtf(-expm1f(2.f * la));
            av[q] = a; uv[q] = mult * (ig * xv[q]); Hl = a * Hl + uv[q]; Pl *= a; }
        PH[(tg * 64 + j) * 2] = Pl; PH[(tg * 64 + j) * 2 + 1] = Hl;
        __syncthreads();
        float cin = CAR[j];
        for (int g2 = 0; g2 < tg; ++g2) cin = PH[(g2 * 64 + j) * 2] * cin + PH[(g2 * 64 + j) * 2 + 1];
#pragma unroll
        for (int q = 0; q < 8; ++q) { cin = av[q] * cin + uv[q];
            if (mode == 1) { const size_t row = (size_t)b * SEQ + t0 + tg * 8 + q; const float y = bf2f(P0[row * AB_IN + c]); CAT[row * DM + c] = (bf16)f2bf(cin * gelu_tanh(y)); } }
        __syncthreads();
        if (tg == 7) { CAR[j] = cin; if (mode == 0) { float pt = 1.f;
#pragma unroll
                for (int g2 = 0; g2 < 8; ++g2) pt *= PH[(g2 * 64 + j) * 2]; ptot *= pt; } }
    }
    if (mode == 0 && tg == 7) { float* q = LS + ((size_t)(b * 16 + seg) * 512 + c) * 2; q[0] = ptot; q[1] = CAR[j]; }
}

__device__ __forceinline__ float ret_log_g(int h) { return log1pf(-exp2f(-5.f - (float)h)); }
__device__ __forceinline__ void ret_kv_item(const Args& A, LAS unsigned char* lds, int item) {
    LAS float* Kd = (LAS float*)lds; LAS float* V = Kd + 8192;
    const int tid = threadIdx.x, b = item >> 8, h = (item >> 5) & 7, m = item & 31;
    const bf16* P0 = (const bf16*)(A.ws + WS_PROJ0); float* KVT = (float*)(A.ws + WS_KVT);
    const float lg = ret_log_g(h);
    __syncthreads();
    for (int e = tid; e < 8192; e += NTHREADS) { const int jj = e >> 6, d = e & 63; const size_t row = (size_t)b * SEQ + m * 128 + jj;
        Kd[e] = bf2f(P0[row * AB_IN + 1536 + h * 64 + d]) * expf((float)(127 - jj) * lg); V[e] = bf2f(P0[row * AB_IN + 2048 + h * 64 + d]); }
    __syncthreads();
    const int d = tid & 63, eg = tid >> 6; float acc[8];
#pragma unroll
    for (int q = 0; q < 8; ++q) acc[q] = 0.f;
    for (int jj = 0; jj < 128; ++jj) { const float kv = Kd[jj * 64 + d]; const f32x4 va = *(const LAS f32x4*)(V + jj * 64 + eg * 8), vb = *(const LAS f32x4*)(V + jj * 64 + eg * 8 + 4);
        acc[0] += kv * va.x; acc[1] += kv * va.y; acc[2] += kv * va.z; acc[3] += kv * va.w; acc[4] += kv * vb.x; acc[5] += kv * vb.y; acc[6] += kv * vb.z; acc[7] += kv * vb.w; }
    float* o = KVT + ((size_t)((b * 8 + h) * 32 + m)) * 4096;
#pragma unroll
    for (int q = 0; q < 8; ++q) o[(eg * 8 + q) * 64 + d] = acc[q];
}
constexpr int VT_LD = 136, ST_LD = 72, PW_LD = 72;
__device__ __forceinline__ void ret_out_item(const Args& A, LAS unsigned char* lds, int item) {
    LAS bf16* VT = (LAS bf16*)lds;
    LAS bf16* STT = VT + 64 * VT_LD;
    LAS bf16* PWall = STT + 64 * ST_LD;
    const int tid = threadIdx.x, lane = tid & 63, w = tid >> 6, b = item >> 8, h = (item >> 5) & 7, n = item & 31;
    const bf16* P0 = (const bf16*)(A.ws + WS_PROJ0); const float* KVT = (const float*)(A.ws + WS_KVT); bf16* CAT = (bf16*)(A.ws + WS_CAT);
    const float lg = ret_log_g(h), l2g = lg * LOG2E;
    const size_t row0 = (size_t)b * SEQ + n * 128;
    __syncthreads();
#pragma unroll
    for (int rep = 0; rep < 2; ++rep) { const int jj = (tid >> 3) + 64 * rep, e8 = tid & 7; const v4u raw = *(const v4u*)(P0 + (row0 + jj) * AB_IN + 2048 + h * 64 + 8 * e8);
        const unsigned wv[4] = {raw.x, raw.y, raw.z, raw.w};
#pragma unroll
        for (int i = 0; i < 4; ++i) { VT[(8 * e8 + 2 * i) * VT_LD + jj] = (bf16)(wv[i] & 0xffffu); VT[(8 * e8 + 2 * i + 1) * VT_LD + jj] = (bf16)(wv[i] >> 16); } }
    {   float st[8];
#pragma unroll
        for (int i = 0; i < 8; ++i) st[i] = 0.f;
        const float cd = expf(128.f * lg); const float* kp = KVT + ((size_t)((b * 8 + h) * 32)) * 4096 + tid * 8;
        for (int m = 0; m < n; ++m) { const f32x4 a = *(const f32x4*)(kp + (size_t)m * 4096), c = *(const f32x4*)(kp + (size_t)m * 4096 + 4);
            st[0] = st[0] * cd + a.x; st[1] = st[1] * cd + a.y; st[2] = st[2] * cd + a.z; st[3] = st[3] * cd + a.w; st[4] = st[4] * cd + c.x; st[5] = st[5] * cd + c.y; st[6] = st[6] * cd + c.z; st[7] = st[7] * cd + c.w; }
        const int e = tid >> 3, d0 = (tid & 7) * 8; v4u o; o.x = pk2(st[0], st[1]); o.y = pk2(st[2], st[3]); o.z = pk2(st[4], st[5]); o.w = pk2(st[6], st[7]);
        *(LAS v4u*)(STT + e * ST_LD + d0) = o; }
    __syncthreads();
    LAS bf16* PW = PWall + w * 16 * PW_LD;
    const int lr = lane & 15, lq = lane >> 4;
    bf16x8 qa[2];
#pragma unroll
    for (int ks = 0; ks < 2; ++ks) qa[ks] = *(const bf16x8*)(P0 + (row0 + 16 * w + lr) * AB_IN + 1024 + h * 64 + 32 * ks + 8 * lq);
    f32x4 O1[4], O2[4];
#pragma unroll
    for (int ct = 0; ct < 4; ++ct) { O1[ct] = (f32x4){0.f, 0.f, 0.f, 0.f}; O2[ct] = (f32x4){0.f, 0.f, 0.f, 0.f}; }
    const int ntile = (w >= 4) ? 2 : 1;
    for (int jt = 0; jt < ntile; ++jt) {
        f32x4 s[4];
#pragma unroll
        for (int nt = 0; nt < 4; ++nt) { const bf16* kp = P0 + (row0 + 64 * jt + 16 * nt + lr) * AB_IN + 1536 + h * 64 + 8 * lq;
            const bf16x8 k0 = *(const bf16x8*)kp, k1 = *(const bf16x8*)(kp + 32);
            s[nt] = mfma16(qa[0], k0, (f32x4){0.f, 0.f, 0.f, 0.f}); s[nt] = mfma16(qa[1], k1, s[nt]); }
#pragma unroll
        for (int nt = 0; nt < 4; ++nt)
#pragma unroll
            for (int r = 0; r < 4; ++r) { const int i = 16 * w + lq * 4 + r, jj = 64 * jt + 16 * nt + lr, dd = i - jj;
                const float p = (dd >= 0) ? s[nt][r] * exp2f((float)dd * l2g) : 0.f; PW[(lq * 4 + r) * PW_LD + 16 * nt + lr] = (bf16)f2bf(p); }
        bf16x8 pa[2];
#pragma unroll
        for (int ks = 0; ks < 2; ++ks) pa[ks] = *(const LAS bf16x8*)(PW + lr * PW_LD + 32 * ks + 8 * lq);
#pragma unroll
        for (int ct = 0; ct < 4; ++ct)
#pragma unroll
            for (int ks = 0; ks < 2; ++ks) { const bf16x8 vb = *(const LAS bf16x8*)(VT + (16 * ct + lr) * VT_LD + 64 * jt + 32 * ks + 8 * lq); O1[ct] = mfma16(pa[ks], vb, O1[ct]); }
    }
#pragma unroll
    for (int ct = 0; ct < 4; ++ct)
#pragma unroll
        for (int ks = 0; ks < 2; ++ks) { const bf16x8 sb = *(const LAS bf16x8*)(STT + (16 * ct + lr) * ST_LD + 32 * ks + 8 * lq); O2[ct] = mfma16(qa[ks], sb, O2[ct]); }
#pragma unroll
    for (int r = 0; r < 4; ++r) { const int i = 16 * w + lq * 4 + r; const float qd = exp2f((float)(i + 1) * l2g);
        float o[4]; float sm = 0.f;
#pragma unroll
        for (int ct = 0; ct < 4; ++ct) { o[ct] = O1[ct][r] + qd * O2[ct][r]; sm += o[ct]; }
        const float mean = gsum16(sm) * (1.f / 64.f); float vs = 0.f;
#pragma unroll
        for (int ct = 0; ct < 4; ++ct) { o[ct] -= mean; vs += o[ct] * o[ct]; }
        const float rstd = 1.f / sqrtf(gsum16(vs) * (1.f / 64.f) + EPSF);
        const size_t row = row0 + i;
#pragma unroll
        for (int ct = 0; ct < 4; ++ct) { const int e = 16 * ct + lr; const float g = bf2f(P0[row * AB_IN + 2560 + h * 64 + e]); CAT[row * DM + 512 + h * 64 + e] = (bf16)f2bf(o[ct] * rstd * (g * sigm(g))); } }
}
__device__ __forceinline__ void cmp_item(const Args& A, LAS unsigned char* lds, int item) {
    LAS float* RED = (LAS float*)lds; LAS bf16* HID = (LAS bf16*)(lds + 32768);
    const int tid = threadIdx.x, lane = tid & 63, w = tid >> 6, lr = lane & 15, lq = lane >> 4;
    const int ctile = item & 15, kv = (item >> 4) & 1, g = (item >> 5) & 3, b = item >> 7;
    const bf16* W1T = (const bf16*)(A.ws + (kv ? W_CV1 : W_CK1)); const bf16* W2T = (const bf16*)(A.ws + (kv ? W_CV2 : W_CK2)); const bf16* KV6 = (const bf16*)(A.ws + WS_KV6);
    const float* CB = (const float*)(A.ws + TAB_CB);
    f32x4 acc[4];
#pragma unroll
    for (int nt = 0; nt < 4; ++nt) acc[nt] = (f32x4){0.f, 0.f, 0.f, 0.f};
    const int c = 16 * ctile + lr;
    __syncthreads();
#pragma unroll
    for (int lt = 0; lt < 4; ++lt) { int tok = 16 * c + 4 * w + lt; tok = tok > SEQ - 1 ? SEQ - 1 : tok;
        const bf16* arow = KV6 + ((size_t)b * SEQ + tok) * 1536 + kv * 256 + g * 64;
#pragma unroll
        for (int ks = 0; ks < 2; ++ks) { const bf16x8 a = *(const bf16x8*)(arow + 32 * ks + 8 * lq);
#pragma unroll
            for (int nt = 0; nt < 4; ++nt) { const bf16x8 bw = *(const bf16x8*)(W1T + (size_t)(16 * nt + lr) * 2048 + (4 * w + lt) * 64 + 32 * ks + 8 * lq); acc[nt] = mfma16(a, bw, acc[nt]); } } }
#pragma unroll
    for (int nt = 0; nt < 4; ++nt)
#pragma unroll
        for (int r = 0; r < 4; ++r) RED[(w * 16 + lq * 4 + r) * 64 + 16 * nt + lr] = acc[nt][r];
    __syncthreads();
#pragma unroll
    for (int rep = 0; rep < 2; ++rep) { const int e = tid + rep * NTHREADS, row = e >> 6, col = e & 63; float s = CB[kv * 64 + col];
#pragma unroll
        for (int w2 = 0; w2 < 8; ++w2) s += RED[(w2 * 16 + row) * 64 + col];
        HID[row * 72 + col] = (bf16)f2bf(gelu_tanh(s)); }
    __syncthreads();
    if (w < 4) {
        f32x4 o = (f32x4){0.f, 0.f, 0.f, 0.f};
#pragma unroll
        for (int ks = 0; ks < 2; ++ks) { const bf16x8 a = *(const LAS bf16x8*)(HID + lr * 72 + 32 * ks + 8 * lq); const bf16x8 bw = *(const bf16x8*)(W2T + (16 * w + lr) * 64 + 32 * ks + 8 * lq); o = mfma16(a, bw, o); }
        bf16* KC = (bf16*)(A.ws + WS_KC); bf16* VCT = (bf16*)(A.ws + WS_VCT); const float* NC = (const float*)(A.ws + TAB_NCOS); const float* NS = (const float*)(A.ws + TAB_NSIN);
#pragma unroll
        for (int r = 0; r < 4; ++r) { const int cc = 16 * ctile + lq * 4 + r, dim = 16 * w + lr; float val = o[r];
            if (kv == 0) {
                if (w == 0) { const float partner = __shfl_xor(val, 8); int pos = 16 * cc + 31; pos = pos > SEQ - 1 ? SEQ - 1 : pos; const int f = lr & 7; const float cs = NC[pos * 8 + f], sn = NS[pos * 8 + f];
                    val = (lr < 8) ? (val * cs - partner * sn) : (val * cs + partner * sn); }
                KC[((size_t)(b * 256 + cc) * 4 + g) * 64 + dim] = (bf16)f2bf(val);
            } else VCT[((size_t)(b * 4 + g) * 64 + dim) * 256 + cc] = (bf16)f2bf(val); }
    }
}
__device__ __forceinline__ void vtr_item(const Args& A, LAS unsigned char* lds, int item) {
    LAS bf16* T = (LAS bf16*)lds;
    const int tid = threadIdx.x, which = item >> 11, b = (item >> 8) & 7, g = (item >> 6) & 3, tt = item & 63;
    const bf16* KV6 = (const bf16*)(A.ws + WS_KV6); bf16* dst = (bf16*)(A.ws + (which ? WS_VTW : WS_VTS)) + (size_t)((b * 4 + g) * 64) * SEQ + 64 * tt;
    const int col = (which ? 5 : 3) * 256 + g * 64;
    __syncthreads();
    {   const int jj = tid >> 3, e8 = tid & 7; const v4u raw = *(const v4u*)(KV6 + ((size_t)b * SEQ + 64 * tt + jj) * 1536 + col + 8 * e8); const unsigned wv[4] = {raw.x, raw.y, raw.z, raw.w};
#pragma unroll
        for (int i = 0; i < 4; ++i) { T[(8 * e8 + 2 * i) * 72 + jj] = (bf16)(wv[i] & 0xffffu); T[(8 * e8 + 2 * i + 1) * 72 + jj] = (bf16)(wv[i] >> 16); } }
    __syncthreads();
    {   const int dim = tid >> 3, c8 = tid & 7; *(v4u*)(dst + (size_t)dim * SEQ + 8 * c8) = *(const LAS v4u*)(T + dim * 72 + 8 * c8); }
}

struct OnlineSm { float m[4], l[4]; f32x4 O[4]; };
template <class MaskF>
__device__ __forceinline__ void attn_tile(const bf16x8 (&qa)[2], const bf16* Kt, int kld, const bf16* VTt, int vld, const MaskF& mask, OnlineSm& st, LAS bf16* PW, int lr, int lq) {
    f32x4 s[4];
#pragma unroll
    for (int nt = 0; nt < 4; ++nt) { const bf16* kp = Kt + (size_t)(16 * nt + lr) * kld + 8 * lq; const bf16x8 k0 = *(const bf16x8*)kp, k1 = *(const bf16x8*)(kp + 32);
        s[nt] = mfma16(qa[0], k0, (f32x4){0.f, 0.f, 0.f, 0.f}); s[nt] = mfma16(qa[1], k1, s[nt]); }
    bool ok[4];
#pragma unroll
    for (int nt = 0; nt < 4; ++nt) ok[nt] = mask(nt);
    float alpha[4];
#pragma unroll
    for (int r = 0; r < 4; ++r) { float mx = NEGF;
#pragma unroll
        for (int nt = 0; nt < 4; ++nt) mx = fmaxf(mx, ok[nt] ? s[nt][r] : NEGF);
        mx = gmax16(mx); const float mn = fmaxf(st.m[r], mx); alpha[r] = exp2f((st.m[r] - mn) * LOG2E); st.m[r] = mn; float ls = 0.f;
#pragma unroll
        for (int nt = 0; nt < 4; ++nt) { const float p = ok[nt] ? exp2f((s[nt][r] - mn) * LOG2E) : 0.f; ls += p; PW[(lq * 4 + r) * PW_LD + 16 * nt + lr] = (bf16)f2bf(p); }
        st.l[r] = st.l[r] * alpha[r] + ls; }
#pragma unroll
    for (int ct = 0; ct < 4; ++ct)
#pragma unroll
        for (int r = 0; r < 4; ++r) st.O[ct][r] *= alpha[r];
    bf16x8 pa[2];
#pragma unroll
    for (int ks = 0; ks < 2; ++ks) pa[ks] = *(const LAS bf16x8*)(PW + lr * PW_LD + 32 * ks + 8 * lq);
#pragma unroll
    for (int ct = 0; ct < 4; ++ct)
#pragma unroll
        for (int ks = 0; ks < 2; ++ks) { const bf16x8 vb = *(const bf16x8*)(VTt + (size_t)(16 * ct + lr) * vld + 32 * ks + 8 * lq); st.O[ct] = mfma16(pa[ks], vb, st.O[ct]); }
}
__device__ __forceinline__ void sm_init(OnlineSm& s) {
#pragma unroll
    for (int r = 0; r < 4; ++r) { s.m[r] = NEGF; s.l[r] = 0.f; }
#pragma unroll
    for (int ct = 0; ct < 4; ++ct) s.O[ct] = (f32x4){0.f, 0.f, 0.f, 0.f};
}
__device__ __forceinline__ void nsa_item(const Args& A, LAS unsigned char* lds, int item) {
    const int tid = threadIdx.x, lane = tid & 63, w = tid >> 6, lr = lane & 15, lq = lane >> 4;
    const int qt = item >> 5, b = (item >> 2) & 7, g = item & 3, t0 = qt * 32, q0 = t0 + 4 * w, qpos = q0 + lq;
    LAS float* PS = (LAS float*)lds + w * 1024;
    LAS bf16* PW = (LAS bf16*)(lds + 32768) + w * 16 * PW_LD;
    const bf16* Qb = (const bf16*)(A.ws + WS_Q); const bf16* KV6 = (const bf16*)(A.ws + WS_KV6); const bf16* KC = (const bf16*)(A.ws + WS_KC); const bf16* VCT = (const bf16*)(A.ws + WS_VCT);
    const bf16* VTS = (const bf16*)(A.ws + WS_VTS); const bf16* VTW = (const bf16*)(A.ws + WS_VTW); const float* GT = (const float*)(A.ws + WS_GATES); bf16* ATT = (bf16*)(A.ws + WS_CAT);
    __syncthreads();
    bf16x8 qa[2];
    {   const size_t qrow = (size_t)b * SEQ + q0 + (lr >> 2); const int head = 4 * g + (lr & 3);
#pragma unroll
        for (int ks = 0; ks < 2; ++ks) qa[ks] = *(const bf16x8*)(Qb + qrow * 1024 + head * 64 + 32 * ks + 8 * lq); }
    f32x4 OC[4];
#pragma unroll
    for (int ct = 0; ct < 4; ++ct) OC[ct] = (f32x4){0.f, 0.f, 0.f, 0.f};
    {   const int qmax = q0 + 3; const int ncv = (qmax >= 31) ? ((qmax - 31) >> 4) + 1 : 0; const int ntmax = (ncv + 15) >> 4;
        const bf16* KCb = KC + ((size_t)(b * 256) * 4 + g) * 64;
        f32x4 s[16];
#pragma unroll
        for (int nt = 0; nt < 16; ++nt) {
            if (nt < ntmax) { const bf16* kp = KCb + (size_t)(16 * nt + lr) * 256 + 8 * lq; const bf16x8 k0 = *(const bf16x8*)kp, k1 = *(const bf16x8*)(kp + 32);
                s[nt] = mfma16(qa[0], k0, (f32x4){0.f, 0.f, 0.f, 0.f}); s[nt] = mfma16(qa[1], k1, s[nt]); }
            else s[nt] = (f32x4){NEGF, NEGF, NEGF, NEGF}; }
        float inv[4], mrow[4];
#pragma unroll
        for (int r = 0; r < 4; ++r) { float mx = NEGF;
#pragma unroll
            for (int nt = 0; nt < 16; ++nt) { const bool vis = (16 * (16 * nt + lr) + 31 <= qpos); mx = fmaxf(mx, vis ? s[nt][r] : NEGF); }
            mrow[r] = gmax16(mx); }
#pragma unroll
        for (int r = 0; r < 4; ++r) { float ls = 0.f;
#pragma unroll
            for (int nt = 0; nt < 16; ++nt) { const bool vis = (16 * (16 * nt + lr) + 31 <= qpos); const float p = vis ? exp2f((s[nt][r] - mrow[r]) * LOG2E) : 0.f; s[nt][r] = p; ls += p; }
            ls = gsum16(ls); inv[r] = ls > 0.f ? 1.f / ls : 0.f; }
#pragma unroll
        for (int nt = 0; nt < 16; ++nt) { float hs = 0.f;
#pragma unroll
            for (int r = 0; r < 4; ++r) { s[nt][r] *= inv[r]; hs += s[nt][r]; }
            PS[lq * 256 + 16 * nt + lr] = hs; }
#pragma unroll
        for (int kc4 = 0; kc4 < 4; ++kc4) {
            if (kc4 * 4 < ntmax) {
#pragma unroll
                for (int ntl = 0; ntl < 4; ++ntl)
#pragma unroll
                    for (int r = 0; r < 4; ++r) PW[(lq * 4 + r) * PW_LD + 16 * ntl + lr] = (bf16)f2bf(s[4 * kc4 + ntl][r]);
                bf16x8 pa[2];
#pragma unroll
                for (int ks = 0; ks < 2; ++ks) pa[ks] = *(const LAS bf16x8*)(PW + lr * PW_LD + 32 * ks + 8 * lq);
#pragma unroll
                for (int ct = 0; ct < 4; ++ct)
#pragma unroll
                    for (int ks = 0; ks < 2; ++ks) { const bf16x8 vb = *(const bf16x8*)(VCT + ((size_t)(b * 4 + g) * 64 + 16 * ct + lr) * 256 + 64 * kc4 + 32 * ks + 8 * lq); OC[ct] = mfma16(pa[ks], vb, OC[ct]); }
            } }
    }
    unsigned long long msk[4];
#pragma unroll
    for (int qi = 0; qi < 4; ++qi) { const int j = lane, qp = q0 + qi, cur = qp >> 6; const LAS float* base = PS + qi * 256;
        float imp = base[4 * j] + base[4 * j + 1] + base[4 * j + 2] + 0.5f * base[4 * j + 3]; if (j > 0) imp += 0.5f * base[4 * j - 1];
        const bool forced = (j == 0) || (j == cur) || (j == cur - 1), causal = (64 * j <= qp);
        const float val = forced ? BIGF : (causal ? imp : NEGF); int cnt = 0;
        for (int jj = 0; jj < 64; ++jj) { const float vo = __shfl(val, jj); cnt += ((vo > val) || (vo == val && jj < j)) ? 1 : 0; }
        msk[qi] = __ballot(cnt < 16); }
    const unsigned long long mymask = (lq == 0) ? msk[0] : (lq == 1) ? msk[1] : (lq == 2) ? msk[2] : msk[3];
    const unsigned long long uni = msk[0] | msk[1] | msk[2] | msk[3];
    OnlineSm SS; sm_init(SS);
    {   const int cur = t0 >> 6; const bf16* Kb = KV6 + (size_t)b * SEQ * 1536 + 2 * 256 + g * 64; const bf16* Vb = VTS + (size_t)((b * 4 + g) * 64) * SEQ;
        for (int kt = 0; kt <= cur; ++kt) { if (!((uni >> kt) & 1ull)) continue; const bool selq = (mymask >> kt) & 1ull;
            attn_tile(qa, Kb + (size_t)(64 * kt) * 1536, 1536, Vb + 64 * kt, SEQ, [&](int nt) { const int key = 64 * kt + 16 * nt + lr; return selq && key <= qpos; }, SS, PW, lr, lq); } }
    OnlineSm SW; sm_init(SW);
    {   const int lo = (q0 - 511 > 0 ? q0 - 511 : 0) >> 6, hi = (q0 + 3) >> 6; const bf16* Kb = KV6 + (size_t)b * SEQ * 1536 + 4 * 256 + g * 64; const bf16* Vb = VTW + (size_t)((b * 4 + g) * 64) * SEQ;
        for (int kt = lo; kt <= hi; ++kt)
            attn_tile(qa, Kb + (size_t)(64 * kt) * 1536, 1536, Vb + 64 * kt, SEQ, [&](int nt) { const int key = 64 * kt + 16 * nt + lr; return key <= qpos && key + 512 > qpos; }, SW, PW, lr, lq); }
    const size_t orow = (size_t)b * SEQ + qpos;
#pragma unroll
    for (int r = 0; r < 4; ++r) { const int head = 4 * g + r; const float* gp = GT + orow * 48 + head * 3; const float g0 = gp[0], g1 = gp[1], g2 = gp[2];
        const float ls = gsum16(SS.l[r]), lw = gsum16(SW.l[r]); const float is = g1 / ls, iw = g2 / lw;
#pragma unroll
        for (int ct = 0; ct < 4; ++ct) ATT[orow * 1024 + head * 64 + 16 * ct + lr] = (bf16)f2bf(g0 * OC[ct][r] + is * SS.O[ct][r] + iw * SW.O[ct][r]); }
}
constexpr int LDS_BYTES = 147456;
constexpr int NPHASES = 17;
#ifndef PHMASK
#define PHMASK 0x1ffff
#endif
#ifndef MK_SINGLE
#define MK_SINGLE 0
#endif

template <class Epi> __device__ __forceinline__ void run_gemm(LAS unsigned char* lds, const bf16* Aop, const bf16* Bt, int N, int K, const Epi& E) {
    pg8::Gemm g{Aop, Bt, MROWS, N, K}; pg8::StaticOrder S; S.init(MROWS, N, (int)gridDim.x, (int)blockIdx.x);
    pg8::gemm_phase<Epi, pg8::StaticOrder, true, true>(lds, g, S, E);
}

__global__ void __launch_bounds__(NTHREADS, 2) mk_fwd(Args args) {
    extern __shared__ __attribute__((aligned(16))) unsigned char lds_raw[];
    LAS unsigned char* lds = (LAS unsigned char*)lds_raw;
    cg::grid_group grid = cg::this_grid();
    const int tid = threadIdx.x, lane = tid & 63, wave = __builtin_amdgcn_readfirstlane(tid >> 6);
    const int gw = blockIdx.x * NWAVES + wave, NGW = gridDim.x * NWAVES;
    unsigned char* ws = args.ws;
    const int lo = args.ph_lo, hi = args.ph_hi;
#define PH_BEGIN(k) if (lo <= (k) && (k) < hi) { if ((k) > lo) grid.sync(); __syncthreads(); if constexpr ((PHMASK >> (k)) & 1) {
#define PH_END }}
    PH_BEGIN(0) p0_prologue(args, lds, wave, lane); PH_END
    PH_BEGIN(1) { pg8::EpiProj0 E{(bf16*)(ws + WS_PROJ0), (const float*)(ws + TAB_RCOS), (const float*)(ws + TAB_RSIN)};
                  run_gemm(lds, (const bf16*)(ws + WS_XN), (const bf16*)(ws + W_ABIN), AB_IN, 1024, E); } PH_END
    PH_BEGIN(2) for (int it = blockIdx.x; it < 3072; it += gridDim.x) { if (it < 1024) lru_item(args, lds, it, 0); else ret_kv_item(args, lds, it - 1024); } PH_END
    PH_BEGIN(3) for (int it = blockIdx.x; it < 3072; it += gridDim.x) { if (it < 1024) lru_item(args, lds, it, 1); else ret_out_item(args, lds, it - 1024); } PH_END
    PH_BEGIN(4) { pg8::EpiResid E{args.in[I_X], args.out}; run_gemm(lds, (const bf16*)(ws + WS_CAT), (const bf16*)(ws + W_ABOUT), 1024, 1024, E); } PH_END
    PH_BEGIN(5) norm_phase(args.out, args.in[I_FFN_NORM], (bf16*)(ws + WS_XN), gw, NGW, lane); PH_END
    PH_BEGIN(6) { pg8::EpiFfnUp E{(bf16*)(ws + WS_ACT), FFH}; run_gemm(lds, (const bf16*)(ws + WS_XN), (const bf16*)(ws + W_F13), 2 * FFH, 1024, E); } PH_END
    PH_BEGIN(7) { pg8::EpiResid E{args.out, args.out}; run_gemm(lds, (const bf16*)(ws + WS_ACT), (const bf16*)(ws + W_F2), 1024, FFH, E); } PH_END
    PH_BEGIN(8) norm_phase(args.out, args.in[I_ATTN_NORM] + DM, (bf16*)(ws + WS_XN), gw, NGW, lane); PH_END
    PH_BEGIN(9) { pg8::EpiNsaIn E{(bf16*)(ws + WS_Q), (bf16*)(ws + WS_KV6), (float*)(ws + WS_GATES), (const float*)(ws + TAB_NCOS), (const float*)(ws + TAB_NSIN)};
                  run_gemm(lds, (const bf16*)(ws + WS_XN), (const bf16*)(ws + W_NSAIN), NSA_INP, 1024, E); } PH_END
    PH_BEGIN(10) for (int it = blockIdx.x; it < 1024 + 4096; it += gridDim.x) { if (it < 1024) cmp_item(args, lds, it); else vtr_item(args, lds, it - 1024); } PH_END
    PH_BEGIN(11) for (int it = blockIdx.x; it < 4096; it += gridDim.x) nsa_item(args, lds, it); PH_END
    PH_BEGIN(12) { pg8::EpiResid E{args.out, args.out}; run_gemm(lds, (const bf16*)(ws + WS_CAT), (const bf16*)(ws + W_NSAOUT), 1024, 1024, E); } PH_END
    PH_BEGIN(13) norm_phase(args.out, args.in[I_FFN_NORM] + DM, (bf16*)(ws + WS_XN), gw, NGW, lane); PH_END
    PH_BEGIN(14) { pg8::EpiFfnUp E{(bf16*)(ws + WS_ACT), FFH}; run_gemm(lds, (const bf16*)(ws + WS_XN), (const bf16*)(ws + W_F13) + (size_t)2 * FFH * 1024, 2 * FFH, 1024, E); } PH_END
    PH_BEGIN(15) { pg8::EpiResid E{args.out, args.out}; run_gemm(lds, (const bf16*)(ws + WS_ACT), (const bf16*)(ws + W_F2) + (size_t)1024 * FFH, 1024, FFH, E); } PH_END
    PH_BEGIN(16) for (int m = gw; m < MROWS; m += NGW) rms_row_to_f32(args.out + (size_t)m * DM, args.in[I_FINAL_NORM], args.out + (size_t)m * DM, lane); PH_END
}

extern "C" void kernel_launch(void* const* d_in, const int* in_sizes, int n_in, void* d_out, int out_size, void* d_ws, size_t ws_size, hipStream_t stream) {
    static int grid = 0;
    if (grid == 0) {
        if (n_in != 24 || out_size != MROWS * DM || ws_size < WS_END) { fprintf(stderr, "kernel_launch: unexpected shapes (n_in %d out %d ws %zu)\n", n_in, out_size, ws_size); grid = -1; return; }
        int dev = 0, cus = 0, per_cu = 0;
        if (hipGetDevice(&dev) != hipSuccess || hipDeviceGetAttribute(&cus, hipDeviceAttributeMultiprocessorCount, dev) != hipSuccess) { grid = -1; return; }
        if (hipFuncSetAttribute((const void*)mk_fwd, hipFuncAttributeMaxDynamicSharedMemorySize, LDS_BYTES) != hipSuccess) { fprintf(stderr, "kernel_launch: hipFuncSetAttribute failed\n"); grid = -1; return; }
        if (hipOccupancyMaxActiveBlocksPerMultiprocessor(&per_cu, (const void*)mk_fwd, NTHREADS, LDS_BYTES) != hipSuccess || per_cu < 1) { fprintf(stderr, "kernel_launch: occupancy query says %d\n", per_cu); per_cu = 1; }
        (void)hipGetLastError();
        grid = cus;
    }
    if (grid < 0) return;
    Args a{};
    for (int i = 0; i < 24; ++i) a.in[i] = (const float*)d_in[i];
    a.out = (float*)d_out; a.ws = (unsigned char*)d_ws;
#if MK_SINGLE
    a.ph_lo = 0; a.ph_hi = NPHASES;
    void* kargs[] = {&a};
    hipError_t e = hipLaunchCooperativeKernel((const void*)mk_fwd, dim3(grid), dim3(NTHREADS), kargs, LDS_BYTES, stream);
    if (e != hipSuccess) fprintf(stderr, "kernel_launch: cooperative launch failed: %s (grid %d)\n", hipGetErrorString(e), grid);
#else
    for (int ph = 0; ph < NPHASES; ++ph) { a.ph_lo = ph; a.ph_hi = ph + 1; hipLaunchKernelGGL(mk_fwd, dim3(grid), dim3(NTHREADS), LDS_BYTES, stream, a); }
#endif
}
```

```cpp
#include <hip/hip_runtime.h>
#include <hip/hip_cooperative_groups.h>
#include <cstdio>
#include <cstdint>
namespace cg = cooperative_groups;
namespace pg8 {
#define PG8_LAS __attribute__((address_space(3)))
typedef unsigned short bf16_t;
typedef short bf16x8 __attribute__((ext_vector_type(8)));
typedef float f32x4 __attribute__((ext_vector_type(4)));
typedef unsigned u32x4 __attribute__((ext_vector_type(4)));
constexpr int BM = 256, BK = 64, HALF = 128, HTB = HALF * BK * 2  , STAGE_BYTES = 8 * HTB, NXCD = 8, WGM = 8;

__host__ __device__ __forceinline__ int lds_byte(int r, int c) { const int st = (r >> 4) * 2 + (c >> 5), rr = r & 15, cc = c & 31, ob = rr * 64 + cc * 2; return st * 1024 + (ob ^ (((ob >> 9) & 1) << 5)); }
__host__ __device__ __forceinline__ void stage_rc(int b, int& R, int& C) { const int st = b / 1024, sb = b % 1024, swz = sb ^ (((sb >> 9) & 1) << 5); R = (st >> 1) * 16 + swz / 64; C = (st & 1) * 32 + (swz % 64) / 2; }
__host__ __device__ __forceinline__ int perm32(int rho) { const int n = rho >> 4, i = rho & 15; return 8 * (i >> 2) + 4 * n + (i & 3); }

struct Unit { int pm, pn, ui; };
struct Gemm { const bf16_t* A; const bf16_t* Bt; int M, N, K; };

struct StaticOrder {
    int nM, nN, nwg, G, c;
    __host__ __device__ void init(int M, int N, int G_, int c_) { nM = M / BM; nN = N / BM; nwg = nM * nN; G = G_; c = c_; }
    __host__ __device__ bool next(int i, Unit& u) const {
        const long L = (long)i * G + c; if (L >= nwg) return false;
        int wgid = (int)L; { const int q = nwg / NXCD, r = nwg % NXCD, xcd = wgid % NXCD, off = wgid / NXCD; wgid = (xcd < r ? xcd * (q + 1) : r * (q + 1) + (xcd - r) * q) + off; }
        const int nig = WGM * nN, gid = wgid / nig, fm = gid * WGM, gsz = (nM - fm) < WGM ? (nM - fm) : WGM;
        u.pm = fm + ((wgid % nig) % gsz); u.pn = (wgid % nig) / gsz; u.ui = i; return true;
    }
    __device__ __forceinline__ void a_ready(const Unit&) const {}
    __device__ __forceinline__ void done(const Unit&) const {}
};

__device__ __forceinline__ unsigned cvt_pk_bf16(float lo, float hi) { unsigned r; asm volatile("v_cvt_pk_bf16_f32 %0, %1, %2" : "=v"(r) : "v"(lo), "v"(hi)); return r; }
typedef unsigned u32x2 __attribute__((ext_vector_type(2)));
__device__ __forceinline__ float sigmoid_f(float x) { return __builtin_amdgcn_rcpf(1.f + __builtin_amdgcn_exp2f(-1.4426950408889634f * x)); }
__device__ __forceinline__ float silu_f(float x) { return x * __builtin_amdgcn_rcpf(1.f + __builtin_amdgcn_exp2f(-1.4426950408889634f * x)); }
__device__ __forceinline__ u32x4 pack8(const f32x4 a, const f32x4 b) { u32x4 w; w.x = cvt_pk_bf16(a[0], a[1]); w.y = cvt_pk_bf16(a[2], a[3]); w.z = cvt_pk_bf16(b[0], b[1]); w.w = cvt_pk_bf16(b[2], b[3]); return w; }
__device__ __forceinline__ u32x2 pack4(const f32x4 a) { u32x2 w; w.x = cvt_pk_bf16(a[0], a[1]); w.y = cvt_pk_bf16(a[2], a[3]); return w; }

__device__ __forceinline__ float row_rs_g(const float* SS, int row) { const f32x4* p = (const f32x4*)(SS + (size_t)row * 16); const f32x4 a = p[0], b = p[1], c = p[2], d = p[3];
    const float t = ((a[0] + a[1]) + (a[2] + a[3])) + ((b[0] + b[1]) + (b[2] + b[3])) + ((c[0] + c[1]) + (c[2] + c[3])) + ((d[0] + d[1]) + (d[2] + d[3])); return 1.f / sqrtf(t * (1.f / 1024.f) + 1e-6f); }
struct EpiProj0 {
    static constexpr bool PERM = true, AFTER_DRAIN = false;
    bf16_t* P; const float* cosT; const float* sinT; const PG8_LAS float* RS;
    __device__ __forceinline__ void operator()(const f32x4 (&acc)[2][2][4][2], const Unit& u, int wr, int wc, int fr, int fq) const {
        const int row0 = u.pm * BM + wr * 64 + fr, colt = u.pn * BM + wc * 32 + 8 * fq;
        const bool rot = (u.pn >= 4 && u.pn < 8); const float sc = (u.pn >= 6 && u.pn < 8) ? 0.125f : 1.f;
#pragma unroll
        for (int ai = 0; ai < 2; ++ai)
#pragma unroll
            for (int m = 0; m < 4; ++m) { const int row = row0 + ai * HALF + m * 16, pos = row & 4095; bf16_t* rowp = P + (size_t)row * 3072; const float rs = RS[u.ui * 256 + (row & 255)];
#pragma unroll
                for (int bj = 0; bj < 2; ++bj) { const int col = colt + bj * HALF; const f32x4 v0 = acc[ai][bj][m][0] * rs, v1 = acc[ai][bj][m][1] * rs;
                    if (rot) { const int hc = col & 63, gi = hc >> 3, hb = col - hc;
                        const f32x4 c = *(const f32x4*)(cosT + pos * 32 + 4 * gi), s = *(const f32x4*)(sinT + pos * 32 + 4 * gi);
                        const f32x4 o1 = (v0 * c - v1 * s) * sc, o2 = (v1 * c + v0 * s) * sc;
                        *(u32x2*)(rowp + hb + 4 * gi) = pack4(o1); *(u32x2*)(rowp + hb + 32 + 4 * gi) = pack4(o2);
                    } else { *(u32x4*)(rowp + col) = pack8(v0, v1); } } }
    }
};
struct EpiNsaIn {
    static constexpr bool PERM = true, AFTER_DRAIN = false;
    bf16_t* Q; bf16_t* KV; float* G; bf16_t* VTS; bf16_t* VTW; const float* cosT; const float* sinT; const PG8_LAS float* RS;
    __device__ __forceinline__ void operator()(const f32x4 (&acc)[2][2][4][2], const Unit& u, int wr, int wc, int fr, int fq) const {
        const int row0 = u.pm * BM + wr * 64 + fr, pn = u.pn;
#pragma unroll
        for (int ai = 0; ai < 2; ++ai)
#pragma unroll
            for (int m = 0; m < 4; ++m) { const int row = row0 + ai * HALF + m * 16, pos = row & 4095; const float rs = RS[u.ui * 256 + (row & 255)];
#pragma unroll
                for (int bj = 0; bj < 2; ++bj) { const int lc = bj * HALF + wc * 32 + 8 * fq; const f32x4 v0 = acc[ai][bj][m][0] * rs, v1 = acc[ai][bj][m][1] * rs;
                    if (pn < 10) {
                        bf16_t* dst; bool rot; float sc;
                        if (pn < 4) { dst = Q + (size_t)row * 1024 + pn * 256 + lc; rot = true; sc = 0.125f * 1.4426950408889634f; }
                        else { const int j = pn - 4;
                            if (j == 3 || j == 5) {
                                bf16_t* vt = (j == 3 ? VTS : VTW) + ((size_t)((row >> 12) * 4 + (lc >> 6)) * 64 + (lc & 63)) * 4096 + pos; const u32x4 w8 = pack8(v0, v1); const unsigned wv[4] = {w8.x, w8.y, w8.z, w8.w};
#pragma unroll
                                for (int i = 0; i < 4; ++i) { vt[(size_t)(2 * i) * 4096] = (bf16_t)(wv[i] & 0xffffu); vt[(size_t)(2 * i + 1) * 4096] = (bf16_t)(wv[i] >> 16); }
                                continue; }
                            dst = KV + (size_t)row * 1536 + j * 256 + lc; rot = (j == 2 || j == 4); sc = 1.f; }
                        const int hc = lc & 63;
                        if (rot && hc < 16) { const int gi = hc >> 3;
                            const f32x4 c = *(const f32x4*)(cosT + pos * 8 + 4 * gi), s = *(const f32x4*)(sinT + pos * 8 + 4 * gi);
                            const f32x4 o1 = (v0 * c - v1 * s) * sc, o2 = (v1 * c + v0 * s) * sc;
                            bf16_t* hbp = dst - hc; *(u32x2*)(hbp + 4 * gi) = pack4(o1); *(u32x2*)(hbp + 8 + 4 * gi) = pack4(o2);
                        } else { *(u32x4*)dst = pack8(v0 * sc, v1 * sc); }
                    } else if (lc < 48) {
                        float* gp = G + (size_t)row * 48 + lc; f32x4 a, b;
#pragma unroll
                        for (int i = 0; i < 4; ++i) { a[i] = sigmoid_f(v0[i]); b[i] = sigmoid_f(v1[i]); }
                        *(f32x4*)gp = a; *(f32x4*)(gp + 4) = b; } } }
    }
};
struct EpiFfnUp {
    static constexpr bool PERM = true, AFTER_DRAIN = false;
    bf16_t* ACT; int ld; const PG8_LAS float* RS;
    __device__ __forceinline__ void operator()(const f32x4 (&acc)[2][2][4][2], const Unit& u, int wr, int wc, int fr, int fq) const {
        const int row0 = u.pm * BM + wr * 64 + fr, col = u.pn * 128 + wc * 32 + 8 * fq;
#pragma unroll
        for (int ai = 0; ai < 2; ++ai)
#pragma unroll
            for (int m = 0; m < 4; ++m) { const int row = row0 + ai * HALF + m * 16; f32x4 h0, h1; const float rs = RS[u.ui * 256 + (row & 255)];
#pragma unroll
                for (int i = 0; i < 4; ++i) { h0[i] = silu_f(acc[ai][0][m][0][i] * rs) * (acc[ai][1][m][0][i] * rs); h1[i] = silu_f(acc[ai][0][m][1][i] * rs) * (acc[ai][1][m][1][i] * rs); }
                *(u32x4*)(ACT + (size_t)row * ld + col) = pack8(h0, h1); }
    }
};
struct EpiResid {
    static constexpr bool PERM = true, AFTER_DRAIN = false;
    const float* base; float* out; bf16_t* HB; float* SS;
    __device__ __forceinline__ void operator()(const f32x4 (&acc)[2][2][4][2], const Unit& u, int wr, int wc, int fr, int fq) const {
        const int row0 = u.pm * BM + wr * 64 + fr, col0 = u.pn * BM + wc * 32 + 8 * fq;
#pragma unroll
        for (int ai = 0; ai < 2; ++ai) {
            f32x4 pre[4][2][2];
#pragma unroll
            for (int m = 0; m < 4; ++m) { const size_t off = (size_t)(row0 + ai * HALF + m * 16) * 1024 + col0;
#pragma unroll
                for (int bj = 0; bj < 2; ++bj) { pre[m][bj][0] = *(const f32x4*)(base + off + bj * HALF); pre[m][bj][1] = *(const f32x4*)(base + off + bj * HALF + 4); } }
            asm volatile("" ::: "memory");
#pragma unroll
            for (int m = 0; m < 4; ++m) { const int row = row0 + ai * HALF + m * 16; const size_t off = (size_t)row * 1024 + col0; float ssq = 0.f;
#pragma unroll
                for (int bj = 0; bj < 2; ++bj) { const size_t o = off + bj * HALF; const f32x4 v0 = pre[m][bj][0] + acc[ai][bj][m][0], v1 = pre[m][bj][1] + acc[ai][bj][m][1];
                    *(f32x4*)(out + o) = v0; *(f32x4*)(out + o + 4) = v1;
                    if (HB) { *(u32x4*)(HB + o) = pack8(v0, v1); ssq += ((v0[0] * v0[0] + v0[1] * v0[1]) + (v0[2] * v0[2] + v0[3] * v0[3])) + ((v1[0] * v1[0] + v1[1] * v1[1]) + (v1[2] * v1[2] + v1[3] * v1[3])); } }
                if (HB) { ssq += __shfl_xor(ssq, 16); ssq += __shfl_xor(ssq, 32); if (fq == 0) SS[(size_t)row * 16 + u.pn * 4 + wc] = ssq; } }
            asm volatile("" ::: "memory");
        }
    }
};
template <class Epi, class Sched, bool ALIGN_EPI = false, bool SP2 = false>
__device__ __forceinline__ void gemm_phase(PG8_LAS unsigned char* lds, const Gemm g, const Sched& S, const Epi& E) {
    const int tid = threadIdx.x, wid = __builtin_amdgcn_readfirstlane(tid >> 6), lane = tid & 63, wr = wid >> 2, wc = wid & 3, fr = lane & 15, fq = lane >> 4;
    const int K = g.K, nt = K / BK;
    unsigned voffA[2], voffB[2];
#pragma unroll
    for (int i = 0; i < 2; ++i) { int R, C; stage_rc(tid * 16 + i * 8192, R, C); const int Rb = Epi::PERM ? ((R & ~31) + perm32(R & 31)) : R;
        voffA[i] = (unsigned)(R * K + C) * 2u; voffB[i] = (unsigned)(Rb * K + C) * 2u; }
    const size_t kstep = (size_t)(BK * 2);
    const size_t hstep = (size_t)HALF * K * 2;
    const size_t tstep = 2 * hstep;
    const unsigned ldsw = (unsigned)wid * 1024u;
    const int aoff = lds_byte(wr * 64 + fr, fq * 8), boff = lds_byte(wc * 32 + fr, fq * 8);
#define PG8_SA(b, h) (((b) * 2 + (h)) * HTB)
#define PG8_SB(b, h) ((4 + (b) * 2 + (h)) * HTB)
#define PG8_STAGE(bufoff, gbase, voff) do { _Pragma("unroll") for (int _i = 0; _i < 2; ++_i) \
        __builtin_amdgcn_global_load_lds((const unsigned*)((const char*)(gbase) + (voff)[_i]), (PG8_LAS unsigned*)(lds + (bufoff) + ldsw + _i * 8192), 16, 0, 0); } while (0)
#define PG8_LDA(dst, b, h) do { _Pragma("unroll") for (int m = 0; m < 4; ++m) _Pragma("unroll") for (int k = 0; k < 2; ++k) dst[m][k] = *(const PG8_LAS bf16x8*)(lds + PG8_SA(b, h) + aoff + m * 2048 + k * 1024); } while (0)
#define PG8_LDB(dst, b, h) do { _Pragma("unroll") for (int n = 0; n < 2; ++n) _Pragma("unroll") for (int k = 0; k < 2; ++k) dst[n][k] = *(const PG8_LAS bf16x8*)(lds + PG8_SB(b, h) + boff + n * 2048 + k * 1024); } while (0)
#define PG8_MMA(ai, bj, At, Bt) do { __builtin_amdgcn_s_setprio(1); _Pragma("unroll") for (int m = 0; m < 4; ++m) _Pragma("unroll") for (int n = 0; n < 2; ++n) _Pragma("unroll") for (int k = 0; k < 2; ++k) \
        acc[ai][bj][m][n] = __builtin_amdgcn_mfma_f32_16x16x32_bf16(Bt[n][k], At[m][k], acc[ai][bj][m][n], 0, 0, 0); __builtin_amdgcn_s_setprio(0); } while (0)
#define PG8_WAIT_V(n) asm volatile("s_waitcnt vmcnt(" #n ")" ::: "memory")
#define PG8_WAIT_L(n) asm volatile("s_waitcnt lgkmcnt(" #n ")" ::: "memory")
#define PG8_BAR __builtin_amdgcn_s_barrier()
#define PG8_SCHED __builtin_amdgcn_sched_barrier(0)
    Unit cur, nxt; int ui = 0;
    if (!S.next(0, cur)) return;
    f32x4 acc[2][2][4][2];
#pragma unroll
    for (int a = 0; a < 2; ++a)
#pragma unroll
        for (int b = 0; b < 2; ++b)
#pragma unroll
            for (int m = 0; m < 4; ++m)
#pragma unroll
                for (int n = 0; n < 2; ++n) acc[a][b][m][n] = (f32x4){0.f, 0.f, 0.f, 0.f};
    bf16x8 At[4][2], B0[2][2], B1[2][2];
    const char* cA = (const char*)g.A + (size_t)cur.pm * tstep; const char* cB = (const char*)g.Bt + (size_t)cur.pn * tstep;
    S.a_ready(cur);
    if constexpr (SP2) {
        PG8_STAGE(PG8_SB(0, 0), cB, voffB); PG8_STAGE(PG8_SB(0, 1), cB + hstep, voffB); PG8_STAGE(PG8_SA(0, 0), cA, voffA); PG8_STAGE(PG8_SA(0, 1), cA + hstep, voffA);
        if (wr == 1) PG8_BAR;
        PG8_WAIT_V(2); PG8_BAR;
        PG8_STAGE(PG8_SB(1, 0), cB + kstep, voffB); PG8_STAGE(PG8_SA(1, 0), cA + kstep, voffA); PG8_STAGE(PG8_SB(1, 1), cB + hstep + kstep, voffB);
        PG8_WAIT_V(6); PG8_BAR;
    } else {
        PG8_STAGE(PG8_SB(0, 0), cB, voffB); PG8_STAGE(PG8_SA(0, 0), cA, voffA); PG8_STAGE(PG8_SB(0, 1), cB + hstep, voffB); PG8_STAGE(PG8_SA(0, 1), cA + hstep, voffA);
        if (wr == 1) PG8_BAR;
        PG8_WAIT_V(4); PG8_BAR;
        PG8_STAGE(PG8_SB(1, 0), cB + kstep, voffB); PG8_STAGE(PG8_SA(1, 0), cA + kstep, voffA); PG8_STAGE(PG8_SB(1, 1), cB + hstep + kstep, voffB);
        PG8_WAIT_V(6); PG8_BAR;
    }
    for (;;) {
        const bool has_next = S.next(ui + 1, nxt);
        const char* nA = has_next ? (const char*)g.A + (size_t)nxt.pm * tstep : cA; const char* nB = has_next ? (const char*)g.Bt + (size_t)nxt.pn * tstep : cB;
        for (int t = 0; t < nt; t += 2) {
            const bool last = (t == nt - 2);
            const char* a1 = cA + (size_t)(t + 1) * kstep;
            const char* a2 = last ? nA : cA + (size_t)(t + 2) * kstep; const char* b2 = last ? nB : cB + (size_t)(t + 2) * kstep;
            const char* a3 = a2 + kstep; const char* b3 = b2 + kstep;
            if (last && has_next) S.a_ready(nxt);
            if constexpr (SP2) {
            PG8_LDB(B0, 0, 0); PG8_LDB(B1, 0, 1); PG8_SCHED; PG8_LDA(At, 0, 0); PG8_STAGE(PG8_SA(1, 1), a1 + hstep, voffA);
            PG8_WAIT_V(8); PG8_WAIT_L(0); PG8_BAR; PG8_MMA(0, 0, At, B0); PG8_MMA(0, 1, At, B1); PG8_BAR; PG8_SCHED;
            PG8_LDA(At, 0, 1); PG8_STAGE(PG8_SB(0, 0), b2, voffB); PG8_STAGE(PG8_SB(0, 1), b2 + hstep, voffB); PG8_STAGE(PG8_SA(0, 0), a2, voffA);
            PG8_WAIT_V(8); PG8_WAIT_L(0); PG8_BAR; PG8_MMA(1, 0, At, B0); PG8_MMA(1, 1, At, B1); PG8_BAR; PG8_SCHED;
            PG8_LDB(B0, 1, 0); PG8_LDB(B1, 1, 1); PG8_SCHED; PG8_LDA(At, 1, 0); PG8_STAGE(PG8_SA(0, 1), a2 + hstep, voffA);
            PG8_WAIT_V(8); PG8_WAIT_L(0); PG8_BAR; PG8_MMA(0, 0, At, B0); PG8_MMA(0, 1, At, B1); PG8_BAR; PG8_SCHED;
            PG8_LDA(At, 1, 1); PG8_STAGE(PG8_SB(1, 0), b3, voffB); PG8_STAGE(PG8_SB(1, 1), b3 + hstep, voffB); PG8_STAGE(PG8_SA(1, 0), a3, voffA);
            PG8_WAIT_V(8); PG8_WAIT_L(0); PG8_BAR; PG8_MMA(1, 0, At, B0); PG8_MMA(1, 1, At, B1); PG8_BAR; PG8_SCHED;
            } else {
            PG8_LDB(B0, 0, 0); PG8_SCHED; PG8_LDA(At, 0, 0); PG8_STAGE(PG8_SA(1, 1), a1 + hstep, voffA);
            PG8_WAIT_L(8); PG8_BAR; PG8_WAIT_L(0); PG8_MMA(0, 0, At, B0); PG8_BAR; PG8_SCHED;
            PG8_LDB(B1, 0, 1); PG8_STAGE(PG8_SB(0, 0), b2, voffB);
            PG8_BAR; PG8_WAIT_L(0); PG8_MMA(0, 1, At, B1); PG8_BAR;
            PG8_LDA(At, 0, 1); PG8_STAGE(PG8_SA(0, 0), a2, voffA);
            PG8_BAR; PG8_WAIT_L(0); PG8_MMA(1, 0, At, B0); PG8_BAR; PG8_SCHED;
            PG8_STAGE(PG8_SB(0, 1), b2 + hstep, voffB);
            PG8_WAIT_V(6); PG8_BAR; PG8_MMA(1, 1, At, B1); PG8_BAR;
            PG8_LDB(B0, 1, 0); PG8_SCHED; PG8_LDA(At, 1, 0); PG8_STAGE(PG8_SA(0, 1), a2 + hstep, voffA);
            PG8_WAIT_L(8); PG8_BAR; PG8_WAIT_L(0); PG8_MMA(0, 0, At, B0); PG8_BAR; PG8_SCHED;
            PG8_LDB(B1, 1, 1); PG8_STAGE(PG8_SB(1, 0), b3, voffB);
            PG8_BAR; PG8_WAIT_L(0); PG8_MMA(0, 1, At, B1); PG8_BAR;
            PG8_LDA(At, 1, 1); PG8_STAGE(PG8_SA(1, 0), a3, voffA);
            PG8_BAR; PG8_WAIT_L(0); PG8_MMA(1, 0, At, B0); PG8_BAR; PG8_SCHED;
            PG8_STAGE(PG8_SB(1, 1), b3 + hstep, voffB);
            PG8_WAIT_V(6); PG8_BAR; PG8_MMA(1, 1, At, B1); PG8_BAR;
            }
        }
        if constexpr (ALIGN_EPI) { if (wr == 0) PG8_BAR; }
        if constexpr (!Epi::AFTER_DRAIN) { E(acc, cur, wr, wc, fr, fq); S.done(cur); }
        if (!has_next) break;
#pragma unroll
        for (int a = 0; a < 2; ++a)
#pragma unroll
            for (int b = 0; b < 2; ++b)
#pragma unroll
                for (int m = 0; m < 4; ++m)
#pragma unroll
                    for (int n = 0; n < 2; ++n) acc[a][b][m][n] = (f32x4){0.f, 0.f, 0.f, 0.f};
        cur = nxt; cA = nA; cB = nB; ++ui;
        if constexpr (ALIGN_EPI) { if (wr == 1) PG8_BAR; }
    }
    PG8_WAIT_V(0);
    if constexpr (!ALIGN_EPI) { if (wr == 0) PG8_BAR; }
    PG8_BAR;
    if constexpr (Epi::AFTER_DRAIN) { E.fused(acc, cur, wr, wc, fr, fq, lds, wid, lane); S.done(cur); }
#undef PG8_SA
#undef PG8_SB
#undef PG8_STAGE
#undef PG8_LDA
#undef PG8_LDB
#undef PG8_MMA
#undef PG8_WAIT_V
#undef PG8_WAIT_L
#undef PG8_BAR
#undef PG8_SCHED
}
}
#define LAS __attribute__((address_space(3)))
typedef unsigned short bf16;
typedef unsigned v4u __attribute__((ext_vector_type(4)));
typedef unsigned v2u __attribute__((ext_vector_type(2)));
typedef float f32x4 __attribute__((ext_vector_type(4)));
typedef short bf16x8 __attribute__((ext_vector_type(8)));

constexpr int NWAVES = 8, NTHREADS = 512;
constexpr int BATCH = 8, SEQ = 4096, DM = 1024, MROWS = BATCH * SEQ;
constexpr int AB_IN = 3072, FFH = 2816, NSA_IN = 2608, NSA_INP = 2816;
constexpr float EPSF = 1e-6f, NEGF = -1e30f, BIGF = 1e30f, LOG2E = 1.4426950408889634f;

constexpr size_t MiB = 1u << 20;
constexpr size_t WS_CTL = 0;
constexpr size_t WS_TAB = 1 * MiB;
constexpr size_t TAB_RCOS = WS_TAB, TAB_RSIN = TAB_RCOS + 4096 * 32 * 4, TAB_NCOS = TAB_RSIN + 4096 * 32 * 4, TAB_NSIN = TAB_NCOS + 4096 * 8 * 4, TAB_CB = TAB_NSIN + 4096 * 8 * 4;
constexpr size_t WS_W = 4 * MiB;
constexpr size_t W_ABIN = WS_W, W_ABOUT = W_ABIN + 6 * MiB, W_NSAIN = W_ABOUT + 2 * MiB, W_NSAOUT = W_NSAIN + 6 * MiB, W_F13 = W_NSAOUT + 2 * MiB  , W_F2 = W_F13 + 22 * MiB  ,
                 W_CK1 = W_F2 + 11 * MiB  , W_CV1 = W_CK1 + 256 * 1024, W_CK2 = W_CV1 + 256 * 1024  , W_CV2 = W_CK2 + 8192, W_GATE = W_CV2 + 8192  , W_END = W_GATE + 131072;
static_assert(W_END <= 64 * MiB, "weights");
constexpr size_t WS_XN = 64 * MiB;
constexpr size_t WS_CAT = 128 * MiB;
constexpr size_t WS_BIG = 192 * MiB;
constexpr size_t WS_PROJ0 = WS_BIG, WS_ACT = WS_BIG;
constexpr size_t WS_Q = WS_BIG, WS_KV6 = WS_BIG + 64 * MiB, WS_GATES = WS_KV6 + 96 * MiB, WS_KC = WS_GATES + 6 * MiB, WS_VCT = WS_KC + 1 * MiB, WS_VTS = WS_VCT + 1 * MiB, WS_VTW = WS_VTS + 16 * MiB;
constexpr size_t WS_KVT = 384 * MiB;
constexpr size_t WS_LSUM = 416 * MiB;
constexpr size_t WS_SS = 418 * MiB;
constexpr size_t WS_END = 428 * MiB;
static_assert(WS_VTW + 16 * MiB <= WS_KVT + 32 * MiB && WS_LSUM + 2 * MiB <= WS_SS && WS_PROJ0 + (size_t)MROWS * AB_IN * 2 <= WS_KVT, "ws map");

__device__ __forceinline__ float bf2f(bf16 v) { return __uint_as_float((unsigned)v << 16); }
__device__ __forceinline__ unsigned f2bf(float f) { unsigned u = __float_as_uint(f); return (u + 0x7fffu + ((u >> 16) & 1u)) >> 16; }
__device__ __forceinline__ unsigned pk2(float lo, float hi) { return f2bf(lo) | (f2bf(hi) << 16); }

__device__ __forceinline__ float gelu_tanh(float x) { const float u = 0.7978845608028654f * (x + 0.044715f * x * x * x); const float e = __expf(2.f * u); const float th = 1.f - 2.f / (e + 1.f); return 0.5f * x * (1.f + th); }
__device__ __forceinline__ float sigm(float x) { return 1.f / (1.f + __expf(-x)); }
__device__ __forceinline__ f32x4 mfma16(bf16x8 a, bf16x8 b, f32x4 c) { return __builtin_amdgcn_mfma_f32_16x16x32_bf16(a, b, c, 0, 0, 0); }
#define DPPF(x_, ctrl_) __int_as_float(__builtin_amdgcn_update_dpp(0, __float_as_int(x_), (ctrl_), 0xF, 0xF, true))
__device__ __forceinline__ float qsum4(float v) { v += DPPF(v, 0xB1); v += DPPF(v, 0x4E); return v; }
__device__ __forceinline__ float gsum16(float v) { v += DPPF(v, 0x128); v += DPPF(v, 0x124); v += DPPF(v, 0x122); v += DPPF(v, 0x121); return v; }
__device__ __forceinline__ float rows4_sum(float v) {
    auto a = __builtin_amdgcn_permlane16_swap(__float_as_uint(v), __float_as_uint(v), false, false); v = __uint_as_float(a[0]) + __uint_as_float(a[1]);
    auto c = __builtin_amdgcn_permlane32_swap(__float_as_uint(v), __float_as_uint(v), false, false); return __uint_as_float(c[0]) + __uint_as_float(c[1]); }
__device__ __forceinline__ float wave_sum(float v) { return rows4_sum(gsum16(v)); }

struct Args { const float* in[24]; float* out; unsigned char* ws; int ph_lo, ph_hi; };
enum { I_X = 0, I_ATTN_NORM, I_AB_W_IN, I_CONV_W, I_CONV_B, I_GA_W, I_GA_B, I_GX_W, I_GX_B, I_LAM, I_AB_W_OUT, I_NSA_W_IN, I_PE_K, I_K_W1, I_K_W2, I_PE_V, I_V_W1, I_V_W2, I_NSA_W_OUT,
       I_FFN_NORM, I_FFN_W1, I_FFN_W3, I_FFN_W2, I_FINAL_NORM };

struct P0Desc { const float* colp; const float* gain; bf16* wt; int ld, K, k0, d0; };
__device__ __forceinline__ void p0_decode(const Args& A, unsigned char* ws, int it, int lane, P0Desc& D) {
    constexpr int I_ABIN = 16 * (AB_IN / 32), I_SQ = 16 * 32, I_NSAIN = 16 * (NSA_INP / 32), I_F13 = 16 * (FFH / 32), I_F2 = (FFH / 64) * 32, I_C1 = 32 * 2, I_C2 = 2;
    int r = it, mapk = 0, Ndst = 1024, half = 0; const float* W; D.gain = nullptr; D.K = 1024;
    if (r < I_ABIN) { W = A.in[I_AB_W_IN]; D.ld = AB_IN; Ndst = AB_IN; D.wt = (bf16*)(ws + W_ABIN); D.gain = A.in[I_ATTN_NORM]; mapk = 1; }
    else if ((r -= I_ABIN) < I_SQ) { W = A.in[I_AB_W_OUT]; D.ld = 1024; D.wt = (bf16*)(ws + W_ABOUT); }
    else if ((r -= I_SQ) < I_NSAIN) { W = A.in[I_NSA_W_IN]; D.ld = NSA_IN; Ndst = NSA_INP; D.wt = (bf16*)(ws + W_NSAIN); D.gain = A.in[I_ATTN_NORM] + DM; mapk = 2; }
    else if ((r -= I_NSAIN) < I_SQ) { W = A.in[I_NSA_W_OUT]; D.ld = 1024; D.wt = (bf16*)(ws + W_NSAOUT); }
    else if ((r -= I_SQ) < 4 * I_F13) { const int q = r / I_F13; r -= q * I_F13; const int L = q & 1; half = q >> 1;
        W = A.in[half ? I_FFN_W3 : I_FFN_W1] + (size_t)L * 1024 * FFH; D.ld = FFH; Ndst = FFH; D.wt = (bf16*)(ws + W_F13) + (size_t)L * 2 * FFH * 1024; D.gain = A.in[I_FFN_NORM] + L * DM; mapk = 3; }
    else if ((r -= 4 * I_F13) < 2 * I_F2) { const int L = r / I_F2; r -= L * I_F2; W = A.in[I_FFN_W2] + (size_t)L * FFH * 1024; D.ld = 1024; D.K = FFH; D.wt = (bf16*)(ws + W_F2) + (size_t)L * 1024 * FFH; }
    else if ((r -= 2 * I_F2) < 2 * I_C1) { const int v = r / I_C1; r -= v * I_C1; W = A.in[v ? I_V_W1 : I_K_W1]; D.ld = 64; Ndst = 64; D.K = 2048; D.wt = (bf16*)(ws + (v ? W_CV1 : W_CK1)); }
    else { r -= 2 * I_C1; const int v = r / I_C2; r -= v * I_C2; W = A.in[v ? I_V_W2 : I_K_W2]; D.ld = 64; Ndst = 64; D.K = 64; D.wt = (bf16*)(ws + (v ? W_CV2 : W_CK2)); }
    const int nblk = Ndst / 32, kb = r / nblk, nb = r % nblk, n0 = 32 * nb, c = n0 + (lane & 31); D.k0 = 64 * kb; D.d0 = n0; int sc = c;
    if (mapk == 1) { if (c >= 1024 && c < 2048) { const int hc = c & 63, gi = hc >> 3, e = hc & 7; sc = (c - hc) + (e < 4 ? 4 * gi + e : 32 + 4 * gi + (e - 4)); } }
    else if (mapk == 2) { if (c >= NSA_IN) sc = -1; else if (c < 1024 || (c >= 1536 && c < 1792) || (c >= 2048 && c < 2304)) { const int hc = c & 63; if (hc < 16) { const int gi = hc >> 3, e = hc & 7; sc = (c - hc) + (e < 4 ? 4 * gi + e : 8 + 4 * gi + (e - 4)); } } }
    else if (mapk == 3) D.d0 = 256 * (n0 >> 7) + (n0 & 127) + 128 * half;
    D.colp = (sc < 0) ? nullptr : W + sc;
}
__device__ __forceinline__ void p0_load(const P0Desc& D, float (&tv)[32], int lane) {
#pragma unroll
    for (int i = 0; i < 32; ++i) { const int kk = 2 * i + (lane >> 5); tv[i] = D.colp ? D.colp[(size_t)(D.k0 + kk) * D.ld] : 0.f; }
}
__device__ __forceinline__ void p0_store(const P0Desc& D, const float (&tv)[32], LAS float* scr, int lane) {
    if (D.gain) {
#pragma unroll
        for (int i = 0; i < 32; ++i) { const int kk = 2 * i + (lane >> 5); scr[kk * 33 + (lane & 31)] = tv[i] * D.gain[D.k0 + kk]; }
    } else {
#pragma unroll
        for (int i = 0; i < 32; ++i) { const int kk = 2 * i + (lane >> 5); scr[kk * 33 + (lane & 31)] = tv[i]; } }
    asm volatile("s_waitcnt lgkmcnt(0)" ::: "memory");
    const int c = lane & 7;
#pragma unroll
    for (int j = 0; j < 4; ++j) { const int n = (lane >> 3) + 8 * j; const LAS float* s = scr + (8 * c) * 33 + n;
        v4u o; o.x = pk2(s[0 * 33], s[1 * 33]); o.y = pk2(s[2 * 33], s[3 * 33]); o.z = pk2(s[4 * 33], s[5 * 33]); o.w = pk2(s[6 * 33], s[7 * 33]);
        *(v4u*)(D.wt + (size_t)(D.d0 + n) * D.K + D.k0 + 8 * c) = o; }
    asm volatile("s_waitcnt lgkmcnt(0)" ::: "memory");
}

__device__ __forceinline__ void final_norm_phase(float* h, const float* gain, int gw, int NGW, int lane) {
    for (int m = gw; m < MROWS; m += 8 * NGW) {
        f32x4 v[8][4]; float ss[8];
#pragma unroll
        for (int u = 0; u < 8; ++u) { const f32x4* xr = (const f32x4*)(h + (size_t)(m + u * NGW) * DM) + lane;
#pragma unroll
            for (int j = 0; j < 4; ++j) v[u][j] = xr[64 * j]; }
#pragma unroll
        for (int u = 0; u < 8; ++u) { float s = 0.f;
#pragma unroll
            for (int j = 0; j < 4; ++j) s += (v[u][j].x * v[u][j].x + v[u][j].y * v[u][j].y) + (v[u][j].z * v[u][j].z + v[u][j].w * v[u][j].w);
            ss[u] = 1.f / sqrtf(wave_sum(s) * (1.f / DM) + EPSF); }
        const f32x4* gr = (const f32x4*)gain + lane; f32x4 g[4];
#pragma unroll
        for (int j = 0; j < 4; ++j) g[j] = gr[64 * j];
#pragma unroll
        for (int u = 0; u < 8; ++u) { f32x4* o = (f32x4*)(h + (size_t)(m + u * NGW) * DM) + lane; const float rs = ss[u];
#pragma unroll
            for (int j = 0; j < 4; ++j) o[64 * j] = v[u][j] * rs * g[j]; }
    }
}

__device__ __forceinline__ void cast_stats_phase(const float* src, bf16* dst, float* SS, int gw, int NGW, int lane) {
    for (int m = gw; m < MROWS; m += 8 * NGW) {
        f32x4 v[8][4];
#pragma unroll
        for (int u = 0; u < 8; ++u) { const f32x4* xr = (const f32x4*)(src + (size_t)(m + u * NGW) * DM) + lane;
#pragma unroll
            for (int j = 0; j < 4; ++j) v[u][j] = xr[64 * j]; }
#pragma unroll
        for (int u = 0; u < 8; ++u) { float s = 0.f; unsigned long long* o8 = (unsigned long long*)(dst + (size_t)(m + u * NGW) * DM) + lane;
#pragma unroll
            for (int j = 0; j < 4; ++j) { s += (v[u][j].x * v[u][j].x + v[u][j].y * v[u][j].y) + (v[u][j].z * v[u][j].z + v[u][j].w * v[u][j].w);
                o8[64 * j] = (unsigned long long)pk2(v[u][j].x, v[u][j].y) | ((unsigned long long)pk2(v[u][j].z, v[u][j].w) << 32); }
            s = wave_sum(s); if (lane < 16) SS[(size_t)(m + u * NGW) * 16 + lane] = (lane == 0) ? s : 0.f; }
    }
}
__device__ __forceinline__ void p0_prologue(const Args& A, LAS unsigned char* lds, int wave, int lane) {
    unsigned char* ws = A.ws;
    LAS float* scr = (LAS float*)(lds + wave * 16384);
    const int gw = blockIdx.x * NWAVES + wave, NGW = gridDim.x * NWAVES;
    {   constexpr int I_ABIN = 16 * (AB_IN / 32), I_SQ = 16 * 32, I_NSAIN = 16 * (NSA_INP / 32), I_F13 = 16 * (FFH / 32), I_F2 = (FFH / 64) * 32, I_C1 = 32 * 2, I_C2 = 2;
        constexpr int NITEMS = I_ABIN + I_SQ + I_NSAIN + I_SQ + 4 * I_F13 + 2 * I_F2 + 2 * I_C1 + 2 * I_C2;
        P0Desc D0, D1; float ta[32], tb[32]; int it = gw;
        if (it < NITEMS) { p0_decode(A, ws, it, lane, D0); p0_load(D0, ta, lane); }
        while (it < NITEMS) {
            const int it1 = it + NGW; const bool has1 = it1 < NITEMS;
            if (has1) { p0_decode(A, ws, it1, lane, D1); p0_load(D1, tb, lane); }
            p0_store(D0, ta, scr, lane);
            if (!has1) break;
            const int it2 = it1 + NGW; const bool has2 = it2 < NITEMS;
            if (has2) { p0_decode(A, ws, it2, lane, D0); p0_load(D0, ta, lane); }
            p0_store(D1, tb, scr, lane);
            if (!has2) break;
            it = it2; } }
    {   const int gt = blockIdx.x * NTHREADS + threadIdx.x, NT = gridDim.x * NTHREADS;
        float* rc = (float*)(ws + TAB_RCOS); float* rsn = (float*)(ws + TAB_RSIN); float* nc = (float*)(ws + TAB_NCOS); float* ns = (float*)(ws + TAB_NSIN);
        for (int e = gt; e < 4096 * 40; e += NT) {
            const int pos = e / 40, i = e % 40; double inv;
            if (i < 32) inv = exp(-9.210340371976184 * ((double)i / 32.0));
            else inv = exp(-13.122363377404328 * ((double)(i - 32) / 8.0));
            double tr = (double)pos * inv * 0.15915494309189535; tr -= floor(tr);
            const float ft = (float)tr; const float sv = __builtin_amdgcn_sinf(ft), cv = __builtin_amdgcn_cosf(ft);
            if (i < 32) { rc[pos * 32 + i] = cv; rsn[pos * 32 + i] = sv; } else { nc[pos * 8 + (i - 32)] = cv; ns[pos * 8 + (i - 32)] = sv; }
        }
    }
    {   const int gt = blockIdx.x * NTHREADS + threadIdx.x, NT = gridDim.x * NTHREADS; bf16* GW = (bf16*)(ws + W_GATE);
        for (int e = gt; e < 2 * 8 * 4096; e += NT) { const int gate = e >> 15, r = e & 32767, n = r >> 12, jj = (r >> 6) & 63, ii = r & 63;
            GW[e] = (bf16)f2bf(A.in[gate ? I_GX_W : I_GA_W][n * 4096 + ii * 64 + jj]); } }
    for (int it = gw; it < 64; it += NGW) { const int which = it >> 5, ch = it & 31; const float* pe = A.in[which ? I_PE_V : I_PE_K] + ch * 64; const float* w1 = A.in[which ? I_V_W1 : I_K_W1] + (size_t)ch * 64 * 64 + lane;
        float s = 0.f;
#pragma unroll 16
        for (int k = 0; k < 64; ++k) s += pe[k] * w1[k * 64];
        ((float*)(ws + TAB_CB))[128 + it * 64 + lane] = s; }
    cast_stats_phase(A.in[I_X], (bf16*)(ws + WS_XN), (float*)(ws + WS_SS), gw, NGW, lane);
}

__device__ __forceinline__ float fsigm(float x) { return __builtin_amdgcn_rcpf(1.f + __builtin_amdgcn_exp2f(-LOG2E * x)); }
__device__ __forceinline__ void lru_item(const Args& A, LAS unsigned char* lds, int item, int mode) {
    LAS bf16* WT = (LAS bf16*)lds; LAS float* RAW = (LAS float*)(lds + 18432); LAS bf16* XB = (LAS bf16*)(lds + 18432 + 17408); LAS float* G = (LAS float*)(lds + 18432 + 17408 + 9216);
    LAS float* PH = G + 8192; LAS float* CAR = PH + 1024;
    const int tid = threadIdx.x, lane = tid & 63, j = tid & 63, tg = tid >> 6, w = tg, lr = lane & 15, lq = lane >> 4;
    const int b = item >> 7, n = (item >> 4) & 7, seg = item & 15, c = n * 64 + j;
    const bf16* P0 = (const bf16*)(A.ws + WS_PROJ0); bf16* CAT = (bf16*)(A.ws + WS_CAT); float* LS = (float*)(A.ws + WS_LSUM);
    __syncthreads();
    const float gab = A.in[I_GA_B][c], gxb = A.in[I_GX_B][c], lam = A.in[I_LAM][c];
    const float sp8 = 8.f * LOG2E * log1pf(expf(-lam));
    const float cw0 = A.in[I_CONV_W][c], cw1 = A.in[I_CONV_W][512 + c], cw2 = A.in[I_CONV_W][1024 + c], cw3 = A.in[I_CONV_W][1536 + c], cb = A.in[I_CONV_B][c];
    float carry = 0.f, ptot = 1.f;
    if (mode == 1) { float pp[15], hh[15];
#pragma unroll
        for (int s2 = 0; s2 < 15; ++s2) { pp[s2] = 1.f; hh[s2] = 0.f; if (s2 < seg) { const float* q = LS + ((size_t)(b * 16 + s2) * 512 + c) * 2; pp[s2] = q[0]; hh[s2] = q[1]; } }
#pragma unroll
        for (int s2 = 0; s2 < 15; ++s2) carry = pp[s2] * carry + hh[s2]; }
    if (tg == 0) CAR[j] = carry;
    __syncthreads();
    bf16x8 bfr[4][2];
#pragma unroll
    for (int nt = 0; nt < 4; ++nt)
#pragma unroll
        for (int ks = 0; ks < 2; ++ks) bfr[nt][ks] = *(const bf16x8*)((const bf16*)(A.ws + W_GATE) + (size_t)(((w & 1) * 8 + n) * 64 + 16 * nt + lr) * 64 + 32 * ks + 8 * lq);
    const bf16* xrb = P0 + (size_t)(b * SEQ) * AB_IN + 512 + c;
    bf16 rawn[9];
#pragma unroll
    for (int i = 0; i < 9; ++i) { const int r = tg + 8 * i, t = seg * 256 - 3 + r; rawn[i] = (r < 67 && t >= 0) ? xrb[(size_t)t * AB_IN] : (bf16)0; }
    for (int sub = 0; sub < 4; ++sub) {
        const int t0 = seg * 256 + sub * 64;
        bf16 yv[8];
        if (mode == 1) {
#pragma unroll
            for (int q = 0; q < 8; ++q) yv[q] = P0[((size_t)b * SEQ + t0 + tg * 8 + q) * AB_IN + c]; }
#pragma unroll
        for (int i = 0; i < 9; ++i) { const int r = tg + 8 * i; if (r < 67) RAW[r * 64 + j] = bf2f(rawn[i]); }
        if (sub < 3) {
#pragma unroll
            for (int i = 0; i < 9; ++i) { const int r = tg + 8 * i, t = t0 + 64 - 3 + r; rawn[i] = (r < 67) ? xrb[(size_t)t * AB_IN] : (bf16)0; } }
        __syncthreads();
        float xv[8];
#pragma unroll
        for (int q = 0; q < 8; ++q) { const int tt = tg * 8 + q; const float x = cb + cw0 * RAW[tt * 64 + j] + cw1 * RAW[(tt + 1) * 64 + j] + cw2 * RAW[(tt + 2) * 64 + j] + cw3 * RAW[(tt + 3) * 64 + j]; xv[q] = x; XB[tt * 72 + j] = (bf16)f2bf(x); }
        __syncthreads();
        {
            const int mt = w >> 1; bf16x8 af[2];
#pragma unroll
            for (int ks = 0; ks < 2; ++ks) af[ks] = *(const LAS bf16x8*)(XB + (16 * mt + lr) * 72 + 32 * ks + 8 * lq);
            LAS float* Gw = G + (w & 1) * 4096 + (16 * mt + 4 * lq) * 64 + lr;
#pragma unroll
            for (int nt = 0; nt < 4; ++nt) { f32x4 acc = mfma16(af[0], bfr[nt][0], (f32x4){0.f, 0.f, 0.f, 0.f}); acc = mfma16(af[1], bfr[nt][1], acc);
#pragma unroll
                for (int r = 0; r < 4; ++r) Gw[r * 64 + 16 * nt] = acc[r]; } }
        __syncthreads();
        float av[8], uv[8]; float Pl = 1.f, Hl = 0.f;
#pragma unroll
        for (int q = 0; q < 8; ++q) { const int tt = tg * 8 + q; const float r = fsigm(G[tt * 64 + j] + gab), ig = fsigm(G[4096 + tt * 64 + j] + gxb);
            const float a = __builtin_amdgcn_exp2f(-sp8 * r); const float mult = sqrtf(fmaf(-a, a, 1.f));
            av[q] = a; uv[q] = mult * (ig * xv[q]); Hl = a * Hl + uv[q]; Pl *= a; }
        PH[(tg * 64 + j) * 2] = Pl; PH[(tg * 64 + j) * 2 + 1] = Hl;
        __syncthreads();
        float cin = CAR[j];
        {   float pp[7], hh[7];
#pragma unroll
            for (int g2 = 0; g2 < 7; ++g2) { pp[g2] = PH[(g2 * 64 + j) * 2]; hh[g2] = PH[(g2 * 64 + j) * 2 + 1]; }
#pragma unroll
            for (int g2 = 0; g2 < 7; ++g2) if (g2 < tg) cin = pp[g2] * cin + hh[g2]; }
#pragma unroll
        for (int q = 0; q < 8; ++q) { cin = av[q] * cin + uv[q];
            if (mode == 1) { const size_t row = (size_t)b * SEQ + t0 + tg * 8 + q; const float y = bf2f(yv[q]); const float u = 0.7978845608028654f * (y + 0.044715f * y * y * y);
                CAT[row * DM + c] = (bf16)f2bf(cin * y * fsigm(2.f * u)); } }
        __syncthreads();
        if (tg == 7) { CAR[j] = cin; if (mode == 0) { float pt = 1.f;
#pragma unroll
                for (int g2 = 0; g2 < 8; ++g2) pt *= PH[(g2 * 64 + j) * 2]; ptot *= pt; } }
    }
    if (mode == 0 && tg == 7) { float* q = LS + ((size_t)(b * 16 + seg) * 512 + c) * 2; q[0] = ptot; q[1] = CAR[j]; }
}

__device__ __forceinline__ float ret_log_g(int h) { return log1pf(-exp2f(-5.f - (float)h)); }
__device__ __forceinline__ void ret_kv_load(const bf16* P0, int item, int tid, v4u (&kraw)[2], v4u (&vraw)[2]) {
    const int b = item >> 8, h = (item >> 5) & 7, m = item & 31; const size_t row0 = (size_t)b * SEQ + m * 128;
#pragma unroll
    for (int rep = 0; rep < 2; ++rep) { const bf16* rp = P0 + (row0 + (tid >> 3) + 64 * rep) * AB_IN + h * 64 + 8 * (tid & 7); kraw[rep] = *(const v4u*)(rp + 1536); vraw[rep] = *(const v4u*)(rp + 2048); }
}
__device__ __forceinline__ void ret_kv_run(const Args& A, LAS unsigned char* lds, int first, int stride, int end) {
    LAS bf16* VT = (LAS bf16*)lds; LAS bf16* KT = VT + 64 * 136;
    const int tid = threadIdx.x, lane = tid & 63, w = tid >> 6, lr = lane & 15, lq = lane >> 4;
    const bf16* P0 = (const bf16*)(A.ws + WS_PROJ0); float* KVT = (float*)(A.ws + WS_KVT);
    v4u kraw[2], vraw[2];
    if (first < end) ret_kv_load(P0, first, tid, kraw, vraw);
    for (int item = first; item < end; item += stride) {
        const int b = item >> 8, h = (item >> 5) & 7, m = item & 31; const float l2g = ret_log_g(h) * LOG2E;
        __syncthreads();
#pragma unroll
        for (int rep = 0; rep < 2; ++rep) { const int jj = (tid >> 3) + 64 * rep, e8 = tid & 7; const float dec = __builtin_amdgcn_exp2f((float)(127 - jj) * l2g);
            const unsigned kw[4] = {kraw[rep].x, kraw[rep].y, kraw[rep].z, kraw[rep].w}, vw[4] = {vraw[rep].x, vraw[rep].y, vraw[rep].z, vraw[rep].w};
#pragma unroll
            for (int i = 0; i < 4; ++i) { VT[(8 * e8 + 2 * i) * 136 + jj] = (bf16)(vw[i] & 0xffffu); VT[(8 * e8 + 2 * i + 1) * 136 + jj] = (bf16)(vw[i] >> 16);
                KT[(8 * e8 + 2 * i) * 136 + jj] = (bf16)f2bf(bf2f((bf16)(kw[i] & 0xffffu)) * dec); KT[(8 * e8 + 2 * i + 1) * 136 + jj] = (bf16)f2bf(bf2f((bf16)(kw[i] >> 16)) * dec); } }
        if (item + stride < end) ret_kv_load(P0, item + stride, tid, kraw, vraw);
        __syncthreads();
        const int et = w >> 1, dt0 = (w & 1) * 2; f32x4 acc[2] = {(f32x4){0.f, 0.f, 0.f, 0.f}, (f32x4){0.f, 0.f, 0.f, 0.f}};
#pragma unroll
        for (int ks = 0; ks < 4; ++ks) { const bf16x8 af = *(const LAS bf16x8*)(VT + (16 * et + lr) * 136 + 32 * ks + 8 * lq);
#pragma unroll
            for (int dd = 0; dd < 2; ++dd) { const bf16x8 bfr = *(const LAS bf16x8*)(KT + (16 * (dt0 + dd) + lr) * 136 + 32 * ks + 8 * lq); acc[dd] = mfma16(af, bfr, acc[dd]); } }
        float* o = KVT + ((size_t)((b * 8 + h) * 32 + m)) * 4096;
#pragma unroll
        for (int dd = 0; dd < 2; ++dd)
#pragma unroll
            for (int r = 0; r < 4; ++r) o[(16 * et + 4 * lq + r) * 64 + 16 * (dt0 + dd) + lr] = acc[dd][r];
    }
}
constexpr int VT_LD = 136, ST_LD = 72, PW_LD = 72;
struct RetPre { v4u vraw[2]; f32x4 ka, kc; };
__device__ __forceinline__ void ret_out_pre(const Args& A, int item, bool first, RetPre& R) {
    const int tid = threadIdx.x, b = item >> 8, h = (item >> 5) & 7, n = item & 31; const bf16* P0 = (const bf16*)(A.ws + WS_PROJ0); const float* KVT = (const float*)(A.ws + WS_KVT); const size_t row0 = (size_t)b * SEQ + n * 128;
#pragma unroll
    for (int rep = 0; rep < 2; ++rep) R.vraw[rep] = *(const v4u*)(P0 + (row0 + (tid >> 3) + 64 * rep) * AB_IN + 2048 + h * 64 + 8 * (tid & 7));
    const float* kp = KVT + ((size_t)((b * 8 + h) * 32)) * 4096 + tid * 8; R.ka = (f32x4){0.f, 0.f, 0.f, 0.f}; R.kc = R.ka;
    if (!first) { R.ka = *(const f32x4*)(kp + (size_t)(n - 1) * 4096); R.kc = *(const f32x4*)(kp + (size_t)(n - 1) * 4096 + 4); }
}
__device__ __forceinline__ void ret_out_item(const Args& A, LAS unsigned char* lds, int item, bool first, RetPre& R, int next_item, bool next_first) {
    LAS bf16* VT = (LAS bf16*)lds;
    LAS bf16* STT = VT + 64 * VT_LD;
    LAS bf16* PWall = STT + 64 * ST_LD;
    const int tid = threadIdx.x, lane = tid & 63, w = tid >> 6, lr = lane & 15, lq = lane >> 4, b = item >> 8, h = (item >> 5) & 7, n = item & 31;
    const bf16* P0 = (const bf16*)(A.ws + WS_PROJ0); const float* KVT = (const float*)(A.ws + WS_KVT); bf16* CAT = (bf16*)(A.ws + WS_CAT);
    const float lg = ret_log_g(h), l2g = lg * LOG2E;
    const size_t row0 = (size_t)b * SEQ + n * 128;
    const v4u vraw[2] = {R.vraw[0], R.vraw[1]}; const f32x4 ka = R.ka, kc = R.kc;
    const float* kp = KVT + ((size_t)((b * 8 + h) * 32)) * 4096 + tid * 8;
    bf16x8 qa[2], kf[2][4][2];
#pragma unroll
    for (int ks = 0; ks < 2; ++ks) qa[ks] = *(const bf16x8*)(P0 + (row0 + 16 * w + lr) * AB_IN + 1024 + h * 64 + 32 * ks + 8 * lq);
    const int ntile = (w >= 4) ? 2 : 1;
#pragma unroll
    for (int jt = 0; jt < 2; ++jt) if (jt < ntile) {
#pragma unroll
        for (int nt = 0; nt < 4; ++nt) { const bf16* kq = P0 + (row0 + 64 * jt + 16 * nt + lr) * AB_IN + 1536 + h * 64 + 8 * lq; kf[jt][nt][0] = *(const bf16x8*)kq; kf[jt][nt][1] = *(const bf16x8*)(kq + 32); } }
    bf16 gv[4][4];
#pragma unroll
    for (int r = 0; r < 4; ++r)
#pragma unroll
        for (int ct = 0; ct < 4; ++ct) gv[r][ct] = P0[(row0 + 16 * w + lq * 4 + r) * AB_IN + 2560 + h * 64 + 16 * ct + lr];
    __syncthreads();
#pragma unroll
    for (int rep = 0; rep < 2; ++rep) { const int jj = (tid >> 3) + 64 * rep, e8 = tid & 7; const unsigned wv[4] = {vraw[rep].x, vraw[rep].y, vraw[rep].z, vraw[rep].w};
#pragma unroll
        for (int i = 0; i < 4; ++i) { VT[(8 * e8 + 2 * i) * VT_LD + jj] = (bf16)(wv[i] & 0xffffu); VT[(8 * e8 + 2 * i + 1) * VT_LD + jj] = (bf16)(wv[i] >> 16); } }
    {   LAS float* SF = (LAS float*)(PWall + 8 * 16 * PW_LD);
        float st[8]; const float cd = expf(128.f * lg);
        if (first) {
#pragma unroll
            for (int i = 0; i < 8; ++i) st[i] = 0.f;
            int m = 0;
            for (; m + 4 <= n; m += 4) { f32x4 a[4], c[4];
#pragma unroll
                for (int u = 0; u < 4; ++u) { a[u] = *(const f32x4*)(kp + (size_t)(m + u) * 4096); c[u] = *(const f32x4*)(kp + (size_t)(m + u) * 4096 + 4); }
#pragma unroll
                for (int u = 0; u < 4; ++u) { st[0] = st[0] * cd + a[u].x; st[1] = st[1] * cd + a[u].y; st[2] = st[2] * cd + a[u].z; st[3] = st[3] * cd + a[u].w; st[4] = st[4] * cd + c[u].x; st[5] = st[5] * cd + c[u].y; st[6] = st[6] * cd + c[u].z; st[7] = st[7] * cd + c[u].w; } }
            for (; m < n; ++m) { const f32x4 a = *(const f32x4*)(kp + (size_t)m * 4096), c = *(const f32x4*)(kp + (size_t)m * 4096 + 4);
                st[0] = st[0] * cd + a.x; st[1] = st[1] * cd + a.y; st[2] = st[2] * cd + a.z; st[3] = st[3] * cd + a.w; st[4] = st[4] * cd + c.x; st[5] = st[5] * cd + c.y; st[6] = st[6] * cd + c.z; st[7] = st[7] * cd + c.w; }
        } else {
            const f32x4 p0 = *(const LAS f32x4*)(SF + tid * 8), p1 = *(const LAS f32x4*)(SF + tid * 8 + 4);
            st[0] = p0.x * cd + ka.x; st[1] = p0.y * cd + ka.y; st[2] = p0.z * cd + ka.z; st[3] = p0.w * cd + ka.w; st[4] = p1.x * cd + kc.x; st[5] = p1.y * cd + kc.y; st[6] = p1.z * cd + kc.z; st[7] = p1.w * cd + kc.w; }
        *(LAS f32x4*)(SF + tid * 8) = (f32x4){st[0], st[1], st[2], st[3]}; *(LAS f32x4*)(SF + tid * 8 + 4) = (f32x4){st[4], st[5], st[6], st[7]};
        const int e = tid >> 3, d0 = (tid & 7) * 8; v4u o; o.x = pk2(st[0], st[1]); o.y = pk2(st[2], st[3]); o.z = pk2(st[4], st[5]); o.w = pk2(st[6], st[7]);
        *(LAS v4u*)(STT + e * ST_LD + d0) = o; }
    __syncthreads();
    if (next_item >= 0) ret_out_pre(A, next_item, next_first, R);
    LAS bf16* PW = PWall + w * 16 * PW_LD;
    f32x4 O1[4], O2[4];
#pragma unroll
    for (int ct = 0; ct < 4; ++ct) { O1[ct] = (f32x4){0.f, 0.f, 0.f, 0.f}; O2[ct] = (f32x4){0.f, 0.f, 0.f, 0.f}; }
#pragma unroll
    for (int jt = 0; jt < 2; ++jt) if (jt < ntile) {
        f32x4 s[4];
#pragma unroll
        for (int nt = 0; nt < 4; ++nt) { s[nt] = mfma16(qa[0], kf[jt][nt][0], (f32x4){0.f, 0.f, 0.f, 0.f}); s[nt] = mfma16(qa[1], kf[jt][nt][1], s[nt]); }
#pragma unroll
        for (int nt = 0; nt < 4; ++nt)
#pragma unroll
            for (int r = 0; r < 4; ++r) { const int i = 16 * w + lq * 4 + r, jj = 64 * jt + 16 * nt + lr, dd = i - jj;
                const float p = (dd >= 0) ? s[nt][r] * __builtin_amdgcn_exp2f((float)dd * l2g) : 0.f; PW[(lq * 4 + r) * PW_LD + 16 * nt + lr] = (bf16)f2bf(p); }
        bf16x8 pa[2];
#pragma unroll
        for (int ks = 0; ks < 2; ++ks) pa[ks] = *(const LAS bf16x8*)(PW + lr * PW_LD + 32 * ks + 8 * lq);
#pragma unroll
        for (int ct = 0; ct < 4; ++ct)
#pragma unroll
            for (int ks = 0; ks < 2; ++ks) { const bf16x8 vb = *(const LAS bf16x8*)(VT + (16 * ct + lr) * VT_LD + 64 * jt + 32 * ks + 8 * lq); O1[ct] = mfma16(pa[ks], vb, O1[ct]); }
    }
#pragma unroll
    for (int ct = 0; ct < 4; ++ct)
#pragma unroll
        for (int ks = 0; ks < 2; ++ks) { const bf16x8 sb = *(const LAS bf16x8*)(STT + (16 * ct + lr) * ST_LD + 32 * ks + 8 * lq); O2[ct] = mfma16(qa[ks], sb, O2[ct]); }
#pragma unroll
    for (int r = 0; r < 4; ++r) { const int i = 16 * w + lq * 4 + r; const float qd = __builtin_amdgcn_exp2f((float)(i + 1) * l2g);
        float o[4]; float sm = 0.f;
#pragma unroll
        for (int ct = 0; ct < 4; ++ct) { o[ct] = O1[ct][r] + qd * O2[ct][r]; sm += o[ct]; }
        const float mean = gsum16(sm) * (1.f / 64.f); float vs = 0.f;
#pragma unroll
        for (int ct = 0; ct < 4; ++ct) { o[ct] -= mean; vs += o[ct] * o[ct]; }
        const float rstd = 1.f / sqrtf(gsum16(vs) * (1.f / 64.f) + EPSF);
        const size_t row = row0 + i;
#pragma unroll
        for (int ct = 0; ct < 4; ++ct) { const int e = 16 * ct + lr; const float g = bf2f(gv[r][ct]); CAT[row * DM + 512 + h * 64 + e] = (bf16)f2bf(o[ct] * rstd * (g * sigm(g))); } }
}
__device__ __forceinline__ void cmp_bias_to_lds(const Args& A, LAS unsigned char* lds) {
    const float* CB = (const float*)(A.ws + TAB_CB); const int tid = threadIdx.x;
    if (tid < 128) { float s = 0.f;
#pragma unroll
        for (int ch = 0; ch < 32; ++ch) s += CB[128 + ((tid >> 6) * 32 + ch) * 64 + (tid & 63)];
        ((LAS float*)(lds + 40960))[tid] = s; }
    __syncthreads();
}
__device__ __forceinline__ void cmp_item(const Args& A, LAS unsigned char* lds, int item) {
    LAS float* RED = (LAS float*)lds; LAS bf16* HID = (LAS bf16*)(lds + 32768);
    const int tid = threadIdx.x, lane = tid & 63, w = tid >> 6, lr = lane & 15, lq = lane >> 4;
    const int cgrp = item & 3, kv = (item >> 2) & 1, g = (item >> 3) & 3, b = item >> 5;
    const bf16* W1T = (const bf16*)(A.ws + (kv ? W_CV1 : W_CK1)); const bf16* W2T = (const bf16*)(A.ws + (kv ? W_CV2 : W_CK2)); const bf16* KV6 = (const bf16*)(A.ws + WS_KV6);
    bf16* KC = (bf16*)(A.ws + WS_KC); bf16* VCT = (bf16*)(A.ws + WS_VCT); const float* NC = (const float*)(A.ws + TAB_NCOS); const float* NS = (const float*)(A.ws + TAB_NSIN);
    bf16x8 bw[4][2][4];
#pragma unroll
    for (int lt = 0; lt < 4; ++lt)
#pragma unroll
        for (int ks = 0; ks < 2; ++ks)
#pragma unroll
            for (int nt = 0; nt < 4; ++nt) bw[lt][ks][nt] = *(const bf16x8*)(W1T + (size_t)(16 * nt + lr) * 2048 + (4 * w + lt) * 64 + 32 * ks + 8 * lq);
    bf16x8 w2f[2] = {(bf16x8){0, 0, 0, 0, 0, 0, 0, 0}, (bf16x8){0, 0, 0, 0, 0, 0, 0, 0}};
    if (w < 4) {
#pragma unroll
        for (int ks = 0; ks < 2; ++ks) w2f[ks] = *(const bf16x8*)(W2T + (16 * w + lr) * 64 + 32 * ks + 8 * lq); }
    bf16x8 af[4][2];
#define CMP_LOADA(ct_) do { const int c_ = 16 * (ct_) + lr; _Pragma("unroll") for (int lt = 0; lt < 4; ++lt) { int tok = 16 * c_ + 4 * w + lt; tok = tok > SEQ - 1 ? SEQ - 1 : tok; \
        const bf16* arow = KV6 + ((size_t)b * SEQ + tok) * 1536 + kv * 256 + g * 64; _Pragma("unroll") for (int ks = 0; ks < 2; ++ks) af[lt][ks] = *(const bf16x8*)(arow + 32 * ks + 8 * lq); } } while (0)
    CMP_LOADA(4 * cgrp);
    for (int ti = 0; ti < 4; ++ti) { const int ctile = 4 * cgrp + ti;
        f32x4 acc[4];
#pragma unroll
        for (int nt = 0; nt < 4; ++nt) acc[nt] = (f32x4){0.f, 0.f, 0.f, 0.f};
#pragma unroll
        for (int lt = 0; lt < 4; ++lt)
#pragma unroll
            for (int ks = 0; ks < 2; ++ks)
#pragma unroll
                for (int nt = 0; nt < 4; ++nt) acc[nt] = mfma16(af[lt][ks], bw[lt][ks][nt], acc[nt]);
        __syncthreads();
        if (ti < 3) CMP_LOADA(ctile + 1);
#pragma unroll
        for (int nt = 0; nt < 4; ++nt)
#pragma unroll
            for (int r = 0; r < 4; ++r) RED[(w * 16 + lq * 4 + r) * 64 + 16 * nt + lr] = acc[nt][r];
        __syncthreads();
#pragma unroll
        for (int rep = 0; rep < 2; ++rep) { const int e = tid + rep * NTHREADS, row = e >> 6, col = e & 63; float s = ((const LAS float*)(lds + 40960))[kv * 64 + col];
#pragma unroll
            for (int w2 = 0; w2 < 8; ++w2) s += RED[(w2 * 16 + row) * 64 + col];
            HID[row * 72 + col] = (bf16)f2bf(gelu_tanh(s)); }
        __syncthreads();
        if (w < 4) {
            f32x4 o = (f32x4){0.f, 0.f, 0.f, 0.f};
#pragma unroll
            for (int ks = 0; ks < 2; ++ks) { const bf16x8 a = *(const LAS bf16x8*)(HID + lr * 72 + 32 * ks + 8 * lq); o = mfma16(a, w2f[ks], o); }
#pragma unroll
            for (int r = 0; r < 4; ++r) { const int cc = 16 * ctile + lq * 4 + r, dim = 16 * w + lr; float val = o[r];
                if (kv == 0) {
                    if (w == 0) { const float partner = DPPF(val, 0x128);   int pos = 16 * cc + 31; pos = pos > SEQ - 1 ? SEQ - 1 : pos; const int f = lr & 7; const float cs = NC[pos * 8 + f], sn = NS[pos * 8 + f];
                        val = (lr < 8) ? (val * cs - partner * sn) : (val * cs + partner * sn); }
                    KC[((size_t)(b * 256 + cc) * 4 + g) * 64 + dim] = (bf16)f2bf(val);
                } else VCT[((size_t)(b * 4 + g) * 64 + dim) * 256 + cc] = (bf16)f2bf(val); }
        }
    }
#undef CMP_LOADA
}
typedef float f32x2 __attribute__((ext_vector_type(2))); typedef __bf16 bf16x2_t __attribute__((ext_vector_type(2)));
__device__ __forceinline__ unsigned cvtpk(float lo, float hi) { f32x2 v = {lo, hi}; bf16x2_t b = __builtin_convertvector(v, bf16x2_t); return __builtin_bit_cast(unsigned, b); }
__device__ __forceinline__ float vmax3(float a, float b, float c) { float r; asm("v_max3_f32 %0, %1, %2, %3" : "=v"(r) : "v"(a), "v"(b), "v"(c)); return r; }
__device__ __forceinline__ float vmax2(float a, float b) { float r; asm("v_max_f32_e32 %0, %1, %2" : "=v"(r) : "v"(a), "v"(b)); return r; }
__device__ __forceinline__ float colmax4(float v) {
    auto a = __builtin_amdgcn_permlane16_swap(__float_as_uint(v), __float_as_uint(v), false, false); v = vmax2(__uint_as_float(a[0]), __uint_as_float(a[1]));
    auto c = __builtin_amdgcn_permlane32_swap(__float_as_uint(v), __float_as_uint(v), false, false); return vmax2(__uint_as_float(c[0]), __uint_as_float(c[1])); }
__device__ __forceinline__ float colsum4(float v) { return rows4_sum(v); }
struct NsaSt { float mhat[2], l[2], invl[2]; f32x4 O[4][2]; };
template <int MODE>
__device__ __forceinline__ void nsa_softmax(NsaSt& S, f32x4 (&st)[4], const int nq, const int klo, const int khi, const bool colok, const int kb, LAS float* PSrow, const int lr, const int lq, bf16x8& p0, bf16x8& p1) {
    if (MODE <= 2) {
        const unsigned span = (khi >= klo) ? (unsigned)(khi - klo) : 0u; const int base = (khi >= klo) ? kb - klo : -0x40000000;
#pragma unroll
        for (int mt = 0; mt < 4; ++mt)
#pragma unroll
            for (int r = 0; r < 4; ++r) { const bool ok = (unsigned)(base + 32 * (mt >> 1) + 4 * (mt & 1) + r) <= span; st[mt][r] = ok ? st[mt][r] : NEGF; } }
    if (MODE != 1) {
        float a = st[0][0];
        asm volatile("s_nop 15\n\ts_nop 1\n\tv_max3_f32 %0, %0, %1, %2\n\tv_max3_f32 %0, %0, %3, %4\n\tv_max3_f32 %0, %0, %5, %6\n\tv_max3_f32 %0, %0, %7, %8\n\tv_max3_f32 %0, %0, %9, %10\n\tv_max3_f32 %0, %0, %11, %12\n\tv_max3_f32 %0, %0, %13, %14\n\tv_max_f32_e32 %0, %0, %15"
                     : "+v"(a) : "v"(st[0][1]), "v"(st[0][2]), "v"(st[0][3]), "v"(st[1][0]), "v"(st[1][1]), "v"(st[1][2]), "v"(st[1][3]), "v"(st[2][0]), "v"(st[2][1]), "v"(st[2][2]),
                       "v"(st[2][3]), "v"(st[3][0]), "v"(st[3][1]), "v"(st[3][2]), "v"(st[3][3]));
        a = colok ? a : NEGF; const float tmax = colmax4(a);
        if (__any(tmax > 8.f)) { const float dl = (tmax > 8.f) ? tmax : 0.f, f = __builtin_amdgcn_exp2f(-dl); S.mhat[nq] += dl; S.l[nq] *= f;
#pragma unroll
            for (int mt = 0; mt < 4; ++mt) st[mt] -= dl;
            if (MODE >= 2) {
#pragma unroll
                for (int ct = 0; ct < 4; ++ct) S.O[ct][nq] *= f; } }
    }
#pragma unroll
    for (int mt = 0; mt < 4; ++mt)
#pragma unroll
        for (int r = 0; r < 4; ++r) st[mt][r] = __builtin_amdgcn_exp2f(st[mt][r]);
    if (MODE == 1) {
#pragma unroll
        for (int mt = 0; mt < 4; ++mt) st[mt] *= S.invl[nq];
#pragma unroll
        for (int mt = 0; mt < 4; ++mt) { f32x4 hs = st[mt];
#pragma unroll
            for (int r = 0; r < 4; ++r) hs[r] = qsum4(hs[r]);
            if ((lr & 3) == 0) *(LAS f32x4*)(PSrow + (4 * nq + (lr >> 2)) * 256 + 32 * (mt >> 1) + 4 * (mt & 1) + 8 * lq) = hs; }
    } else { f32x2 a2 = (f32x2){st[0][0], st[0][1]} + (f32x2){st[0][2], st[0][3]};
#pragma unroll
        for (int mt = 1; mt < 4; ++mt) { a2 += (f32x2){st[mt][0], st[mt][1]}; a2 += (f32x2){st[mt][2], st[mt][3]}; }
        const float ls = a2.x + a2.y; S.l[nq] += colok ? ls : 0.f; }
    if (MODE >= 1) {
#pragma unroll
        for (int kk = 0; kk < 2; ++kk) { const f32x4 a = st[2 * kk], c = st[2 * kk + 1]; v4u pk; pk.x = cvtpk(a[0], a[1]); pk.y = cvtpk(a[2], a[3]); pk.z = cvtpk(c[0], c[1]); pk.w = cvtpk(c[2], c[3]);
            if (MODE >= 2 && !colok) pk = (v4u){0u, 0u, 0u, 0u};
            if (kk == 0) p0 = __builtin_bit_cast(bf16x8, pk); else p1 = __builtin_bit_cast(bf16x8, pk); } }
}
template <int MODE>
__device__ __forceinline__ void nsa_full(NsaSt& S, const bf16x8 (&qf)[2][2], const LAS unsigned char* kbuf, const int koff, const int voff, const int klo0, const int klo1, const int khi0, const int khi1, const bool col0, const bool col1,
                                          const int kb, LAS float* PSrow, const int lr, const int lq) {
    bf16x8 kf[4][2];
#pragma unroll
    for (int mt = 0; mt < 4; ++mt) { kf[mt][0] = *(const LAS bf16x8*)(kbuf + 4096 * (mt >> 1) + 512 * (mt & 1) + koff); kf[mt][1] = *(const LAS bf16x8*)(kbuf + 4096 * (mt >> 1) + 512 * (mt & 1) + (koff ^ 64)); }
    f32x4 st0[4], st1[4];
    {   const float n0 = -S.mhat[0], n1 = -S.mhat[1]; const f32x4 negm0 = (f32x4){n0, n0, n0, n0}, negm1 = (f32x4){n1, n1, n1, n1};
#pragma unroll
        for (int mt = 0; mt < 4; ++mt) st0[mt] = mfma16(kf[mt][0], qf[0][0], negm0);
#pragma unroll
        for (int mt = 0; mt < 4; ++mt) st0[mt] = mfma16(kf[mt][1], qf[0][1], st0[mt]);
#pragma unroll
        for (int mt = 0; mt < 4; ++mt) st1[mt] = mfma16(kf[mt][0], qf[1][0], negm1);
#pragma unroll
        for (int mt = 0; mt < 4; ++mt) st1[mt] = mfma16(kf[mt][1], qf[1][1], st1[mt]); }
    __builtin_amdgcn_sched_barrier(0);
    bf16x8 p0, p1; bf16x8 vf[4][2];
    nsa_softmax<MODE>(S, st0, 0, klo0, khi0, col0, kb, PSrow, lr, lq, p0, p1);
    if (MODE >= 1) {
        const LAS unsigned char* vbuf = kbuf + 8192;
#pragma unroll
        for (int ct = 0; ct < 4; ++ct)
#pragma unroll
            for (int kk = 0; kk < 2; ++kk) vf[ct][kk] = *(const LAS bf16x8*)(vbuf + 2048 * ct + (voff ^ (64 * kk)));
#pragma unroll
        for (int ct = 0; ct < 4; ++ct) { S.O[ct][0] = mfma16(vf[ct][0], p0, S.O[ct][0]); S.O[ct][0] = mfma16(vf[ct][1], p1, S.O[ct][0]); } }
    __builtin_amdgcn_sched_barrier(0);
    nsa_softmax<MODE>(S, st1, 1, klo1, khi1, col1, kb, PSrow, lr, lq, p0, p1);
    if (MODE >= 1) {
#pragma unroll
        for (int ct = 0; ct < 4; ++ct) { S.O[ct][1] = mfma16(vf[ct][0], p0, S.O[ct][1]); S.O[ct][1] = mfma16(vf[ct][1], p1, S.O[ct][1]); } }
}
__device__ __forceinline__ void nsa_item2(const Args& A, LAS unsigned char* lds, int item) {
    const int tid = threadIdx.x, lane = tid & 63, w = tid >> 6, lr = lane & 15, lq = lane >> 4;
    const int qt = item >> 5, b = (item >> 2) & 7, g = item & 3, t0 = qt * 64, cur = qt;
    const bf16* Qb = (const bf16*)(A.ws + WS_Q); const bf16* KV6 = (const bf16*)(A.ws + WS_KV6); const bf16* KC = (const bf16*)(A.ws + WS_KC); const bf16* VCT = (const bf16*)(A.ws + WS_VCT);
    const bf16* VTS = (const bf16*)(A.ws + WS_VTS); const bf16* VTW = (const bf16*)(A.ws + WS_VTW); const float* GT = (const float*)(A.ws + WS_GATES); bf16* ATT = (bf16*)(A.ws + WS_CAT);
    LAS float* PS = (LAS float*)(lds + 65536) + w * 2048;
    const int head = 4 * g + (lr & 3);
#define NSA_QPOS(nq_) (t0 + 8 * w + 4 * (nq_) + (lr >> 2))
    bf16x8 qf[2][2]; float gtv[2][3];
#pragma unroll
    for (int nq = 0; nq < 2; ++nq) { const size_t row = (size_t)b * SEQ + NSA_QPOS(nq);
#pragma unroll
        for (int ks = 0; ks < 2; ++ks) qf[nq][ks] = *(const bf16x8*)(Qb + row * 1024 + head * 64 + 32 * ks + 8 * lq);
#pragma unroll
        for (int i = 0; i < 3; ++i) gtv[nq][i] = GT[row * 48 + head * 3 + i]; }
    const int ncv = ((t0 + 63 - 31) >> 4) + 1, ncmp = (ncv + 63) >> 6;
    const int lo = cur >= 8 ? cur - 8 : 0;
    const int n1 = ncmp, n2 = 2 * ncmp, n3 = n2 + cur + 1, n4 = n3 + (cur - lo + 1);
    const int srow = 8 * w + (lane >> 3), schv = (lane & 7) ^ ((srow >> 1) & 7), schk = (lane & 7) ^ (((srow & 3) >> 1) | (((srow >> 3) & 3) << 1));
    const bf16* kcb = KC + ((size_t)(b * 256) * 4 + g) * 64; const bf16* vcb = VCT + (size_t)((b * 4 + g) * 64) * 256;
    const bf16* ksb = KV6 + (size_t)b * SEQ * 1536 + 2 * 256 + g * 64; const bf16* kwb = ksb + 2 * 256;
    const bf16* vsb = VTS + (size_t)((b * 4 + g) * 64) * SEQ; const bf16* vwb = VTW + (size_t)((b * 4 + g) * 64) * SEQ;
    const unsigned sk16 = (unsigned)schk * 16u, sv16 = (unsigned)schv * 16u, srw = (unsigned)srow;
    const unsigned lds0 = (unsigned)(unsigned long)lds + (unsigned)w * 1024u;
#define NSA_GATE(nq_, i_) (gtv[nq_][i_])
#define NSA_GLDS(gp_, vo_, la_) do { unsigned keep_; asm volatile("s_mov_b32 %0, m0\n\ts_mov_b32 m0, %3\n\ts_nop 0\n\tglobal_load_lds_dwordx4 %1, %2\n\ts_mov_b32 m0, %0" : "=&s"(keep_) : "v"(vo_), "s"(gp_), "s"(la_) : "memory"); } while (0)
#define NSA_ISSUE(s_) do { const int s__ = (s_); const bf16* kp_; const bf16* vp_; unsigned ko_, vo_; \
        if (s__ < n2) { const int kt_ = s__ < n1 ? s__ : s__ - n1; kp_ = kcb + (size_t)(64 * kt_) * 256; vp_ = vcb + 64 * kt_; ko_ = srw * 512u + sk16; vo_ = srw * 512u + sv16; } \
        else if (s__ < n3) { const int kt_ = s__ - n2; kp_ = ksb + (size_t)(64 * kt_) * 1536; vp_ = vsb + 64 * kt_; ko_ = srw * 3072u + sk16; vo_ = srw * 8192u + sv16; } \
        else { const int kt_ = lo + s__ - n3; kp_ = kwb + (size_t)(64 * kt_) * 1536; vp_ = vwb + 64 * kt_; ko_ = srw * 3072u + sk16; vo_ = srw * 8192u + sv16; } \
        const unsigned la_ = (unsigned)__builtin_amdgcn_readfirstlane(lds0 + (unsigned)(s__ & 3) * 16384u); NSA_GLDS(kp_, ko_, la_); NSA_GLDS(vp_, vo_, la_ + 8192u); } while (0)
#define NSA_WAITBAR(N) asm volatile("s_waitcnt vmcnt(" #N ") lgkmcnt(0)\n\ts_barrier" ::: "memory")
    asm volatile("s_waitcnt vmcnt(0)" ::: "memory");
    __syncthreads();
#pragma unroll
    for (int i = 0; i < 8; ++i) *(LAS f32x4*)(PS + (i * 64 + lane) * 4) = (f32x4){0.f, 0.f, 0.f, 0.f};
    NSA_ISSUE(0); NSA_ISSUE(1); NSA_ISSUE(2);
    NsaSt S;
    LAS f32x4* OUTL = (LAS f32x4*)PS + lane;
#pragma unroll
    for (int nq = 0; nq < 2; ++nq) { S.mhat[nq] = 0.f; S.l[nq] = 0.f; S.invl[nq] = 0.f;
#pragma unroll
        for (int ct = 0; ct < 4; ++ct) S.O[ct][nq] = (f32x4){0.f, 0.f, 0.f, 0.f}; }
    unsigned long long mym[2] = {0ull, 0ull};
#pragma unroll
    for (int nq = 0; nq < 2; ++nq)
#pragma unroll
        for (int ks = 0; ks < 2; ++ks) asm volatile("" : "+v"(qf[nq][ks]));
#pragma unroll
    for (int nq = 0; nq < 2; ++nq)
#pragma unroll
        for (int i = 0; i < 3; ++i) asm volatile("" : "+v"(gtv[nq][i]));
    NSA_WAITBAR(4);
    const int xk = ((lr & 3) >> 1) | ((lr >> 2) << 1), xv = (lr >> 1) & 7;
    const int koff = (8 * (lr >> 2) + (lr & 3)) * 128 + ((lq ^ xk) << 4);
    const int voff = lr * 128 + ((lq ^ xv) << 4);
#define NSA_ENDWAIT(s_) do { if ((s_) + 3 < n4) NSA_WAITBAR(4); else if ((s_) + 2 < n4) NSA_WAITBAR(2); else NSA_WAITBAR(0); } while (0)
#define NSA_STEP(MODE_, s_, kt_, PSrow_) do { const int s__s = (s_), kt__ = (kt_); const LAS unsigned char* kbuf = lds + (s__s & 3) * 16384; const int kb = 64 * kt__ + 8 * lq; \
        int klo0, klo1, khi0, khi1; bool col0 = true, col1 = true; { const int qp0 = NSA_QPOS(0), qp1 = NSA_QPOS(1); \
            if (MODE_ < 2) { klo0 = 0; klo1 = 0; khi0 = (qp0 >= 31) ? ((qp0 - 31) >> 4) : -1; khi1 = (qp1 >= 31) ? ((qp1 - 31) >> 4) : -1; } \
            else if (s__s < n3) { col0 = (mym[0] >> kt__) & 1ull; col1 = (mym[1] >> kt__) & 1ull; klo0 = 0; klo1 = 0; khi0 = qp0; khi1 = qp1; } \
            else { klo0 = qp0 - 511; klo1 = qp1 - 511; khi0 = qp0; khi1 = qp1; } } \
        if (s__s + 3 < n4) NSA_ISSUE(s__s + 3); \
        nsa_full<MODE_>(S, qf, kbuf, koff, voff, klo0, klo1, khi0, khi1, col0, col1, kb, (PSrow_), lr, lq); \
        NSA_ENDWAIT(s__s); } while (0)
    for (int s = 0; s < n1; ++s) NSA_STEP(0, s, s, PS);
#pragma unroll
    for (int nq = 0; nq < 2; ++nq) { const float lf = colsum4(S.l[nq]); S.invl[nq] = lf > 0.f ? 1.f / lf : 0.f; }
    for (int s = n1; s < n2; ++s) NSA_STEP(1, s, s - n1, PS + 64 * (s - n1));
    {
        unsigned uk[8], pref[8];
#pragma unroll
        for (int qi = 0; qi < 8; ++qi) { const int j = lane, qp = t0 + 8 * w + qi; const LAS float* base = PS + qi * 256;
            float imp = base[4 * j] + base[4 * j + 1] + base[4 * j + 2] + 0.5f * base[4 * j + 3]; if (j > 0) imp += 0.5f * base[4 * j - 1];
            const bool forced = (j == 0) || (j == cur) || (j == cur - 1), causal = (64 * j <= qp);
            const float val = forced ? BIGF : (causal ? imp : NEGF);
            const unsigned ub = __float_as_uint(val); uk[qi] = (ub & 0x80000000u) ? ~ub : (ub | 0x80000000u); pref[qi] = 0u; }
#pragma unroll 1
        for (int bit = 31; bit >= 0; --bit) {
#pragma unroll
            for (int qi = 0; qi < 8; ++qi) { const unsigned cand = pref[qi] | (1u << bit); if (__popcll(__ballot(uk[qi] >= cand)) >= 16) pref[qi] = cand; } }
#pragma unroll
        for (int qi = 0; qi < 8; ++qi) { const int j = lane;
            const unsigned long long gt = __ballot(uk[qi] > pref[qi]), eq = __ballot(uk[qi] == pref[qi]); const int need = 16 - __popcll(gt);
            const unsigned long long below = eq & ((1ull << j) - 1ull);
            const unsigned long long mk = gt | __ballot(uk[qi] == pref[qi] && __popcll(below) < need);
            if (qi == (lr >> 2)) mym[0] = mk; if (qi == 4 + (lr >> 2)) mym[1] = mk; }
#pragma unroll
        for (int nq = 0; nq < 2; ++nq) { S.mhat[nq] = 0.f; S.l[nq] = 0.f; const float g0 = NSA_GATE(nq, 0);
#pragma unroll
            for (int ct = 0; ct < 4; ++ct) { OUTL[(ct * 2 + nq) * 64] = S.O[ct][nq] * g0; S.O[ct][nq] = (f32x4){0.f, 0.f, 0.f, 0.f}; } }
    }
    for (int s = n2; s < n3 - 1; ++s) NSA_STEP(3, s, s - n2, PS);
    NSA_STEP(2, n3 - 1, cur, PS);
#pragma unroll
    for (int nq = 0; nq < 2; ++nq) { const float lf = colsum4(S.l[nq]); const float sc = NSA_GATE(nq, 1) / lf; S.mhat[nq] = 0.f; S.l[nq] = 0.f;
#pragma unroll
        for (int ct = 0; ct < 4; ++ct) { OUTL[(ct * 2 + nq) * 64] += S.O[ct][nq] * sc; S.O[ct][nq] = (f32x4){0.f, 0.f, 0.f, 0.f}; } }
    {   int s = n3; if (cur >= 8) { NSA_STEP(2, s, lo, PS); ++s; }
        for (; s < n4 - 1; ++s) NSA_STEP(3, s, lo + s - n3, PS);
        NSA_STEP(2, n4 - 1, cur, PS); }
#undef NSA_STEP
#undef NSA_ENDWAIT
#undef NSA_ISSUE
#undef NSA_GLDS
#undef NSA_WAITBAR
#pragma unroll
    for (int nq = 0; nq < 2; ++nq) { const float lf = colsum4(S.l[nq]); const float sc = NSA_GATE(nq, 2) / lf; bf16* op = ATT + ((size_t)b * SEQ + NSA_QPOS(nq)) * 1024 + head * 64 + 4 * lq;
#pragma unroll
        for (int ct = 0; ct < 4; ++ct) { const f32x4 o = OUTL[(ct * 2 + nq) * 64] + S.O[ct][nq] * sc; v2u pk; pk.x = pk2(o[0], o[1]); pk.y = pk2(o[2], o[3]); *(v2u*)(op + 16 * ct) = pk; } }
#undef NSA_GATE
#undef NSA_QPOS
}
#define XB_TMO      128
#define XB_XCNT(j)  (256  + 64 * (j))
#define XB_XSUB(j)  (1280 + 64 * (j))
#define XB_XGEN(j)  (2304 + 64 * (j))
#define XB_TOP      3328
#define XB_TOPGEN   3392
#define XCD_BAR_WORDS 3456
#define XB_SPIN_CAP (1u << 18)

__device__ __forceinline__ unsigned xb_ld(unsigned* p)              { return __hip_atomic_load(p, __ATOMIC_RELAXED, __HIP_MEMORY_SCOPE_AGENT); }
__device__ __forceinline__ unsigned xb_add(unsigned* p, unsigned v) { return __hip_atomic_fetch_add(p, v, __ATOMIC_RELAXED, __HIP_MEMORY_SCOPE_AGENT); }
__device__ __forceinline__ unsigned xb_xcc_id() { return (unsigned)__builtin_amdgcn_s_getreg((3 << 11) | 20) & 0xFu; }
#define XB_SPIN(cond, bar) do { unsigned _sp = 0; while (cond) { __builtin_amdgcn_s_sleep(1); \
    if ((++_sp & 255u) == 0u) { if (xb_ld(&(bar)[XB_TMO])) break; if (_sp > XB_SPIN_CAP) { atomicAdd(&(bar)[XB_TMO], 1u); break; } } } } while (0)

struct XcdBarrier {
    unsigned* bar; unsigned x;
    volatile LAS unsigned* st;
};

__device__ __forceinline__ XcdBarrier xcd_barrier_post(unsigned* bar, volatile LAS unsigned* st) {
    XcdBarrier b; b.bar = bar; b.x = xb_xcc_id(); b.st = st;
    if (threadIdx.x == 0) (void)xb_add(&bar[XB_XCNT(b.x)], 1u);
    return b;
}
__device__ __forceinline__ void xcd_barrier_complete(unsigned* bar, unsigned x, unsigned& nloc, unsigned& nx) {
    const unsigned G = gridDim.x * gridDim.y * gridDim.z;
    unsigned sum, cnt, mine, sp = 0u;
    for (;;) {
        sum = 0u; cnt = 0u; mine = 0u;
#pragma unroll
        for (unsigned j = 0; j < 16; ++j) { const unsigned c = xb_ld(&bar[XB_XCNT(j)]); sum += c; cnt += (c > 0u) ? 1u : 0u; mine = (j == x) ? c : mine; }
        if (sum == G) break;
        __builtin_amdgcn_s_sleep(1);
        if ((++sp & 255u) == 0u) { if (xb_ld(&bar[XB_TMO])) break; if (sp > XB_SPIN_CAP) { atomicAdd(&bar[XB_TMO], 1u); break; } }
    }
    nloc = mine > 0u ? mine : 1u; nx = cnt > 0u ? cnt : 1u;
}

__device__ __forceinline__ void xcd_barrier(const XcdBarrier& b) {
    asm volatile("s_waitcnt vmcnt(0)" ::: "memory");
    __syncthreads();
    if (threadIdx.x == 0) {
        unsigned* bar = b.bar;
        __builtin_amdgcn_s_waitcnt(0);
        unsigned nloc = b.st[0], nx = b.st[1];
        if (nloc == 0u) { xcd_barrier_complete(bar, b.x, nloc, nx); b.st[0] = nloc; b.st[1] = nx; }
        const unsigned old = xb_add(&bar[XB_XSUB(b.x)], 1u);
        const unsigned gen = old / nloc;
        if (old + 1u == (gen + 1u) * nloc) {
            __builtin_amdgcn_fence(__ATOMIC_RELEASE, "agent");
            asm volatile("s_waitcnt vmcnt(0)" ::: "memory");
            const unsigned og = xb_add(&bar[XB_TOP], 1u);
            const unsigned tg = og / nx;
            if (og + 1u == (tg + 1u) * nx) xb_add(&bar[XB_TOPGEN], 1u);
            else XB_SPIN(xb_ld(&bar[XB_TOPGEN]) == tg, bar);
            __builtin_amdgcn_fence(__ATOMIC_ACQUIRE, "agent");
            xb_add(&bar[XB_XGEN(b.x)], 1u);
            asm volatile("s_waitcnt vmcnt(0)" ::: "memory");
        } else {
            XB_SPIN(xb_ld(&bar[XB_XGEN(b.x)]) == gen, bar);
            __builtin_amdgcn_fence(__ATOMIC_ACQUIRE, "agent");
            asm volatile("s_waitcnt vmcnt(0)" ::: "memory");
        }
    }
    __syncthreads();
}
constexpr int LDS_BYTES = 147456;
constexpr int NPHASES = 14;
#ifndef PHMASK
#define PHMASK 0x3fff
#endif
#ifndef PHREP
#define PHREP 0
#endif
#ifndef RES_ALIGN
#define RES_ALIGN true
#endif
#ifndef MK_SINGLE
#define MK_SINGLE 1
#endif

constexpr int RS_OFF = 131072 + 256;
__device__ __forceinline__ void rs_table(LAS unsigned char* lds, const float* SS, int N) {
    pg8::StaticOrder S; S.init(MROWS, N, (int)gridDim.x, (int)blockIdx.x); LAS float* RS = (LAS float*)(lds + RS_OFF); pg8::Unit u;
    for (int idx = threadIdx.x; ; idx += NTHREADS) { const int ui = idx >> 8; if (ui >= 11 || !S.next(ui, u)) break; RS[idx] = pg8::row_rs_g(SS, u.pm * 256 + (idx & 255)); }
    __syncthreads();
}
template <class Epi, bool ALIGN = true> __device__ __forceinline__ void run_gemm(LAS unsigned char* lds, const bf16* Aop, const bf16* Bt, int N, int K, const Epi& E) {
    pg8::Gemm g{Aop, Bt, MROWS, N, K}; pg8::StaticOrder S; S.init(MROWS, N, (int)gridDim.x, (int)blockIdx.x);
    pg8::gemm_phase<Epi, pg8::StaticOrder, ALIGN, true>(lds, g, S, E);
}

__global__ void __launch_bounds__(NTHREADS, 2) mk_fwd(Args args) {
    extern __shared__ __attribute__((aligned(16))) unsigned char lds_raw[];
    LAS unsigned char* lds = (LAS unsigned char*)lds_raw;
    cg::grid_group grid = cg::this_grid();
    volatile LAS unsigned* MISC = (volatile LAS unsigned*)(lds + 131072);
    if (threadIdx.x < 32) MISC[threadIdx.x] = 0u;
    __syncthreads();
    XcdBarrier xbar = xcd_barrier_post((unsigned*)(args.ws + WS_CTL) + 4096, MISC + 8);
    const int tid = threadIdx.x, lane = tid & 63, wave = __builtin_amdgcn_readfirstlane(tid >> 6);
    const int gw = blockIdx.x * NWAVES + wave, NGW = gridDim.x * NWAVES;
    unsigned char* ws = args.ws;
    const int lo = args.ph_lo, hi = args.ph_hi;
#define PH_BEGIN(k) if (lo <= (k) && (k) < hi) { if ((k) > lo) { if ((k) == lo + 1) grid.sync(); else xcd_barrier(xbar); } for (int rep_ = 0; rep_ < ((((PHREP) >> (k)) & 1) ? 2 : 1); ++rep_) { __syncthreads(); if constexpr ((PHMASK >> (k)) & 1) {
#define PH_END }}}
    float* const SS = (float*)(ws + WS_SS); constexpr size_t SSN = (size_t)MROWS * 16;
    bf16* const XN = (bf16*)(ws + WS_XN);
    PH_BEGIN(0) p0_prologue(args, lds, wave, lane); PH_END
    const LAS float* RSL = (const LAS float*)(lds + RS_OFF);
    PH_BEGIN(1) { rs_table(lds, SS, AB_IN); pg8::EpiProj0 E{(bf16*)(ws + WS_PROJ0), (const float*)(ws + TAB_RCOS), (const float*)(ws + TAB_RSIN), RSL};
                  run_gemm(lds, XN, (const bf16*)(ws + W_ABIN), AB_IN, 1024, E); } PH_END
    PH_BEGIN(2) { for (int it = blockIdx.x; it < 1024; it += gridDim.x) lru_item(args, lds, it, 0); ret_kv_run(args, lds, (int)blockIdx.x, (int)gridDim.x, 2048); } PH_END
    PH_BEGIN(3) {
                  for (int it = blockIdx.x; it < 1024; it += gridDim.x) lru_item(args, lds, it, 1);
                  const int per = (2048 + (int)gridDim.x - 1) / (int)gridDim.x, i0 = (int)blockIdx.x * per;
                  const int i1 = (i0 + per < 2048) ? i0 + per : 2048;
                  if (i0 < i1) { RetPre R; ret_out_pre(args, i0, true, R);
                      for (int it = i0; it < i1; ++it) { const int nx = (it + 1 < i1) ? it + 1 : -1; ret_out_item(args, lds, it, it == i0 || (it & 31) == 0, R, nx, nx >= 0 && (nx & 31) == 0); } } } PH_END
    PH_BEGIN(4) { pg8::EpiResid E{args.in[I_X], args.out, XN, SS + SSN}; run_gemm<pg8::EpiResid, RES_ALIGN>(lds, (const bf16*)(ws + WS_CAT), (const bf16*)(ws + W_ABOUT), 1024, 1024, E); } PH_END
    PH_BEGIN(5) { rs_table(lds, SS + SSN, 2 * FFH); pg8::EpiFfnUp E{(bf16*)(ws + WS_ACT), FFH, RSL}; run_gemm(lds, XN, (const bf16*)(ws + W_F13), 2 * FFH, 1024, E); } PH_END
    PH_BEGIN(6) { pg8::EpiResid E{args.out, args.out, XN, SS + 2 * SSN}; run_gemm<pg8::EpiResid, RES_ALIGN>(lds, (const bf16*)(ws + WS_ACT), (const bf16*)(ws + W_F2), 1024, FFH, E); } PH_END
    PH_BEGIN(7) { rs_table(lds, SS + 2 * SSN, NSA_INP); pg8::EpiNsaIn E{(bf16*)(ws + WS_Q), (bf16*)(ws + WS_KV6), (float*)(ws + WS_GATES), (bf16*)(ws + WS_VTS), (bf16*)(ws + WS_VTW), (const float*)(ws + TAB_NCOS), (const float*)(ws + TAB_NSIN), RSL};
                  run_gemm(lds, XN, (const bf16*)(ws + W_NSAIN), NSA_INP, 1024, E); } PH_END
    PH_BEGIN(8) { cmp_bias_to_lds(args, lds); for (int it = blockIdx.x; it < 256; it += gridDim.x) cmp_item(args, lds, it); } PH_END
    PH_BEGIN(9) { if (gridDim.x == 256) {
                      const int grp = (int)blockIdx.x >> 5, bg = (int)blockIdx.x & 31;
                      for (int i = 0; i < 8; ++i) { const int qt = (i & 1) ? 8 * i + 7 - grp : 8 * i + grp; nsa_item2(args, lds, qt * 32 + bg); } }
                  else for (int it = blockIdx.x; it < 2048; it += gridDim.x) nsa_item2(args, lds, it); } PH_END
    PH_BEGIN(10) { pg8::EpiResid E{args.out, args.out, XN, SS + 3 * SSN}; run_gemm<pg8::EpiResid, RES_ALIGN>(lds, (const bf16*)(ws + WS_CAT), (const bf16*)(ws + W_NSAOUT), 1024, 1024, E); } PH_END
    PH_BEGIN(11) { rs_table(lds, SS + 3 * SSN, 2 * FFH); pg8::EpiFfnUp E{(bf16*)(ws + WS_ACT), FFH, RSL}; run_gemm(lds, XN, (const bf16*)(ws + W_F13) + (size_t)2 * FFH * 1024, 2 * FFH, 1024, E); } PH_END
    PH_BEGIN(12) { pg8::EpiResid E{args.out, args.out, nullptr, nullptr}; run_gemm<pg8::EpiResid, RES_ALIGN>(lds, (const bf16*)(ws + WS_ACT), (const bf16*)(ws + W_F2) + (size_t)1024 * FFH, 1024, FFH, E); } PH_END
    PH_BEGIN(13) final_norm_phase(args.out, args.in[I_FINAL_NORM], gw, NGW, lane); PH_END
}

extern "C" void kernel_launch(void* const* d_in, const int* in_sizes, int n_in, void* d_out, int out_size, void* d_ws, size_t ws_size, hipStream_t stream) {
    static int grid = 0;
    if (grid == 0) {
        if (n_in != 24 || out_size != MROWS * DM || ws_size < WS_END) { fprintf(stderr, "kernel_launch: unexpected shapes (n_in %d out %d ws %zu)\n", n_in, out_size, ws_size); grid = -1; return; }
        int dev = 0, cus = 0, per_cu = 0;
        if (hipGetDevice(&dev) != hipSuccess || hipDeviceGetAttribute(&cus, hipDeviceAttributeMultiprocessorCount, dev) != hipSuccess) { grid = -1; return; }
        if (hipFuncSetAttribute((const void*)mk_fwd, hipFuncAttributeMaxDynamicSharedMemorySize, LDS_BYTES) != hipSuccess) { fprintf(stderr, "kernel_launch: hipFuncSetAttribute failed\n"); grid = -1; return; }
        if (hipOccupancyMaxActiveBlocksPerMultiprocessor(&per_cu, (const void*)mk_fwd, NTHREADS, LDS_BYTES) != hipSuccess || per_cu < 1) { fprintf(stderr, "kernel_launch: occupancy query says %d\n", per_cu); per_cu = 1; }
        (void)hipGetLastError();
        grid = cus;
    }
    if (grid < 0) return;
    if (hipMemsetAsync((char*)d_ws + WS_CTL, 0, 65536, stream) != hipSuccess) { fprintf(stderr, "kernel_launch: memset failed\n"); return; }
    Args a{};
    for (int i = 0; i < 24; ++i) a.in[i] = (const float*)d_in[i];
    a.out = (float*)d_out; a.ws = (unsigned char*)d_ws;
#if MK_SINGLE
    a.ph_lo = 0; a.ph_hi = NPHASES;
    void* kargs[] = {&a};
    hipError_t e = hipLaunchCooperativeKernel((const void*)mk_fwd, dim3(grid), dim3(NTHREADS), kargs, LDS_BYTES, stream);
    if (e != hipSuccess) fprintf(stderr, "kernel_launch: cooperative launch failed: %s (grid %d)\n", hipGetErrorString(e), grid);
#else
    for (int ph = 0; ph < NPHASES; ++ph) { a.ph_lo = ph; a.ph_hi = ph + 1; hipLaunchKernelGGL(mk_fwd, dim3(grid), dim3(NTHREADS), LDS_BYTES, stream, a); }
#endif
}
```

```cpp
#include <hip/hip_runtime.h>
#include <hip/hip_cooperative_groups.h>
#include <cstdio>
#include <cstdint>
namespace cg = cooperative_groups;
namespace pg8 {
#define PG8_LAS __attribute__((address_space(3)))
typedef unsigned short bf16_t;
typedef short bf16x8 __attribute__((ext_vector_type(8)));
typedef float f32x4 __attribute__((ext_vector_type(4)));
typedef unsigned u32x4 __attribute__((ext_vector_type(4)));
constexpr int BM = 256, BK = 64, HALF = 128, HTB = HALF * BK * 2  , STAGE_BYTES = 8 * HTB, NXCD = 8, WGM = 8;

__host__ __device__ __forceinline__ int lds_byte(int r, int c) { const int st = (r >> 4) * 2 + (c >> 5), rr = r & 15, cc = c & 31, ob = rr * 64 + cc * 2; return st * 1024 + (ob ^ (((ob >> 9) & 1) << 5)); }
__host__ __device__ __forceinline__ void stage_rc(int b, int& R, int& C) { const int st = b / 1024, sb = b % 1024, swz = sb ^ (((sb >> 9) & 1) << 5); R = (st >> 1) * 16 + swz / 64; C = (st & 1) * 32 + (swz % 64) / 2; }
__host__ __device__ __forceinline__ int perm32(int rho) { const int n = rho >> 4, i = rho & 15; return 8 * (i >> 2) + 4 * n + (i & 3); }

struct Unit { int pm, pn, ui; };
struct Gemm { const bf16_t* A; const bf16_t* Bt; int M, N, K; };

struct StaticOrder {
    int nM, nN, nwg, G, c;
    __host__ __device__ void init(int M, int N, int G_, int c_) { nM = M / BM; nN = N / BM; nwg = nM * nN; G = G_; c = c_; }
    __host__ __device__ bool next(int i, Unit& u) const {
        const long L = (long)i * G + c; if (L >= nwg) return false;
        int wgid = (int)L; { const int q = nwg / NXCD, r = nwg % NXCD, xcd = wgid % NXCD, off = wgid / NXCD; wgid = (xcd < r ? xcd * (q + 1) : r * (q + 1) + (xcd - r) * q) + off; }
        const int nig = WGM * nN, gid = wgid / nig, fm = gid * WGM, gsz = (nM - fm) < WGM ? (nM - fm) : WGM;
        u.pm = fm + ((wgid % nig) % gsz); u.pn = (wgid % nig) / gsz; u.ui = i; return true;
    }
    __device__ __forceinline__ void a_ready(const Unit&) const {}
    __device__ __forceinline__ void done(const Unit&) const {}
};

__device__ __forceinline__ unsigned cvt_pk_bf16(float lo, float hi) { unsigned r; asm volatile("v_cvt_pk_bf16_f32 %0, %1, %2" : "=v"(r) : "v"(lo), "v"(hi)); return r; }
typedef unsigned u32x2 __attribute__((ext_vector_type(2)));
__device__ __forceinline__ float sigmoid_f(float x) { return __builtin_amdgcn_rcpf(1.f + __builtin_amdgcn_exp2f(-1.4426950408889634f * x)); }
__device__ __forceinline__ float silu_f(float x) { return x * __builtin_amdgcn_rcpf(1.f + __builtin_amdgcn_exp2f(-1.4426950408889634f * x)); }
__device__ __forceinline__ u32x4 pack8(const f32x4 a, const f32x4 b) { u32x4 w; w.x = cvt_pk_bf16(a[0], a[1]); w.y = cvt_pk_bf16(a[2], a[3]); w.z = cvt_pk_bf16(b[0], b[1]); w.w = cvt_pk_bf16(b[2], b[3]); return w; }
__device__ __forceinline__ u32x2 pack4(const f32x4 a) { u32x2 w; w.x = cvt_pk_bf16(a[0], a[1]); w.y = cvt_pk_bf16(a[2], a[3]); return w; }

__device__ __forceinline__ float row_rs_g(const float* SS, int row) { const f32x4* p = (const f32x4*)(SS + (size_t)row * 16); const f32x4 a = p[0], b = p[1], c = p[2], d = p[3];
    const float t = ((a[0] + a[1]) + (a[2] + a[3])) + ((b[0] + b[1]) + (b[2] + b[3])) + ((c[0] + c[1]) + (c[2] + c[3])) + ((d[0] + d[1]) + (d[2] + d[3])); return 1.f / sqrtf(t * (1.f / 1024.f) + 1e-6f); }
struct EpiProj0 {
    static constexpr bool PERM = true, AFTER_DRAIN = false;
    bf16_t* P; const float* cosT; const float* sinT; const PG8_LAS float* RS;
    __device__ __forceinline__ void operator()(const f32x4 (&acc)[2][2][4][2], const Unit& u, int wr, int wc, int fr, int fq) const {
        const int row0 = u.pm * BM + wr * 64 + fr, colt = u.pn * BM + wc * 32 + 8 * fq;
        const bool rot = (u.pn >= 4 && u.pn < 8); const float sc = (u.pn >= 6 && u.pn < 8) ? 0.125f : 1.f;
#pragma unroll
        for (int ai = 0; ai < 2; ++ai)
#pragma unroll
            for (int m = 0; m < 4; ++m) { const int row = row0 + ai * HALF + m * 16, pos = row & 4095; bf16_t* rowp = P + (size_t)row * 3072; const float rs = RS[u.ui * 256 + (row & 255)];
#pragma unroll
                for (int bj = 0; bj < 2; ++bj) { const int col = colt + bj * HALF; const f32x4 v0 = acc[ai][bj][m][0] * rs, v1 = acc[ai][bj][m][1] * rs;
                    if (rot) { const int hc = col & 63, gi = hc >> 3, hb = col - hc;
                        const f32x4 c = *(const f32x4*)(cosT + pos * 32 + 4 * gi), s = *(const f32x4*)(sinT + pos * 32 + 4 * gi);
                        const f32x4 o1 = (v0 * c - v1 * s) * sc, o2 = (v1 * c + v0 * s) * sc;
                        *(u32x2*)(rowp + hb + 4 * gi) = pack4(o1); *(u32x2*)(rowp + hb + 32 + 4 * gi) = pack4(o2);
                    } else { *(u32x4*)(rowp + col) = pack8(v0, v1); } } }
    }
};
struct EpiNsaIn {
    static constexpr bool PERM = true, AFTER_DRAIN = false;
    bf16_t* Q; bf16_t* KV; float* G; bf16_t* VTS; bf16_t* VTW; const float* cosT; const float* sinT; const PG8_LAS float* RS;
    __device__ __forceinline__ void operator()(const f32x4 (&acc)[2][2][4][2], const Unit& u, int wr, int wc, int fr, int fq) const {
        const int row0 = u.pm * BM + wr * 64 + fr, pn = u.pn;
#pragma unroll
        for (int ai = 0; ai < 2; ++ai)
#pragma unroll
            for (int m = 0; m < 4; ++m) { const int row = row0 + ai * HALF + m * 16, pos = row & 4095; const float rs = RS[u.ui * 256 + (row & 255)];
#pragma unroll
                for (int bj = 0; bj < 2; ++bj) { const int lc = bj * HALF + wc * 32 + 8 * fq; const f32x4 v0 = acc[ai][bj][m][0] * rs, v1 = acc[ai][bj][m][1] * rs;
                    if (pn < 10) {
                        bf16_t* dst; bool rot; float sc;
                        if (pn < 4) { dst = Q + (size_t)row * 1024 + pn * 256 + lc; rot = true; sc = 0.125f * 1.4426950408889634f; }
                        else { const int j = pn - 4;
                            if (j == 3 || j == 5) {
                                bf16_t* vt = (j == 3 ? VTS : VTW) + ((size_t)((row >> 12) * 4 + (lc >> 6)) * 64 + (lc & 63)) * 4096 + pos; const u32x4 w8 = pack8(v0, v1); const unsigned wv[4] = {w8.x, w8.y, w8.z, w8.w};
#pragma unroll
                                for (int i = 0; i < 4; ++i) { vt[(size_t)(2 * i) * 4096] = (bf16_t)(wv[i] & 0xffffu); vt[(size_t)(2 * i + 1) * 4096] = (bf16_t)(wv[i] >> 16); }
                                continue; }
                            dst = KV + (size_t)row * 1536 + j * 256 + lc; rot = (j == 2 || j == 4); sc = 1.f; }
                        const int hc = lc & 63;
                        if (rot && hc < 16) { const int gi = hc >> 3;
                            const f32x4 c = *(const f32x4*)(cosT + pos * 8 + 4 * gi), s = *(const f32x4*)(sinT + pos * 8 + 4 * gi);
                            const f32x4 o1 = (v0 * c - v1 * s) * sc, o2 = (v1 * c + v0 * s) * sc;
                            bf16_t* hbp = dst - hc; *(u32x2*)(hbp + 4 * gi) = pack4(o1); *(u32x2*)(hbp + 8 + 4 * gi) = pack4(o2);
                        } else { *(u32x4*)dst = pack8(v0 * sc, v1 * sc); }
                    } else if (lc < 48) {
                        float* gp = G + (size_t)row * 48 + lc; f32x4 a, b;
#pragma unroll
                        for (int i = 0; i < 4; ++i) { a[i] = sigmoid_f(v0[i]); b[i] = sigmoid_f(v1[i]); }
                        *(f32x4*)gp = a; *(f32x4*)(gp + 4) = b; } } }
    }
};
struct EpiFfnUp {
    static constexpr bool PERM = true, AFTER_DRAIN = false;
    bf16_t* ACT; int ld; const PG8_LAS float* RS;
    __device__ __forceinline__ void operator()(const f32x4 (&acc)[2][2][4][2], const Unit& u, int wr, int wc, int fr, int fq) const {
        const int row0 = u.pm * BM + wr * 64 + fr, col = u.pn * 128 + wc * 32 + 8 * fq;
#pragma unroll
        for (int ai = 0; ai < 2; ++ai)
#pragma unroll
            for (int m = 0; m < 4; ++m) { const int row = row0 + ai * HALF + m * 16; f32x4 h0, h1; const float rs = RS[u.ui * 256 + (row & 255)];
#pragma unroll
                for (int i = 0; i < 4; ++i) { h0[i] = silu_f(acc[ai][0][m][0][i] * rs) * (acc[ai][1][m][0][i] * rs); h1[i] = silu_f(acc[ai][0][m][1][i] * rs) * (acc[ai][1][m][1][i] * rs); }
                *(u32x4*)(ACT + (size_t)row * ld + col) = pack8(h0, h1); }
    }
};
struct EpiResid {
    static constexpr bool PERM = true, AFTER_DRAIN = false;
    const float* base; float* out; bf16_t* HB; float* SS;
    __device__ __forceinline__ void operator()(const f32x4 (&acc)[2][2][4][2], const Unit& u, int wr, int wc, int fr, int fq) const {
        const int row0 = u.pm * BM + wr * 64 + fr, col0 = u.pn * BM + wc * 32 + 8 * fq;
#pragma unroll
        for (int ai = 0; ai < 2; ++ai) {
            f32x4 pre[4][2][2];
#pragma unroll
            for (int m = 0; m < 4; ++m) { const size_t off = (size_t)(row0 + ai * HALF + m * 16) * 1024 + col0;
#pragma unroll
                for (int bj = 0; bj < 2; ++bj) { pre[m][bj][0] = *(const f32x4*)(base + off + bj * HALF); pre[m][bj][1] = *(const f32x4*)(base + off + bj * HALF + 4); } }
            asm volatile("" ::: "memory");
#pragma unroll
            for (int m = 0; m < 4; ++m) { const int row = row0 + ai * HALF + m * 16; const size_t off = (size_t)row * 1024 + col0; float ssq = 0.f;
#pragma unroll
                for (int bj = 0; bj < 2; ++bj) { const size_t o = off + bj * HALF; const f32x4 v0 = pre[m][bj][0] + acc[ai][bj][m][0], v1 = pre[m][bj][1] + acc[ai][bj][m][1];
                    *(f32x4*)(out + o) = v0; *(f32x4*)(out + o + 4) = v1;
                    if (HB) { *(u32x4*)(HB + o) = pack8(v0, v1); ssq += ((v0[0] * v0[0] + v0[1] * v0[1]) + (v0[2] * v0[2] + v0[3] * v0[3])) + ((v1[0] * v1[0] + v1[1] * v1[1]) + (v1[2] * v1[2] + v1[3] * v1[3])); } }
                if (HB) { ssq += __shfl_xor(ssq, 16); ssq += __shfl_xor(ssq, 32); if (fq == 0) SS[(size_t)row * 16 + u.pn * 4 + wc] = ssq; } }
            asm volatile("" ::: "memory");
        }
    }
};
template <class Epi, class Sched, bool ALIGN_EPI = false, bool SP2 = false>
__device__ __forceinline__ void gemm_phase(PG8_LAS unsigned char* lds, const Gemm g, const Sched& S, const Epi& E) {
    const int tid = threadIdx.x, wid = __builtin_amdgcn_readfirstlane(tid >> 6), lane = tid & 63, wr = wid >> 2, wc = wid & 3, fr = lane & 15, fq = lane >> 4;
    const int K = g.K, nt = K / BK;
    unsigned voffA[2], voffB[2];
#pragma unroll
    for (int i = 0; i < 2; ++i) { int R, C; stage_rc(tid * 16 + i * 8192, R, C); const int Rb = Epi::PERM ? ((R & ~31) + perm32(R & 31)) : R;
        voffA[i] = (unsigned)(R * K + C) * 2u; voffB[i] = (unsigned)(Rb * K + C) * 2u; }
    const size_t kstep = (size_t)(BK * 2);
    const size_t hstep = (size_t)HALF * K * 2;
    const size_t tstep = 2 * hstep;
    const unsigned ldsw = (unsigned)wid * 1024u;
    const int aoff = lds_byte(wr * 64 + fr, fq * 8), boff = lds_byte(wc * 32 + fr, fq * 8);
#define PG8_SA(b, h) (((b) * 2 + (h)) * HTB)
#define PG8_SB(b, h) ((4 + (b) * 2 + (h)) * HTB)
#define PG8_STAGE(bufoff, gbase, voff) do { _Pragma("unroll") for (int _i = 0; _i < 2; ++_i) \
        __builtin_amdgcn_global_load_lds((const unsigned*)((const char*)(gbase) + (voff)[_i]), (PG8_LAS unsigned*)(lds + (bufoff) + ldsw + _i * 8192), 16, 0, 0); } while (0)
#define PG8_LDA(dst, b, h) do { _Pragma("unroll") for (int m = 0; m < 4; ++m) _Pragma("unroll") for (int k = 0; k < 2; ++k) dst[m][k] = *(const PG8_LAS bf16x8*)(lds + PG8_SA(b, h) + aoff + m * 2048 + k * 1024); } while (0)
#define PG8_LDB(dst, b, h) do { _Pragma("unroll") for (int n = 0; n < 2; ++n) _Pragma("unroll") for (int k = 0; k < 2; ++k) dst[n][k] = *(const PG8_LAS bf16x8*)(lds + PG8_SB(b, h) + boff + n * 2048 + k * 1024); } while (0)
#define PG8_MMA(ai, bj, At, Bt) do { __builtin_amdgcn_s_setprio(1); _Pragma("unroll") for (int m = 0; m < 4; ++m) _Pragma("unroll") for (int n = 0; n < 2; ++n) _Pragma("unroll") for (int k = 0; k < 2; ++k) \
        acc[ai][bj][m][n] = __builtin_amdgcn_mfma_f32_16x16x32_bf16(Bt[n][k], At[m][k], acc[ai][bj][m][n], 0, 0, 0); __builtin_amdgcn_s_setprio(0); } while (0)
#define PG8_WAIT_V(n) asm volatile("s_waitcnt vmcnt(" #n ")" ::: "memory")
#define PG8_WAIT_L(n) asm volatile("s_waitcnt lgkmcnt(" #n ")" ::: "memory")
#define PG8_BAR __builtin_amdgcn_s_barrier()
#define PG8_SCHED __builtin_amdgcn_sched_barrier(0)
    Unit cur, nxt; int ui = 0;
    if (!S.next(0, cur)) return;
    f32x4 acc[2][2][4][2];
#pragma unroll
    for (int a = 0; a < 2; ++a)
#pragma unroll
        for (int b = 0; b < 2; ++b)
#pragma unroll
            for (int m = 0; m < 4; ++m)
#pragma unroll
                for (int n = 0; n < 2; ++n) acc[a][b][m][n] = (f32x4){0.f, 0.f, 0.f, 0.f};
    bf16x8 At[4][2], B0[2][2], B1[2][2];
    const char* cA = (const char*)g.A + (size_t)cur.pm * tstep; const char* cB = (const char*)g.Bt + (size_t)cur.pn * tstep;
    S.a_ready(cur);
    if constexpr (SP2) {
        PG8_STAGE(PG8_SB(0, 0), cB, voffB); PG8_STAGE(PG8_SB(0, 1), cB + hstep, voffB); PG8_STAGE(PG8_SA(0, 0), cA, voffA); PG8_STAGE(PG8_SA(0, 1), cA + hstep, voffA);
        if (wr == 1) PG8_BAR;
        PG8_WAIT_V(2); PG8_BAR;
        PG8_STAGE(PG8_SB(1, 0), cB + kstep, voffB); PG8_STAGE(PG8_SA(1, 0), cA + kstep, voffA); PG8_STAGE(PG8_SB(1, 1), cB + hstep + kstep, voffB);
        PG8_WAIT_V(6); PG8_BAR;
    } else {
        PG8_STAGE(PG8_SB(0, 0), cB, voffB); PG8_STAGE(PG8_SA(0, 0), cA, voffA); PG8_STAGE(PG8_SB(0, 1), cB + hstep, voffB); PG8_STAGE(PG8_SA(0, 1), cA + hstep, voffA);
        if (wr == 1) PG8_BAR;
        PG8_WAIT_V(4); PG8_BAR;
        PG8_STAGE(PG8_SB(1, 0), cB + kstep, voffB); PG8_STAGE(PG8_SA(1, 0), cA + kstep, voffA); PG8_STAGE(PG8_SB(1, 1), cB + hstep + kstep, voffB);
        PG8_WAIT_V(6); PG8_BAR;
    }
    for (;;) {
        const bool has_next = S.next(ui + 1, nxt);
        const char* nA = has_next ? (const char*)g.A + (size_t)nxt.pm * tstep : cA; const char* nB = has_next ? (const char*)g.Bt + (size_t)nxt.pn * tstep : cB;
        for (int t = 0; t < nt; t += 2) {
            const bool last = (t == nt - 2);
            const char* a1 = cA + (size_t)(t + 1) * kstep;
            const char* a2 = last ? nA : cA + (size_t)(t + 2) * kstep; const char* b2 = last ? nB : cB + (size_t)(t + 2) * kstep;
            const char* a3 = a2 + kstep; const char* b3 = b2 + kstep;
            if (last && has_next) S.a_ready(nxt);
            if constexpr (SP2) {
            PG8_LDB(B0, 0, 0); PG8_LDB(B1, 0, 1); PG8_SCHED; PG8_LDA(At, 0, 0); PG8_STAGE(PG8_SA(1, 1), a1 + hstep, voffA);
            PG8_WAIT_V(8); PG8_WAIT_L(0); PG8_BAR; PG8_MMA(0, 0, At, B0); PG8_MMA(0, 1, At, B1); PG8_BAR; PG8_SCHED;
            PG8_LDA(At, 0, 1); PG8_STAGE(PG8_SB(0, 0), b2, voffB); PG8_STAGE(PG8_SB(0, 1), b2 + hstep, voffB); PG8_STAGE(PG8_SA(0, 0), a2, voffA);
            PG8_WAIT_V(8); PG8_WAIT_L(0); PG8_BAR; PG8_MMA(1, 0, At, B0); PG8_MMA(1, 1, At, B1); PG8_BAR; PG8_SCHED;
            PG8_LDB(B0, 1, 0); PG8_LDB(B1, 1, 1); PG8_SCHED; PG8_LDA(At, 1, 0); PG8_STAGE(PG8_SA(0, 1), a2 + hstep, voffA);
            PG8_WAIT_V(8); PG8_WAIT_L(0); PG8_BAR; PG8_MMA(0, 0, At, B0); PG8_MMA(0, 1, At, B1); PG8_BAR; PG8_SCHED;
            PG8_LDA(At, 1, 1); PG8_STAGE(PG8_SB(1, 0), b3, voffB); PG8_STAGE(PG8_SB(1, 1), b3 + hstep, voffB); PG8_STAGE(PG8_SA(1, 0), a3, voffA);
            PG8_WAIT_V(8); PG8_WAIT_L(0); PG8_BAR; PG8_MMA(1, 0, At, B0); PG8_MMA(1, 1, At, B1); PG8_BAR; PG8_SCHED;
            } else {
            PG8_LDB(B0, 0, 0); PG8_SCHED; PG8_LDA(At, 0, 0); PG8_STAGE(PG8_SA(1, 1), a1 + hstep, voffA);
            PG8_WAIT_L(8); PG8_BAR; PG8_WAIT_L(0); PG8_MMA(0, 0, At, B0); PG8_BAR; PG8_SCHED;
            PG8_LDB(B1, 0, 1); PG8_STAGE(PG8_SB(0, 0), b2, voffB);
            PG8_BAR; PG8_WAIT_L(0); PG8_MMA(0, 1, At, B1); PG8_BAR;
            PG8_LDA(At, 0, 1); PG8_STAGE(PG8_SA(0, 0), a2, voffA);
            PG8_BAR; PG8_WAIT_L(0); PG8_MMA(1, 0, At, B0); PG8_BAR; PG8_SCHED;
            PG8_STAGE(PG8_SB(0, 1), b2 + hstep, voffB);
            PG8_WAIT_V(6); PG8_BAR; PG8_MMA(1, 1, At, B1); PG8_BAR;
            PG8_LDB(B0, 1, 0); PG8_SCHED; PG8_LDA(At, 1, 0); PG8_STAGE(PG8_SA(0, 1), a2 + hstep, voffA);
            PG8_WAIT_L(8); PG8_BAR; PG8_WAIT_L(0); PG8_MMA(0, 0, At, B0); PG8_BAR; PG8_SCHED;
            PG8_LDB(B1, 1, 1); PG8_STAGE(PG8_SB(1, 0), b3, voffB);
            PG8_BAR; PG8_WAIT_L(0); PG8_MMA(0, 1, At, B1); PG8_BAR;
            PG8_LDA(At, 1, 1); PG8_STAGE(PG8_SA(1, 0), a3, voffA);
            PG8_BAR; PG8_WAIT_L(0); PG8_MMA(1, 0, At, B0); PG8_BAR; PG8_SCHED;
            PG8_STAGE(PG8_SB(1, 1), b3 + hstep, voffB);
            PG8_WAIT_V(6); PG8_BAR; PG8_MMA(1, 1, At, B1); PG8_BAR;
            }
        }
        if constexpr (ALIGN_EPI) { if (wr == 0) PG8_BAR; }
        if constexpr (!Epi::AFTER_DRAIN) { E(acc, cur, wr, wc, fr, fq); S.done(cur); }
        if (!has_next) break;
#pragma unroll
        for (int a = 0; a < 2; ++a)
#pragma unroll
            for (int b = 0; b < 2; ++b)
#pragma unroll
                for (int m = 0; m < 4; ++m)
#pragma unroll
                    for (int n = 0; n < 2; ++n) acc[a][b][m][n] = (f32x4){0.f, 0.f, 0.f, 0.f};
        cur = nxt; cA = nA; cB = nB; ++ui;
        if constexpr (ALIGN_EPI) { if (wr == 1) PG8_BAR; }
    }
    PG8_WAIT_V(0);
    if constexpr (!ALIGN_EPI) { if (wr == 0) PG8_BAR; }
    PG8_BAR;
    if constexpr (Epi::AFTER_DRAIN) { E.fused(acc, cur, wr, wc, fr, fq, lds, wid, lane); S.done(cur); }
#undef PG8_SA
#undef PG8_SB
#undef PG8_STAGE
#undef PG8_LDA
#undef PG8_LDB
#undef PG8_MMA
#undef PG8_WAIT_V
#undef PG8_WAIT_L
#undef PG8_BAR
#undef PG8_SCHED
}
}
#define LAS __attribute__((address_space(3)))
typedef unsigned short bf16;
typedef unsigned v4u __attribute__((ext_vector_type(4)));
typedef unsigned v2u __attribute__((ext_vector_type(2)));
typedef float f32x4 __attribute__((ext_vector_type(4)));
typedef short bf16x8 __attribute__((ext_vector_type(8)));

constexpr int NWAVES = 8, NTHREADS = 512;
constexpr int BATCH = 8, SEQ = 4096, DM = 1024, MROWS = BATCH * SEQ;
constexpr int AB_IN = 3072, FFH = 2816, NSA_IN = 2608, NSA_INP = 2816;
constexpr float EPSF = 1e-6f, NEGF = -1e30f, BIGF = 1e30f, LOG2E = 1.4426950408889634f;

constexpr size_t MiB = 1u << 20;
constexpr size_t WS_CTL = 0;
constexpr size_t WS_TAB = 1 * MiB;
constexpr size_t TAB_RCOS = WS_TAB, TAB_RSIN = TAB_RCOS + 4096 * 32 * 4, TAB_NCOS = TAB_RSIN + 4096 * 32 * 4, TAB_NSIN = TAB_NCOS + 4096 * 8 * 4, TAB_CB = TAB_NSIN + 4096 * 8 * 4;
constexpr size_t WS_W = 4 * MiB;
constexpr size_t W_ABIN = WS_W, W_ABOUT = W_ABIN + 6 * MiB, W_NSAIN = W_ABOUT + 2 * MiB, W_NSAOUT = W_NSAIN + 6 * MiB, W_F13 = W_NSAOUT + 2 * MiB  , W_F2 = W_F13 + 22 * MiB  ,
                 W_CK1 = W_F2 + 11 * MiB  , W_CV1 = W_CK1 + 256 * 1024, W_CK2 = W_CV1 + 256 * 1024  , W_CV2 = W_CK2 + 8192, W_GATE = W_CV2 + 8192  , W_END = W_GATE + 131072;
static_assert(W_END <= 64 * MiB, "weights");
constexpr size_t WS_XN = 64 * MiB;
constexpr size_t WS_CAT = 128 * MiB;
constexpr size_t WS_BIG = 192 * MiB;
constexpr size_t WS_PROJ0 = WS_BIG, WS_ACT = WS_BIG;
constexpr size_t WS_Q = WS_BIG, WS_KV6 = WS_BIG + 64 * MiB, WS_GATES = WS_KV6 + 96 * MiB, WS_KC = WS_GATES + 6 * MiB, WS_VCT = WS_KC + 1 * MiB, WS_VTS = WS_VCT + 1 * MiB, WS_VTW = WS_VTS + 16 * MiB;
constexpr size_t WS_KVT = 384 * MiB;
constexpr size_t WS_LSUM = 416 * MiB;
constexpr size_t WS_SS = 418 * MiB;
constexpr size_t WS_END = 428 * MiB;
static_assert(WS_VTW + 16 * MiB <= WS_KVT + 32 * MiB && WS_LSUM + 2 * MiB <= WS_SS && WS_PROJ0 + (size_t)MROWS * AB_IN * 2 <= WS_KVT, "ws map");

__device__ __forceinline__ float bf2f(bf16 v) { return __uint_as_float((unsigned)v << 16); }
__device__ __forceinline__ unsigned f2bf(float f) { unsigned u = __float_as_uint(f); return (u + 0x7fffu + ((u >> 16) & 1u)) >> 16; }
__device__ __forceinline__ unsigned pk2(float lo, float hi) { return f2bf(lo) | (f2bf(hi) << 16); }

__device__ __forceinline__ float gelu_tanh(float x) { const float u = 0.7978845608028654f * (x + 0.044715f * x * x * x); const float e = __expf(2.f * u); const float th = 1.f - 2.f / (e + 1.f); return 0.5f * x * (1.f + th); }
__device__ __forceinline__ float sigm(float x) { return 1.f / (1.f + __expf(-x)); }
__device__ __forceinline__ f32x4 mfma16(bf16x8 a, bf16x8 b, f32x4 c) { return __builtin_amdgcn_mfma_f32_16x16x32_bf16(a, b, c, 0, 0, 0); }
#define DPPF(x_, ctrl_) __int_as_float(__builtin_amdgcn_update_dpp(0, __float_as_int(x_), (ctrl_), 0xF, 0xF, true))
__device__ __forceinline__ float qsum4(float v) { v += DPPF(v, 0xB1); v += DPPF(v, 0x4E); return v; }
__device__ __forceinline__ float gsum16(float v) { v += DPPF(v, 0x128); v += DPPF(v, 0x124); v += DPPF(v, 0x122); v += DPPF(v, 0x121); return v; }
__device__ __forceinline__ float rows4_sum(float v) {
    auto a = __builtin_amdgcn_permlane16_swap(__float_as_uint(v), __float_as_uint(v), false, false); v = __uint_as_float(a[0]) + __uint_as_float(a[1]);
    auto c = __builtin_amdgcn_permlane32_swap(__float_as_uint(v), __float_as_uint(v), false, false); return __uint_as_float(c[0]) + __uint_as_float(c[1]); }
__device__ __forceinline__ float wave_sum(float v) { return rows4_sum(gsum16(v)); }

struct Args { const float* in[24]; float* out; unsigned char* ws; int ph_lo, ph_hi; };
enum { I_X = 0, I_ATTN_NORM, I_AB_W_IN, I_CONV_W, I_CONV_B, I_GA_W, I_GA_B, I_GX_W, I_GX_B, I_LAM, I_AB_W_OUT, I_NSA_W_IN, I_PE_K, I_K_W1, I_K_W2, I_PE_V, I_V_W1, I_V_W2, I_NSA_W_OUT,
       I_FFN_NORM, I_FFN_W1, I_FFN_W3, I_FFN_W2, I_FINAL_NORM };

struct P0Desc { const float* colp; const float* gain; bf16* wt; int ld, K, k0, d0; };
__device__ __forceinline__ void p0_decode(const Args& A, unsigned char* ws, int it, int lane, P0Desc& D) {
    constexpr int I_ABIN = 16 * (AB_IN / 32), I_SQ = 16 * 32, I_NSAIN = 16 * (NSA_INP / 32), I_F13 = 16 * (FFH / 32), I_F2 = (FFH / 64) * 32, I_C1 = 32 * 2, I_C2 = 2;
    int r = it, mapk = 0, Ndst = 1024, half = 0; const float* W; D.gain = nullptr; D.K = 1024;
    if (r < I_ABIN) { W = A.in[I_AB_W_IN]; D.ld = AB_IN; Ndst = AB_IN; D.wt = (bf16*)(ws + W_ABIN); D.gain = A.in[I_ATTN_NORM]; mapk = 1; }
    else if ((r -= I_ABIN) < I_SQ) { W = A.in[I_AB_W_OUT]; D.ld = 1024; D.wt = (bf16*)(ws + W_ABOUT); }
    else if ((r -= I_SQ) < I_NSAIN) { W = A.in[I_NSA_W_IN]; D.ld = NSA_IN; Ndst = NSA_INP; D.wt = (bf16*)(ws + W_NSAIN); D.gain = A.in[I_ATTN_NORM] + DM; mapk = 2; }
    else if ((r -= I_NSAIN) < I_SQ) { W = A.in[I_NSA_W_OUT]; D.ld = 1024; D.wt = (bf16*)(ws + W_NSAOUT); }
    else if ((r -= I_SQ) < 4 * I_F13) { const int q = r / I_F13; r -= q * I_F13; const int L = q & 1; half = q >> 1;
        W = A.in[half ? I_FFN_W3 : I_FFN_W1] + (size_t)L * 1024 * FFH; D.ld = FFH; Ndst = FFH; D.wt = (bf16*)(ws + W_F13) + (size_t)L * 2 * FFH * 1024; D.gain = A.in[I_FFN_NORM] + L * DM; mapk = 3; }
    else if ((r -= 4 * I_F13) < 2 * I_F2) { const int L = r / I_F2; r -= L * I_F2; W = A.in[I_FFN_W2] + (size_t)L * FFH * 1024; D.ld = 1024; D.K = FFH; D.wt = (bf16*)(ws + W_F2) + (size_t)L * 1024 * FFH; }
    else if ((r -= 2 * I_F2) < 2 * I_C1) { const int v = r / I_C1; r -= v * I_C1; W = A.in[v ? I_V_W1 : I_K_W1]; D.ld = 64; Ndst = 64; D.K = 2048; D.wt = (bf16*)(ws + (v ? W_CV1 : W_CK1)); }
    else { r -= 2 * I_C1; const int v = r / I_C2; r -= v * I_C2; W = A.in[v ? I_V_W2 : I_K_W2]; D.ld = 64; Ndst = 64; D.K = 64; D.wt = (bf16*)(ws + (v ? W_CV2 : W_CK2)); }
    const int nblk = Ndst / 32, kb = r / nblk, nb = r % nblk, n0 = 32 * nb, c = n0 + (lane & 31); D.k0 = 64 * kb; D.d0 = n0; int sc = c;
    if (mapk == 1) { if (c >= 1024 && c < 2048) { const int hc = c & 63, gi = hc >> 3, e = hc & 7; sc = (c - hc) + (e < 4 ? 4 * gi + e : 32 + 4 * gi + (e - 4)); } }
    else if (mapk == 2) { if (c >= NSA_IN) sc = -1; else if (c < 1024 || (c >= 1536 && c < 1792) || (c >= 2048 && c < 2304)) { const int hc = c & 63; if (hc < 16) { const int gi = hc >> 3, e = hc & 7; sc = (c - hc) + (e < 4 ? 4 * gi + e : 8 + 4 * gi + (e - 4)); } } }
    else if (mapk == 3) D.d0 = 256 * (n0 >> 7) + (n0 & 127) + 128 * half;
    D.colp = (sc < 0) ? nullptr : W + sc;
}
__device__ __forceinline__ void p0_load(const P0Desc& D, float (&tv)[32], int lane) {
#pragma unroll
    for (int i = 0; i < 32; ++i) { const int kk = 2 * i + (lane >> 5); tv[i] = D.colp ? D.colp[(size_t)(D.k0 + kk) * D.ld] : 0.f; }
}
__device__ __forceinline__ void p0_store(const P0Desc& D, const float (&tv)[32], LAS float* scr, int lane) {
    if (D.gain) {
#pragma unroll
        for (int i = 0; i < 32; ++i) { const int kk = 2 * i + (lane >> 5); scr[kk * 33 + (lane & 31)] = tv[i] * D.gain[D.k0 + kk]; }
    } else {
#pragma unroll
        for (int i = 0; i < 32; ++i) { const int kk = 2 * i + (lane >> 5); scr[kk * 33 + (lane & 31)] = tv[i]; } }
    asm volatile("s_waitcnt lgkmcnt(0)" ::: "memory");
    const int c = lane & 7;
#pragma unroll
    for (int j = 0; j < 4; ++j) { const int n = (lane >> 3) + 8 * j; const LAS float* s = scr + (8 * c) * 33 + n;
        v4u o; o.x = pk2(s[0 * 33], s[1 * 33]); o.y = pk2(s[2 * 33], s[3 * 33]); o.z = pk2(s[4 * 33], s[5 * 33]); o.w = pk2(s[6 * 33], s[7 * 33]);
        *(v4u*)(D.wt + (size_t)(D.d0 + n) * D.K + D.k0 + 8 * c) = o; }
    asm volatile("s_waitcnt lgkmcnt(0)" ::: "memory");
}

__device__ __forceinline__ void final_norm_phase(float* h, const float* gain, int gw, int NGW, int lane) {
    for (int m = gw; m < MROWS; m += 8 * NGW) {
        f32x4 v[8][4]; float ss[8];
#pragma unroll
        for (int u = 0; u < 8; ++u) { const f32x4* xr = (const f32x4*)(h + (size_t)(m + u * NGW) * DM) + lane;
#pragma unroll
            for (int j = 0; j < 4; ++j) v[u][j] = xr[64 * j]; }
#pragma unroll
        for (int u = 0; u < 8; ++u) { float s = 0.f;
#pragma unroll
            for (int j = 0; j < 4; ++j) s += (v[u][j].x * v[u][j].x + v[u][j].y * v[u][j].y) + (v[u][j].z * v[u][j].z + v[u][j].w * v[u][j].w);
            ss[u] = 1.f / sqrtf(wave_sum(s) * (1.f / DM) + EPSF); }
        const f32x4* gr = (const f32x4*)gain + lane; f32x4 g[4];
#pragma unroll
        for (int j = 0; j < 4; ++j) g[j] = gr[64 * j];
#pragma unroll
        for (int u = 0; u < 8; ++u) { f32x4* o = (f32x4*)(h + (size_t)(m + u * NGW) * DM) + lane; const float rs = ss[u];
#pragma unroll
            for (int j = 0; j < 4; ++j) o[64 * j] = v[u][j] * rs * g[j]; }
    }
}

__device__ __forceinline__ void cast_stats_phase(const float* src, bf16* dst, float* SS, int gw, int NGW, int lane) {
    for (int m = gw; m < MROWS; m += 8 * NGW) {
        f32x4 v[8][4];
#pragma unroll
        for (int u = 0; u < 8; ++u) { const f32x4* xr = (const f32x4*)(src + (size_t)(m + u * NGW) * DM) + lane;
#pragma unroll
            for (int j = 0; j < 4; ++j) v[u][j] = xr[64 * j]; }
#pragma unroll
        for (int u = 0; u < 8; ++u) { float s = 0.f; unsigned long long* o8 = (unsigned long long*)(dst + (size_t)(m + u * NGW) * DM) + lane;
#pragma unroll
            for (int j = 0; j < 4; ++j) { s += (v[u][j].x * v[u][j].x + v[u][j].y * v[u][j].y) + (v[u][j].z * v[u][j].z + v[u][j].w * v[u][j].w);
                o8[64 * j] = (unsigned long long)pk2(v[u][j].x, v[u][j].y) | ((unsigned long long)pk2(v[u][j].z, v[u][j].w) << 32); }
            s = wave_sum(s); if (lane < 16) SS[(size_t)(m + u * NGW) * 16 + lane] = (lane == 0) ? s : 0.f; }
    }
}
__device__ __forceinline__ void p0_prologue(const Args& A, LAS unsigned char* lds, int wave, int lane) {
    unsigned char* ws = A.ws;
    LAS float* scr = (LAS float*)(lds + wave * 16384);
    const int gw = blockIdx.x * NWAVES + wave, NGW = gridDim.x * NWAVES;
    {   constexpr int I_ABIN = 16 * (AB_IN / 32), I_SQ = 16 * 32, I_NSAIN = 16 * (NSA_INP / 32), I_F13 = 16 * (FFH / 32), I_F2 = (FFH / 64) * 32, I_C1 = 32 * 2, I_C2 = 2;
        constexpr int NITEMS = I_ABIN + I_SQ + I_NSAIN + I_SQ + 4 * I_F13 + 2 * I_F2 + 2 * I_C1 + 2 * I_C2;
        P0Desc D0, D1; float ta[32], tb[32]; int it = gw;
        if (it < NITEMS) { p0_decode(A, ws, it, lane, D0); p0_load(D0, ta, lane); }
        while (it < NITEMS) {
            const int it1 = it + NGW; const bool has1 = it1 < NITEMS;
            if (has1) { p0_decode(A, ws, it1, lane, D1); p0_load(D1, tb, lane); }
            p0_store(D0, ta, scr, lane);
            if (!has1) break;
            const int it2 = it1 + NGW; const bool has2 = it2 < NITEMS;
            if (has2) { p0_decode(A, ws, it2, lane, D0); p0_load(D0, ta, lane); }
            p0_store(D1, tb, scr, lane);
            if (!has2) break;
            it = it2; } }
    {   const int gt = blockIdx.x * NTHREADS + threadIdx.x, NT = gridDim.x * NTHREADS;
        float* rc = (float*)(ws + TAB_RCOS); float* rsn = (float*)(ws + TAB_RSIN); float* nc = (float*)(ws + TAB_NCOS); float* ns = (float*)(ws + TAB_NSIN);
        for (int e = gt; e < 4096 * 40; e += NT) {
            const int pos = e / 40, i = e % 40; double inv;
            if (i < 32) inv = exp(-9.210340371976184 * ((double)i / 32.0));
            else inv = exp(-13.122363377404328 * ((double)(i - 32) / 8.0));
            double tr = (double)pos * inv * 0.15915494309189535; tr -= floor(tr);
            const float ft = (float)tr; const float sv = __builtin_amdgcn_sinf(ft), cv = __builtin_amdgcn_cosf(ft);
            if (i < 32) { rc[pos * 32 + i] = cv; rsn[pos * 32 + i] = sv; } else { nc[pos * 8 + (i - 32)] = cv; ns[pos * 8 + (i - 32)] = sv; }
        }
    }
    {   const int gt = blockIdx.x * NTHREADS + threadIdx.x, NT = gridDim.x * NTHREADS; bf16* GW = (bf16*)(ws + W_GATE);
        for (int e = gt; e < 2 * 8 * 4096; e += NT) { const int gate = e >> 15, r = e & 32767, n = r >> 12, jj = (r >> 6) & 63, ii = r & 63;
            GW[e] = (bf16)f2bf(A.in[gate ? I_GX_W : I_GA_W][n * 4096 + ii * 64 + jj]); } }
    for (int it = gw; it < 64; it += NGW) { const int which = it >> 5, ch = it & 31; const float* pe = A.in[which ? I_PE_V : I_PE_K] + ch * 64; const float* w1 = A.in[which ? I_V_W1 : I_K_W1] + (size_t)ch * 64 * 64 + lane;
        float s = 0.f;
#pragma unroll 16
        for (int k = 0; k < 64; ++k) s += pe[k] * w1[k * 64];
        ((float*)(ws + TAB_CB))[128 + it * 64 + lane] = s; }
    cast_stats_phase(A.in[I_X], (bf16*)(ws + WS_XN), (float*)(ws + WS_SS), gw, NGW, lane);
}

__device__ __forceinline__ float fsigm(float x) { return __builtin_amdgcn_rcpf(1.f + __builtin_amdgcn_exp2f(-LOG2E * x)); }
__device__ __forceinline__ void lru_item(const Args& A, LAS unsigned char* lds, int item, int mode) {
    LAS bf16* WT = (LAS bf16*)lds; LAS float* RAW = (LAS float*)(lds + 18432); LAS bf16* XB = (LAS bf16*)(lds + 18432 + 17408); LAS float* G = (LAS float*)(lds + 18432 + 17408 + 9216);
    LAS float* PH = G + 8192; LAS float* CAR = PH + 1024;
    const int tid = threadIdx.x, lane = tid & 63, j = tid & 63, tg = tid >> 6, w = tg, lr = lane & 15, lq = lane >> 4;
    const int b = item >> 7, n = (item >> 4) & 7, seg = item & 15, c = n * 64 + j;
    const bf16* P0 = (const bf16*)(A.ws + WS_PROJ0); bf16* CAT = (bf16*)(A.ws + WS_CAT); float* LS = (float*)(A.ws + WS_LSUM);
    __syncthreads();
    const float gab = A.in[I_GA_B][c], gxb = A.in[I_GX_B][c], lam = A.in[I_LAM][c];
    const float sp8 = 8.f * LOG2E * log1pf(expf(-lam));
    const float cw0 = A.in[I_CONV_W][c], cw1 = A.in[I_CONV_W][512 + c], cw2 = A.in[I_CONV_W][1024 + c], cw3 = A.in[I_CONV_W][1536 + c], cb = A.in[I_CONV_B][c];
    float carry = 0.f, ptot = 1.f;
    if (mode == 1) { float pp[15], hh[15];
#pragma unroll
        for (int s2 = 0; s2 < 15; ++s2) { pp[s2] = 1.f; hh[s2] = 0.f; if (s2 < seg) { const float* q = LS + ((size_t)(b * 16 + s2) * 512 + c) * 2; pp[s2] = q[0]; hh[s2] = q[1]; } }
#pragma unroll
        for (int s2 = 0; s2 < 15; ++s2) carry = pp[s2] * carry + hh[s2]; }
    if (tg == 0) CAR[j] = carry;
    __syncthreads();
    bf16x8 bfr[4][2];
#pragma unroll
    for (int nt = 0; nt < 4; ++nt)
#pragma unroll
        for (int ks = 0; ks < 2; ++ks) bfr[nt][ks] = *(const bf16x8*)((const bf16*)(A.ws + W_GATE) + (size_t)(((w & 1) * 8 + n) * 64 + 16 * nt + lr) * 64 + 32 * ks + 8 * lq);
    const bf16* xrb = P0 + (size_t)(b * SEQ) * AB_IN + 512 + c;
    bf16 rawn[9];
#pragma unroll
    for (int i = 0; i < 9; ++i) { const int r = tg + 8 * i, t = seg * 256 - 3 + r; rawn[i] = (r < 67 && t >= 0) ? xrb[(size_t)t * AB_IN] : (bf16)0; }
    for (int sub = 0; sub < 4; ++sub) {
        const int t0 = seg * 256 + sub * 64;
        bf16 yv[8];
        if (mode == 1) {
#pragma unroll
            for (int q = 0; q < 8; ++q) yv[q] = P0[((size_t)b * SEQ + t0 + tg * 8 + q) * AB_IN + c]; }
#pragma unroll
        for (int i = 0; i < 9; ++i) { const int r = tg + 8 * i; if (r < 67) RAW[r * 64 + j] = bf2f(rawn[i]); }
        if (sub < 3) {
#pragma unroll
            for (int i = 0; i < 9; ++i) { const int r = tg + 8 * i, t = t0 + 64 - 3 + r; rawn[i] = (r < 67) ? xrb[(size_t)t * AB_IN] : (bf16)0; } }
        __syncthreads();
        float xv[8];
#pragma unroll
        for (int q = 0; q < 8; ++q) { const int tt = tg * 8 + q; const float x = cb + cw0 * RAW[tt * 64 + j] + cw1 * RAW[(tt + 1) * 64 + j] + cw2 * RAW[(tt + 2) * 64 + j] + cw3 * RAW[(tt + 3) * 64 + j]; xv[q] = x; XB[tt * 72 + j] = (bf16)f2bf(x); }
        __syncthreads();
        {
            const int mt = w >> 1; bf16x8 af[2];
#pragma unroll
            for (int ks = 0; ks < 2; ++ks) af[ks] = *(const LAS bf16x8*)(XB + (16 * mt + lr) * 72 + 32 * ks + 8 * lq);
            LAS float* Gw = G + (w & 1) * 4096 + (16 * mt + 4 * lq) * 64 + lr;
#pragma unroll
            for (int nt = 0; nt < 4; ++nt) { f32x4 acc = mfma16(af[0], bfr[nt][0], (f32x4){0.f, 0.f, 0.f, 0.f}); acc = mfma16(af[1], bfr[nt][1], acc);
#pragma unroll
                for (int r = 0; r < 4; ++r) Gw[r * 64 + 16 * nt] = acc[r]; } }
        __syncthreads();
        float av[8], uv[8]; float Pl = 1.f, Hl = 0.f;
#pragma unroll
        for (int q = 0; q < 8; ++q) { const int tt = tg * 8 + q; const float r = fsigm(G[tt * 64 + j] + gab), ig = fsigm(G[4096 + tt * 64 + j] + gxb);
            const float a = __builtin_amdgcn_exp2f(-sp8 * r); const float mult = sqrtf(fmaf(-a, a, 1.f));
            av[q] = a; uv[q] = mult * (ig * xv[q]); Hl = a * Hl + uv[q]; Pl *= a; }
        PH[(tg * 64 + j) * 2] = Pl; PH[(tg * 64 + j) * 2 + 1] = Hl;
        __syncthreads();
        float cin = CAR[j];
        {   float pp[7], hh[7];
#pragma unroll
            for (int g2 = 0; g2 < 7; ++g2) { pp[g2] = PH[(g2 * 64 + j) * 2]; hh[g2] = PH[(g2 * 64 + j) * 2 + 1]; }
#pragma unroll
            for (int g2 = 0; g2 < 7; ++g2) if (g2 < tg) cin = pp[g2] * cin + hh[g2]; }
#pragma unroll
        for (int q = 0; q < 8; ++q) { cin = av[q] * cin + uv[q];
            if (mode == 1) { const size_t row = (size_t)b * SEQ + t0 + tg * 8 + q; const float y = bf2f(yv[q]); const float u = 0.7978845608028654f * (y + 0.044715f * y * y * y);
                CAT[row * DM + c] = (bf16)f2bf(cin * y * fsigm(2.f * u)); } }
        __syncthreads();
        if (tg == 7) { CAR[j] = cin; if (mode == 0) { float pt = 1.f;
#pragma unroll
                for (int g2 = 0; g2 < 8; ++g2) pt *= PH[(g2 * 64 + j) * 2]; ptot *= pt; } }
    }
    if (mode == 0 && tg == 7) { float* q = LS + ((size_t)(b * 16 + seg) * 512 + c) * 2; q[0] = ptot; q[1] = CAR[j]; }
}

__device__ __forceinline__ float ret_log_g(int h) { return log1pf(-exp2f(-5.f - (float)h)); }
__device__ __forceinline__ void ret_kv_load(const bf16* P0, int item, int tid, v4u (&kraw)[2], v4u (&vraw)[2]) {
    const int b = item >> 8, h = (item >> 5) & 7, m = item & 31; const size_t row0 = (size_t)b * SEQ + m * 128;
#pragma unroll
    for (int rep = 0; rep < 2; ++rep) { const bf16* rp = P0 + (row0 + (tid >> 3) + 64 * rep) * AB_IN + h * 64 + 8 * (tid & 7); kraw[rep] = *(const v4u*)(rp + 1536); vraw[rep] = *(const v4u*)(rp + 2048); }
}
__device__ __forceinline__ void ret_kv_run(const Args& A, LAS unsigned char* lds, int first, int stride, int end) {
    LAS bf16* VT = (LAS bf16*)lds; LAS bf16* KT = VT + 64 * 136;
    const int tid = threadIdx.x, lane = tid & 63, w = tid >> 6, lr = lane & 15, lq = lane >> 4;
    const bf16* P0 = (const bf16*)(A.ws + WS_PROJ0); float* KVT = (float*)(A.ws + WS_KVT);
    v4u kraw[2], vraw[2];
    if (first < end) ret_kv_load(P0, first, tid, kraw, vraw);
    for (int item = first; item < end; item += stride) {
        const int b = item >> 8, h = (item >> 5) & 7, m = item & 31; const float l2g = ret_log_g(h) * LOG2E;
        __syncthreads();
#pragma unroll
        for (int rep = 0; rep < 2; ++rep) { const int jj = (tid >> 3) + 64 * rep, e8 = tid & 7; const float dec = __builtin_amdgcn_exp2f((float)(127 - jj) * l2g);
            const unsigned kw[4] = {kraw[rep].x, kraw[rep].y, kraw[rep].z, kraw[rep].w}, vw[4] = {vraw[rep].x, vraw[rep].y, vraw[rep].z, vraw[rep].w};
#pragma unroll
            for (int i = 0; i < 4; ++i) { VT[(8 * e8 + 2 * i) * 136 + jj] = (bf16)(vw[i] & 0xffffu); VT[(8 * e8 + 2 * i + 1) * 136 + jj] = (bf16)(vw[i] >> 16);
                KT[(8 * e8 + 2 * i) * 136 + jj] = (bf16)f2bf(bf2f((bf16)(kw[i] & 0xffffu)) * dec); KT[(8 * e8 + 2 * i + 1) * 136 + jj] = (bf16)f2bf(bf2f((bf16)(kw[i] >> 16)) * dec); } }
        if (item + stride < end) ret_kv_load(P0, item + stride, tid, kraw, vraw);
        __syncthreads();
        const int et = w >> 1, dt0 = (w & 1) * 2; f32x4 acc[2] = {(f32x4){0.f, 0.f, 0.f, 0.f}, (f32x4){0.f, 0.f, 0.f, 0.f}};
#pragma unroll
        for (int ks = 0; ks < 4; ++ks) { const bf16x8 af = *(const LAS bf16x8*)(VT + (16 * et + lr) * 136 + 32 * ks + 8 * lq);
#pragma unroll
            for (int dd = 0; dd < 2; ++dd) { const bf16x8 bfr = *(const LAS bf16x8*)(KT + (16 * (dt0 + dd) + lr) * 136 + 32 * ks + 8 * lq); acc[dd] = mfma16(af, bfr, acc[dd]); } }
        float* o = KVT + ((size_t)((b * 8 + h) * 32 + m)) * 4096;
#pragma unroll
        for (int dd = 0; dd < 2; ++dd)
#pragma unroll
            for (int r = 0; r < 4; ++r) o[(16 * et + 4 * lq + r) * 64 + 16 * (dt0 + dd) + lr] = acc[dd][r];
    }
}
constexpr int VT_LD = 136, ST_LD = 72, PW_LD = 72;
struct RetPre { v4u vraw[2]; f32x4 ka, kc; };
__device__ __forceinline__ void ret_out_pre(const Args& A, int item, bool first, RetPre& R) {
    const int tid = threadIdx.x, b = item >> 8, h = (item >> 5) & 7, n = item & 31; const bf16* P0 = (const bf16*)(A.ws + WS_PROJ0); const float* KVT = (const float*)(A.ws + WS_KVT); const size_t row0 = (size_t)b * SEQ + n * 128;
#pragma unroll
    for (int rep = 0; rep < 2; ++rep) R.vraw[rep] = *(const v4u*)(P0 + (row0 + (tid >> 3) + 64 * rep) * AB_IN + 2048 + h * 64 + 8 * (tid & 7));
    const float* kp = KVT + ((size_t)((b * 8 + h) * 32)) * 4096 + tid * 8; R.ka = (f32x4){0.f, 0.f, 0.f, 0.f}; R.kc = R.ka;
    if (!first) { R.ka = *(const f32x4*)(kp + (size_t)(n - 1) * 4096); R.kc = *(const f32x4*)(kp + (size_t)(n - 1) * 4096 + 4); }
}
__device__ __forceinline__ void ret_out_item(const Args& A, LAS unsigned char* lds, int item, bool first, RetPre& R, int next_item, bool next_first) {
    LAS bf16* VT = (LAS bf16*)lds;
    LAS bf16* STT = VT + 64 * VT_LD;
    LAS bf16* PWall = STT + 64 * ST_LD;
    const int tid = threadIdx.x, lane = tid & 63, w = tid >> 6, lr = lane & 15, lq = lane >> 4, b = item >> 8, h = (item >> 5) & 7, n = item & 31;
    const bf16* P0 = (const bf16*)(A.ws + WS_PROJ0); const float* KVT = (const float*)(A.ws + WS_KVT); bf16* CAT = (bf16*)(A.ws + WS_CAT);
    const float lg = ret_log_g(h), l2g = lg * LOG2E;
    const size_t row0 = (size_t)b * SEQ + n * 128;
    const v4u vraw[2] = {R.vraw[0], R.vraw[1]}; const f32x4 ka = R.ka, kc = R.kc;
    const float* kp = KVT + ((size_t)((b * 8 + h) * 32)) * 4096 + tid * 8;
    bf16x8 qa[2], kf[2][4][2];
#pragma unroll
    for (int ks = 0; ks < 2; ++ks) qa[ks] = *(const bf16x8*)(P0 + (row0 + 16 * w + lr) * AB_IN + 1024 + h * 64 + 32 * ks + 8 * lq);
    const int ntile = (w >= 4) ? 2 : 1;
#pragma unroll
    for (int jt = 0; jt < 2; ++jt) if (jt < ntile) {
#pragma unroll
        for (int nt = 0; nt < 4; ++nt) { const bf16* kq = P0 + (row0 + 64 * jt + 16 * nt + lr) * AB_IN + 1536 + h * 64 + 8 * lq; kf[jt][nt][0] = *(const bf16x8*)kq; kf[jt][nt][1] = *(const bf16x8*)(kq + 32); } }
    bf16 gv[4][4];
#pragma unroll
    for (int r = 0; r < 4; ++r)
#pragma unroll
        for (int ct = 0; ct < 4; ++ct) gv[r][ct] = P0[(row0 + 16 * w + lq * 4 + r) * AB_IN + 2560 + h * 64 + 16 * ct + lr];
    __syncthreads();
#pragma unroll
    for (int rep = 0; rep < 2; ++rep) { const int jj = (tid >> 3) + 64 * rep, e8 = tid & 7; const unsigned wv[4] = {vraw[rep].x, vraw[rep].y, vraw[rep].z, vraw[rep].w};
#pragma unroll
        for (int i = 0; i < 4; ++i) { VT[(8 * e8 + 2 * i) * VT_LD + jj] = (bf16)(wv[i] & 0xffffu); VT[(8 * e8 + 2 * i + 1) * VT_LD + jj] = (bf16)(wv[i] >> 16); } }
    {   LAS float* SF = (LAS float*)(PWall + 8 * 16 * PW_LD);
        float st[8]; const float cd = expf(128.f * lg);
        if (first) {
#pragma unroll
            for (int i = 0; i < 8; ++i) st[i] = 0.f;
            int m = 0;
            for (; m + 4 <= n; m += 4) { f32x4 a[4], c[4];
#pragma unroll
                for (int u = 0; u < 4; ++u) { a[u] = *(const f32x4*)(kp + (size_t)(m + u) * 4096); c[u] = *(const f32x4*)(kp + (size_t)(m + u) * 4096 + 4); }
#pragma unroll
                for (int u = 0; u < 4; ++u) { st[0] = st[0] * cd + a[u].x; st[1] = st[1] * cd + a[u].y; st[2] = st[2] * cd + a[u].z; st[3] = st[3] * cd + a[u].w; st[4] = st[4] * cd + c[u].x; st[5] = st[5] * cd + c[u].y; st[6] = st[6] * cd + c[u].z; st[7] = st[7] * cd + c[u].w; } }
            for (; m < n; ++m) { const f32x4 a = *(const f32x4*)(kp + (size_t)m * 4096), c = *(const f32x4*)(kp + (size_t)m * 4096 + 4);
                st[0] = st[0] * cd + a.x; st[1] = st[1] * cd + a.y; st[2] = st[2] * cd + a.z; st[3] = st[3] * cd + a.w; st[4] = st[4] * cd + c.x; st[5] = st[5] * cd + c.y; st[6] = st[6] * cd + c.z; st[7] = st[7] * cd + c.w; }
        } else {
            const f32x4 p0 = *(const LAS f32x4*)(SF + tid * 8), p1 = *(const LAS f32x4*)(SF + tid * 8 + 4);
            st[0] = p0.x * cd + ka.x; st[1] = p0.y * cd + ka.y; st[2] = p0.z * cd + ka.z; st[3] = p0.w * cd + ka.w; st[4] = p1.x * cd + kc.x; st[5] = p1.y * cd + kc.y; st[6] = p1.z * cd + kc.z; st[7] = p1.w * cd + kc.w; }
        *(LAS f32x4*)(SF + tid * 8) = (f32x4){st[0], st[1], st[2], st[3]}; *(LAS f32x4*)(SF + tid * 8 + 4) = (f32x4){st[4], st[5], st[6], st[7]};
        const int e = tid >> 3, d0 = (tid & 7) * 8; v4u o; o.x = pk2(st[0], st[1]); o.y = pk2(st[2], st[3]); o.z = pk2(st[4], st[5]); o.w = pk2(st[6], st[7]);
        *(LAS v4u*)(STT + e * ST_LD + d0) = o; }
    __syncthreads();
    if (next_item >= 0) ret_out_pre(A, next_item, next_first, R);
    LAS bf16* PW = PWall + w * 16 * PW_LD;
    f32x4 O1[4], O2[4];
#pragma unroll
    for (int ct = 0; ct < 4; ++ct) { O1[ct] = (f32x4){0.f, 0.f, 0.f, 0.f}; O2[ct] = (f32x4){0.f, 0.f, 0.f, 0.f}; }
#pragma unroll
    for (int jt = 0; jt < 2; ++jt) if (jt < ntile) {
        f32x4 s[4];
#pragma unroll
        for (int nt = 0; nt < 4; ++nt) { s[nt] = mfma16(qa[0], kf[jt][nt][0], (f32x4){0.f, 0.f, 0.f, 0.f}); s[nt] = mfma16(qa[1], kf[jt][nt][1], s[nt]); }
#pragma unroll
        for (int nt = 0; nt < 4; ++nt)
#pragma unroll
            for (int r = 0; r < 4; ++r) { const int i = 16 * w + lq * 4 + r, jj = 64 * jt + 16 * nt + lr, dd = i - jj;
                const float p = (dd >= 0) ? s[nt][r] * __builtin_amdgcn_exp2f((float)dd * l2g) : 0.f; PW[(lq * 4 + r) * PW_LD + 16 * nt + lr] = (bf16)f2bf(p); }
        bf16x8 pa[2];
#pragma unroll
        for (int ks = 0; ks < 2; ++ks) pa[ks] = *(const LAS bf16x8*)(PW + lr * PW_LD + 32 * ks + 8 * lq);
#pragma unroll
        for (int ct = 0; ct < 4; ++ct)
#pragma unroll
            for (int ks = 0; ks < 2; ++ks) { const bf16x8 vb = *(const LAS bf16x8*)(VT + (16 * ct + lr) * VT_LD + 64 * jt + 32 * ks + 8 * lq); O1[ct] = mfma16(pa[ks], vb, O1[ct]); }
    }
#pragma unroll
    for (int ct = 0; ct < 4; ++ct)
#pragma unroll
        for (int ks = 0; ks < 2; ++ks) { const bf16x8 sb = *(const LAS bf16x8*)(STT + (16 * ct + lr) * ST_LD + 32 * ks + 8 * lq); O2[ct] = mfma16(qa[ks], sb, O2[ct]); }
#pragma unroll
    for (int r = 0; r < 4; ++r) { const int i = 16 * w + lq * 4 + r; const float qd = __builtin_amdgcn_exp2f((float)(i + 1) * l2g);
        float o[4]; float sm = 0.f;
#pragma unroll
        for (int ct = 0; ct < 4; ++ct) { o[ct] = O1[ct][r] + qd * O2[ct][r]; sm += o[ct]; }
        const float mean = gsum16(sm) * (1.f / 64.f); float vs = 0.f;
#pragma unroll
        for (int ct = 0; ct < 4; ++ct) { o[ct] -= mean; vs += o[ct] * o[ct]; }
        const float rstd = 1.f / sqrtf(gsum16(vs) * (1.f / 64.f) + EPSF);
        const size_t row = row0 + i;
#pragma unroll
        for (int ct = 0; ct < 4; ++ct) { const int e = 16 * ct + lr; const float g = bf2f(gv[r][ct]); CAT[row * DM + 512 + h * 64 + e] = (bf16)f2bf(o[ct] * rstd * (g * sigm(g))); } }
}
__device__ __forceinline__ void cmp_bias_to_lds(const Args& A, LAS unsigned char* lds) {
    const float* CB = (const float*)(A.ws + TAB_CB); const int tid = threadIdx.x;
    if (tid < 128) { float s = 0.f;
#pragma unroll
        for (int ch = 0; ch < 32; ++ch) s += CB[128 + ((tid >> 6) * 32 + ch) * 64 + (tid & 63)];
        ((LAS float*)(lds + 40960))[tid] = s; }
    __syncthreads();
}
__device__ __forceinline__ void cmp_item(const Args& A, LAS unsigned char* lds, int item) {
    LAS float* RED = (LAS float*)lds; LAS bf16* HID = (LAS bf16*)(lds + 32768);
    const int tid = threadIdx.x, lane = tid & 63, w = tid >> 6, lr = lane & 15, lq = lane >> 4;
    const int cgrp = item & 3, kv = (item >> 2) & 1, g = (item >> 3) & 3, b = item >> 5;
    const bf16* W1T = (const bf16*)(A.ws + (kv ? W_CV1 : W_CK1)); const bf16* W2T = (const bf16*)(A.ws + (kv ? W_CV2 : W_CK2)); const bf16* KV6 = (const bf16*)(A.ws + WS_KV6);
    bf16* KC = (bf16*)(A.ws + WS_KC); bf16* VCT = (bf16*)(A.ws + WS_VCT); const float* NC = (const float*)(A.ws + TAB_NCOS); const float* NS = (const float*)(A.ws + TAB_NSIN);
    bf16x8 bw[4][2][4];
#pragma unroll
    for (int lt = 0; lt < 4; ++lt)
#pragma unroll
        for (int ks = 0; ks < 2; ++ks)
#pragma unroll
            for (int nt = 0; nt < 4; ++nt) bw[lt][ks][nt] = *(const bf16x8*)(W1T + (size_t)(16 * nt + lr) * 2048 + (4 * w + lt) * 64 + 32 * ks + 8 * lq);
    bf16x8 w2f[2] = {(bf16x8){0, 0, 0, 0, 0, 0, 0, 0}, (bf16x8){0, 0, 0, 0, 0, 0, 0, 0}};
    if (w < 4) {
#pragma unroll
        for (int ks = 0; ks < 2; ++ks) w2f[ks] = *(const bf16x8*)(W2T + (16 * w + lr) * 64 + 32 * ks + 8 * lq); }
    bf16x8 af[4][2];
#define CMP_LOADA(ct_) do { const int c_ = 16 * (ct_) + lr; _Pragma("unroll") for (int lt = 0; lt < 4; ++lt) { int tok = 16 * c_ + 4 * w + lt; tok = tok > SEQ - 1 ? SEQ - 1 : tok; \
        const bf16* arow = KV6 + ((size_t)b * SEQ + tok) * 1536 + kv * 256 + g * 64; _Pragma("unroll") for (int ks = 0; ks < 2; ++ks) af[lt][ks] = *(const bf16x8*)(arow + 32 * ks + 8 * lq); } } while (0)
    CMP_LOADA(4 * cgrp);
    for (int ti = 0; ti < 4; ++ti) { const int ctile = 4 * cgrp + ti;
        f32x4 acc[4];
#pragma unroll
        for (int nt = 0; nt < 4; ++nt) acc[nt] = (f32x4){0.f, 0.f, 0.f, 0.f};
#pragma unroll
        for (int lt = 0; lt < 4; ++lt)
#pragma unroll
            for (int ks = 0; ks < 2; ++ks)
#pragma unroll
                for (int nt = 0; nt < 4; ++nt) acc[nt] = mfma16(af[lt][ks], bw[lt][ks][nt], acc[nt]);
        __syncthreads();
        if (ti < 3) CMP_LOADA(ctile + 1);
#pragma unroll
        for (int nt = 0; nt < 4; ++nt)
#pragma unroll
            for (int r = 0; r < 4; ++r) RED[(w * 16 + lq * 4 + r) * 64 + 16 * nt + lr] = acc[nt][r];
        __syncthreads();
#pragma unroll
        for (int rep = 0; rep < 2; ++rep) { const int e = tid + rep * NTHREADS, row = e >> 6, col = e & 63; float s = ((const LAS float*)(lds + 40960))[kv * 64 + col];
#pragma unroll
            for (int w2 = 0; w2 < 8; ++w2) s += RED[(w2 * 16 + row) * 64 + col];
            HID[row * 72 + col] = (bf16)f2bf(gelu_tanh(s)); }
        __syncthreads();
        if (w < 4) {
            f32x4 o = (f32x4){0.f, 0.f, 0.f, 0.f};
#pragma unroll
            for (int ks = 0; ks < 2; ++ks) { const bf16x8 a = *(const LAS bf16x8*)(HID + lr * 72 + 32 * ks + 8 * lq); o = mfma16(a, w2f[ks], o); }
#pragma unroll
            for (int r = 0; r < 4; ++r) { const int cc = 16 * ctile + lq * 4 + r, dim = 16 * w + lr; float val = o[r];
                if (kv == 0) {
                    if (w == 0) { const float partner = DPPF(val, 0x128);   int pos = 16 * cc + 31; pos = pos > SEQ - 1 ? SEQ - 1 : pos; const int f = lr & 7; const float cs = NC[pos * 8 + f], sn = NS[pos * 8 + f];
                        val = (lr < 8) ? (val * cs - partner * sn) : (val * cs + partner * sn); }
                    KC[((size_t)(b * 256 + cc) * 4 + g) * 64 + dim] = (bf16)f2bf(val);
                } else VCT[((size_t)(b * 4 + g) * 64 + dim) * 256 + cc] = (bf16)f2bf(val); }
        }
    }
#undef CMP_LOADA
}
typedef float f32x2 __attribute__((ext_vector_type(2))); typedef __bf16 bf16x2_t __attribute__((ext_vector_type(2)));
__device__ __forceinline__ unsigned cvtpk(float lo, float hi) { f32x2 v = {lo, hi}; bf16x2_t b = __builtin_convertvector(v, bf16x2_t); return __builtin_bit_cast(unsigned, b); }
__device__ __forceinline__ float vmax3(float a, float b, float c) { float r; asm("v_max3_f32 %0, %1, %2, %3" : "=v"(r) : "v"(a), "v"(b), "v"(c)); return r; }
__device__ __forceinline__ float vmax2(float a, float b) { float r; asm("v_max_f32_e32 %0, %1, %2" : "=v"(r) : "v"(a), "v"(b)); return r; }
__device__ __forceinline__ float colmax4(float v) {
    auto a = __builtin_amdgcn_permlane16_swap(__float_as_uint(v), __float_as_uint(v), false, false); v = vmax2(__uint_as_float(a[0]), __uint_as_float(a[1]));
    auto c = __builtin_amdgcn_permlane32_swap(__float_as_uint(v), __float_as_uint(v), false, false); return vmax2(__uint_as_float(c[0]), __uint_as_float(c[1])); }
__device__ __forceinline__ float colsum4(float v) { return rows4_sum(v); }
struct NsaSt { float mhat[2], l[2], invl[2]; f32x4 O[4][2]; };
template <int MODE>
__device__ __forceinline__ void nsa_softmax(NsaSt& S, f32x4 (&st)[4], const int nq, const int klo, const int khi, const bool colok, const int kb, LAS float* PSrow, const int lr, const int lq, bf16x8& p0, bf16x8& p1) {
    if (MODE <= 2) {
        const unsigned span = (khi >= klo) ? (unsigned)(khi - klo) : 0u; const int base = (khi >= klo) ? kb - klo : -0x40000000;
#pragma unroll
        for (int mt = 0; mt < 4; ++mt)
#pragma unroll
            for (int r = 0; r < 4; ++r) { const bool ok = (unsigned)(base + 32 * (mt >> 1) + 4 * (mt & 1) + r) <= span; st[mt][r] = ok ? st[mt][r] : NEGF; } }
    if (MODE != 1) {
        float a = st[0][0];
        asm volatile("s_nop 15\n\ts_nop 1\n\tv_max3_f32 %0, %0, %1, %2\n\tv_max3_f32 %0, %0, %3, %4\n\tv_max3_f32 %0, %0, %5, %6\n\tv_max3_f32 %0, %0, %7, %8\n\tv_max3_f32 %0, %0, %9, %10\n\tv_max3_f32 %0, %0, %11, %12\n\tv_max3_f32 %0, %0, %13, %14\n\tv_max_f32_e32 %0, %0, %15"
                     : "+v"(a) : "v"(st[0][1]), "v"(st[0][2]), "v"(st[0][3]), "v"(st[1][0]), "v"(st[1][1]), "v"(st[1][2]), "v"(st[1][3]), "v"(st[2][0]), "v"(st[2][1]), "v"(st[2][2]),
                       "v"(st[2][3]), "v"(st[3][0]), "v"(st[3][1]), "v"(st[3][2]), "v"(st[3][3]));
        a = colok ? a : NEGF; const float tmax = colmax4(a);
        if (__any(tmax > 8.f)) { const float dl = (tmax > 8.f) ? tmax : 0.f, f = __builtin_amdgcn_exp2f(-dl); S.mhat[nq] += dl; S.l[nq] *= f;
#pragma unroll
            for (int mt = 0; mt < 4; ++mt) st[mt] -= dl;
            if (MODE >= 2) {
#pragma unroll
                for (int ct = 0; ct < 4; ++ct) S.O[ct][nq] *= f; } }
    }
#pragma unroll
    for (int mt = 0; mt < 4; ++mt)
#pragma unroll
        for (int r = 0; r < 4; ++r) st[mt][r] = __builtin_amdgcn_exp2f(st[mt][r]);
    if (MODE == 1) {
#pragma unroll
        for (int mt = 0; mt < 4; ++mt) st[mt] *= S.invl[nq];
#pragma unroll
        for (int mt = 0; mt < 4; ++mt) { f32x4 hs = st[mt];
#pragma unroll
            for (int r = 0; r < 4; ++r) hs[r] = qsum4(hs[r]);
            if ((lr & 3) == 0) *(LAS f32x4*)(PSrow + (4 * nq + (lr >> 2)) * 256 + 32 * (mt >> 1) + 4 * (mt & 1) + 8 * lq) = hs; }
    } else { f32x2 a2 = (f32x2){st[0][0], st[0][1]} + (f32x2){st[0][2], st[0][3]};
#pragma unroll
        for (int mt = 1; mt < 4; ++mt) { a2 += (f32x2){st[mt][0], st[mt][1]}; a2 += (f32x2){st[mt][2], st[mt][3]}; }
        const float ls = a2.x + a2.y; S.l[nq] += colok ? ls : 0.f; }
    if (MODE >= 1) {
#pragma unroll
        for (int kk = 0; kk < 2; ++kk) { const f32x4 a = st[2 * kk], c = st[2 * kk + 1]; v4u pk; pk.x = cvtpk(a[0], a[1]); pk.y = cvtpk(a[2], a[3]); pk.z = cvtpk(c[0], c[1]); pk.w = cvtpk(c[2], c[3]);
            if (MODE >= 2 && !colok) pk = (v4u){0u, 0u, 0u, 0u};
            if (kk == 0) p0 = __builtin_bit_cast(bf16x8, pk); else p1 = __builtin_bit_cast(bf16x8, pk); } }
}
template <int MODE>
__device__ __forceinline__ void nsa_full(NsaSt& S, const bf16x8 (&qf)[2][2], const LAS unsigned char* kbuf, const int koff, const int voff, const int klo0, const int klo1, const int khi0, const int khi1, const bool col0, const bool col1,
                                          const int kb, LAS float* PSrow, const int lr, const int lq) {
    bf16x8 kf[4][2];
#pragma unroll
    for (int mt = 0; mt < 4; ++mt) { kf[mt][0] = *(const LAS bf16x8*)(kbuf + 4096 * (mt >> 1) + 512 * (mt & 1) + koff); kf[mt][1] = *(const LAS bf16x8*)(kbuf + 4096 * (mt >> 1) + 512 * (mt & 1) + (koff ^ 64)); }
    f32x4 st0[4], st1[4];
    {   const float n0 = -S.mhat[0], n1 = -S.mhat[1]; const f32x4 negm0 = (f32x4){n0, n0, n0, n0}, negm1 = (f32x4){n1, n1, n1, n1};
#pragma unroll
        for (int mt = 0; mt < 4; ++mt) st0[mt] = mfma16(kf[mt][0], qf[0][0], negm0);
#pragma unroll
        for (int mt = 0; mt < 4; ++mt) st0[mt] = mfma16(kf[mt][1], qf[0][1], st0[mt]);
#pragma unroll
        for (int mt = 0; mt < 4; ++mt) st1[mt] = mfma16(kf[mt][0], qf[1][0], negm1);
#pragma unroll
        for (int mt = 0; mt < 4; ++mt) st1[mt] = mfma16(kf[mt][1], qf[1][1], st1[mt]); }
    __builtin_amdgcn_sched_barrier(0);
    bf16x8 p0, p1; bf16x8 vf[4][2];
    nsa_softmax<MODE>(S, st0, 0, klo0, khi0, col0, kb, PSrow, lr, lq, p0, p1);
    if (MODE >= 1) {
        const LAS unsigned char* vbuf = kbuf + 8192;
#pragma unroll
        for (int ct = 0; ct < 4; ++ct)
#pragma unroll
            for (int kk = 0; kk < 2; ++kk) vf[ct][kk] = *(const LAS bf16x8*)(vbuf + 2048 * ct + (voff ^ (64 * kk)));
#pragma unroll
        for (int ct = 0; ct < 4; ++ct) { S.O[ct][0] = mfma16(vf[ct][0], p0, S.O[ct][0]); S.O[ct][0] = mfma16(vf[ct][1], p1, S.O[ct][0]); } }
    __builtin_amdgcn_sched_barrier(0);
    nsa_softmax<MODE>(S, st1, 1, klo1, khi1, col1, kb, PSrow, lr, lq, p0, p1);
    if (MODE >= 1) {
#pragma unroll
        for (int ct = 0; ct < 4; ++ct) { S.O[ct][1] = mfma16(vf[ct][0], p0, S.O[ct][1]); S.O[ct][1] = mfma16(vf[ct][1], p1, S.O[ct][1]); } }
}
__device__ __forceinline__ void nsa_item2(const Args& A, LAS unsigned char* lds, int item) {
    const int tid = threadIdx.x, lane = tid & 63, w = tid >> 6, lr = lane & 15, lq = lane >> 4;
    const int qt = item >> 5, b = (item >> 2) & 7, g = item & 3, t0 = qt * 64, cur = qt;
    const bf16* Qb = (const bf16*)(A.ws + WS_Q); const bf16* KV6 = (const bf16*)(A.ws + WS_KV6); const bf16* KC = (const bf16*)(A.ws + WS_KC); const bf16* VCT = (const bf16*)(A.ws + WS_VCT);
    const bf16* VTS = (const bf16*)(A.ws + WS_VTS); const bf16* VTW = (const bf16*)(A.ws + WS_VTW); const float* GT = (const float*)(A.ws + WS_GATES); bf16* ATT = (bf16*)(A.ws + WS_CAT);
    LAS float* PS = (LAS float*)(lds + 65536) + w * 2048;
    const int head = 4 * g + (lr & 3);
#define NSA_QPOS(nq_) (t0 + 8 * w + 4 * (nq_) + (lr >> 2))
    bf16x8 qf[2][2]; float gtv[2][3];
#pragma unroll
    for (int nq = 0; nq < 2; ++nq) { const size_t row = (size_t)b * SEQ + NSA_QPOS(nq);
#pragma unroll
        for (int ks = 0; ks < 2; ++ks) qf[nq][ks] = *(const bf16x8*)(Qb + row * 1024 + head * 64 + 32 * ks + 8 * lq);
#pragma unroll
        for (int i = 0; i < 3; ++i) gtv[nq][i] = GT[row * 48 + head * 3 + i]; }
    const int ncv = ((t0 + 63 - 31) >> 4) + 1, ncmp = (ncv + 63) >> 6;
    const int lo = cur >= 8 ? cur - 8 : 0;
    const int n1 = ncmp, n2 = 2 * ncmp, n3 = n2 + cur + 1, n4 = n3 + (cur - lo + 1);
    const int srow = 8 * w + (lane >> 3), schv = (lane & 7) ^ ((srow >> 1) & 7), schk = (lane & 7) ^ (((srow & 3) >> 1) | (((srow >> 3) & 3) << 1));
    const bf16* kcb = KC + ((size_t)(b * 256) * 4 + g) * 64; const bf16* vcb = VCT + (size_t)((b * 4 + g) * 64) * 256;
    const bf16* ksb = KV6 + (size_t)b * SEQ * 1536 + 2 * 256 + g * 64; const bf16* kwb = ksb + 2 * 256;
    const bf16* vsb = VTS + (size_t)((b * 4 + g) * 64) * SEQ; const bf16* vwb = VTW + (size_t)((b * 4 + g) * 64) * SEQ;
    const unsigned sk16 = (unsigned)schk * 16u, sv16 = (unsigned)schv * 16u, srw = (unsigned)srow;
    const unsigned lds0 = (unsigned)(unsigned long)lds + (unsigned)w * 1024u;
#define NSA_GATE(nq_, i_) (gtv[nq_][i_])
#define NSA_GLDS(gp_, vo_, la_) do { unsigned keep_; asm volatile("s_mov_b32 %0, m0\n\ts_mov_b32 m0, %3\n\ts_nop 0\n\tglobal_load_lds_dwordx4 %1, %2\n\ts_mov_b32 m0, %0" : "=&s"(keep_) : "v"(vo_), "s"(gp_), "s"(la_) : "memory"); } while (0)
#define NSA_ISSUE(s_, slot_) do { const int s__ = (s_); const bf16* kp_; const bf16* vp_; unsigned ko_, vo_; \
        if (s__ < n2) { const int kt_ = s__ < n1 ? s__ : s__ - n1; kp_ = kcb + (size_t)(64 * kt_) * 256; vp_ = vcb + 64 * kt_; ko_ = srw * 512u + sk16; vo_ = srw * 512u + sv16; } \
        else if (s__ < n3) { const int kt_ = s__ - n2; kp_ = ksb + (size_t)(64 * kt_) * 1536; vp_ = vsb + 64 * kt_; ko_ = srw * 3072u + sk16; vo_ = srw * 8192u + sv16; } \
        else { const int kt_ = lo + s__ - n3; kp_ = kwb + (size_t)(64 * kt_) * 1536; vp_ = vwb + 64 * kt_; ko_ = srw * 3072u + sk16; vo_ = srw * 8192u + sv16; } \
        const unsigned la_ = (unsigned)__builtin_amdgcn_readfirstlane(lds0 + (unsigned)(slot_) * 16384u); NSA_GLDS(kp_, ko_, la_); NSA_GLDS(vp_, vo_, la_ + 8192u); } while (0)
#define NSA_WAITBAR(N) asm volatile("s_waitcnt vmcnt(" #N ") lgkmcnt(0)\n\ts_barrier" ::: "memory")
    asm volatile("s_waitcnt vmcnt(0)" ::: "memory");
    __syncthreads();
#pragma unroll
    for (int i = 0; i < 8; ++i) *(LAS f32x4*)(PS + (i * 64 + lane) * 4) = (f32x4){0.f, 0.f, 0.f, 0.f};
    NSA_ISSUE(0, 0);
    NsaSt S;
    LAS f32x4* OUTL = (LAS f32x4*)PS + lane;
#pragma unroll
    for (int nq = 0; nq < 2; ++nq) { S.mhat[nq] = 0.f; S.l[nq] = 0.f; S.invl[nq] = 0.f;
#pragma unroll
        for (int ct = 0; ct < 4; ++ct) S.O[ct][nq] = (f32x4){0.f, 0.f, 0.f, 0.f}; }
    unsigned long long mym[2] = {0ull, 0ull};
#pragma unroll
    for (int nq = 0; nq < 2; ++nq)
#pragma unroll
        for (int ks = 0; ks < 2; ++ks) asm volatile("" : "+v"(qf[nq][ks]));
#pragma unroll
    for (int nq = 0; nq < 2; ++nq)
#pragma unroll
        for (int i = 0; i < 3; ++i) asm volatile("" : "+v"(gtv[nq][i]));
    NSA_WAITBAR(0);
    const int xk = ((lr & 3) >> 1) | ((lr >> 2) << 1), xv = (lr >> 1) & 7;
    const int koff = (8 * (lr >> 2) + (lr & 3)) * 128 + ((lq ^ xk) << 4);
    const int voff = lr * 128 + ((lq ^ xv) << 4);
    const int wi0 = n3 + (cur >= 8 ? 1 : 0);
#define NSA_GSZ(t_) (((t_) >= n4) ? 0 : (((t_) >= n2 && (t_) < n3 - 1) ? (((t_) + 1 < n3 - 1) ? 2 : 1) : (((t_) >= wi0 && (t_) < n4 - 1) ? (((t_) + 1 < n4 - 1) ? 2 : 1) : 1)))
#define NSA_TILE(MODE_, s_, slot_, kt_, PSrow_) do { const int s__s = (s_), kt__ = (kt_); const LAS unsigned char* kbuf = lds + (slot_) * 16384; const int kb = 64 * kt__ + 8 * lq; \
        int klo0, klo1, khi0, khi1; bool col0 = true, col1 = true; { const int qp0 = NSA_QPOS(0), qp1 = NSA_QPOS(1); \
            if (MODE_ < 2) { klo0 = 0; klo1 = 0; khi0 = (qp0 >= 31) ? ((qp0 - 31) >> 4) : -1; khi1 = (qp1 >= 31) ? ((qp1 - 31) >> 4) : -1; } \
            else if (s__s < n3) { col0 = (mym[0] >> kt__) & 1ull; col1 = (mym[1] >> kt__) & 1ull; klo0 = 0; klo1 = 0; khi0 = qp0; khi1 = qp1; } \
            else { klo0 = qp0 - 511; klo1 = qp1 - 511; khi0 = qp0; khi1 = qp1; } } \
        nsa_full<MODE_>(S, qf, kbuf, koff, voff, klo0, klo1, khi0, khi1, col0, col1, kb, (PSrow_), lr, lq); } while (0)
#define NSA_NEXT(t_, z_) do { const int nt_ = (t_) + (z_), z2_ = NSA_GSZ(nt_); if (z2_ >= 1) NSA_ISSUE(nt_, 2 * (gp ^ 1)); if (z2_ >= 2) NSA_ISSUE(nt_ + 1, 2 * (gp ^ 1) + 1); } while (0)
#define NSA_STEP(MODE_, s_, kt_, PSrow_) do { NSA_NEXT((s_), 1); NSA_TILE(MODE_, (s_), 2 * gp, (kt_), (PSrow_)); NSA_WAITBAR(0); gp ^= 1; } while (0)
#define NSA_PAIR(MODE_, s_, kt_) do { NSA_NEXT((s_), 2); NSA_TILE(MODE_, (s_), 2 * gp, (kt_), PS); NSA_TILE(MODE_, (s_) + 1, 2 * gp + 1, (kt_) + 1, PS); NSA_WAITBAR(0); gp ^= 1; } while (0)
    int gp = 0;
    for (int s = 0; s < n1; ++s) NSA_STEP(0, s, s, PS);
#pragma unroll
    for (int nq = 0; nq < 2; ++nq) { const float lf = colsum4(S.l[nq]); S.invl[nq] = lf > 0.f ? 1.f / lf : 0.f; }
    for (int s = n1; s < n2; ++s) NSA_STEP(1, s, s - n1, PS + 64 * (s - n1));
    {
        unsigned uk[8], pref[8];
#pragma unroll
        for (int qi = 0; qi < 8; ++qi) { const int j = lane, qp = t0 + 8 * w + qi; const LAS float* base = PS + qi * 256;
            float imp = base[4 * j] + base[4 * j + 1] + base[4 * j + 2] + 0.5f * base[4 * j + 3]; if (j > 0) imp += 0.5f * base[4 * j - 1];
            const bool forced = (j == 0) || (j == cur) || (j == cur - 1), causal = (64 * j <= qp);
            const float val = forced ? BIGF : (causal ? imp : NEGF);
            const unsigned ub = __float_as_uint(val); uk[qi] = (ub & 0x80000000u) ? ~ub : (ub | 0x80000000u); pref[qi] = 0u; }
#pragma unroll 1
        for (int bit = 31; bit >= 0; --bit) {
#pragma unroll
            for (int qi = 0; qi < 8; ++qi) { const unsigned cand = pref[qi] | (1u << bit); if (__popcll(__ballot(uk[qi] >= cand)) >= 16) pref[qi] = cand; } }
#pragma unroll
        for (int qi = 0; qi < 8; ++qi) { const int j = lane;
            const unsigned long long gt = __ballot(uk[qi] > pref[qi]), eq = __ballot(uk[qi] == pref[qi]); const int need = 16 - __popcll(gt);
            const unsigned long long below = eq & ((1ull << j) - 1ull);
            const unsigned long long mk = gt | __ballot(uk[qi] == pref[qi] && __popcll(below) < need);
            if (qi == (lr >> 2)) mym[0] = mk; if (qi == 4 + (lr >> 2)) mym[1] = mk; }
#pragma unroll
        for (int nq = 0; nq < 2; ++nq) { S.mhat[nq] = 0.f; S.l[nq] = 0.f; const float g0 = NSA_GATE(nq, 0);
#pragma unroll
            for (int ct = 0; ct < 4; ++ct) { OUTL[(ct * 2 + nq) * 64] = S.O[ct][nq] * g0; S.O[ct][nq] = (f32x4){0.f, 0.f, 0.f, 0.f}; } }
    }
    {   int s = n2; for (; s + 1 < n3 - 1; s += 2) NSA_PAIR(3, s, s - n2);
        if (s < n3 - 1) NSA_STEP(3, s, s - n2, PS); }
    NSA_STEP(2, n3 - 1, cur, PS);
#pragma unroll
    for (int nq = 0; nq < 2; ++nq) { const float lf = colsum4(S.l[nq]); const float sc = NSA_GATE(nq, 1) / lf; S.mhat[nq] = 0.f; S.l[nq] = 0.f;
#pragma unroll
        for (int ct = 0; ct < 4; ++ct) { OUTL[(ct * 2 + nq) * 64] += S.O[ct][nq] * sc; S.O[ct][nq] = (f32x4){0.f, 0.f, 0.f, 0.f}; } }
    {   int s = n3; if (cur >= 8) { NSA_STEP(2, s, lo, PS); ++s; }
        for (; s + 1 < n4 - 1; s += 2) NSA_PAIR(3, s, lo + s - n3);
        if (s < n4 - 1) NSA_STEP(3, s, lo + s - n3, PS);
        NSA_STEP(2, n4 - 1, cur, PS); }
#undef NSA_STEP
#undef NSA_PAIR
#undef NSA_NEXT
#undef NSA_TILE
#undef NSA_GSZ
#undef NSA_ISSUE
#undef NSA_GLDS
#undef NSA_WAITBAR
#pragma unroll
    for (int nq = 0; nq < 2; ++nq) { const float lf = colsum4(S.l[nq]); const float sc = NSA_GATE(nq, 2) / lf; bf16* op = ATT + ((size_t)b * SEQ + NSA_QPOS(nq)) * 1024 + head * 64 + 4 * lq;
#pragma unroll
        for (int ct = 0; ct < 4; ++ct) { const f32x4 o = OUTL[(ct * 2 + nq) * 64] + S.O[ct][nq] * sc; v2u pk; pk.x = pk2(o[0], o[1]); pk.y = pk2(o[2], o[3]); *(v2u*)(op + 16 * ct) = pk; } }
#undef NSA_GATE
#undef NSA_QPOS
}
#define XB_TMO      128
#define XB_XCNT(j)  (256  + 64 * (j))
#define XB_XSUB(j)  (1280 + 64 * (j))
#define XB_XGEN(j)  (2304 + 64 * (j))
#define XB_TOP      3328
#define XB_TOPGEN   3392
#define XCD_BAR_WORDS 3456
#define XB_SPIN_CAP (1u << 18)

__device__ __forceinline__ unsigned xb_ld(unsigned* p)              { return __hip_atomic_load(p, __ATOMIC_RELAXED, __HIP_MEMORY_SCOPE_AGENT); }
__device__ __forceinline__ unsigned xb_add(unsigned* p, unsigned v) { return __hip_atomic_fetch_add(p, v, __ATOMIC_RELAXED, __HIP_MEMORY_SCOPE_AGENT); }
__device__ __forceinline__ unsigned xb_xcc_id() { return (unsigned)__builtin_amdgcn_s_getreg((3 << 11) | 20) & 0xFu; }
#define XB_SPIN(cond, bar) do { unsigned _sp = 0; while (cond) { __builtin_amdgcn_s_sleep(1); \
    if ((++_sp & 255u) == 0u) { if (xb_ld(&(bar)[XB_TMO])) break; if (_sp > XB_SPIN_CAP) { atomicAdd(&(bar)[XB_TMO], 1u); break; } } } } while (0)

struct XcdBarrier {
    unsigned* bar; unsigned x;
    volatile LAS unsigned* st;
};

__device__ __forceinline__ XcdBarrier xcd_barrier_post(unsigned* bar, volatile LAS unsigned* st) {
    XcdBarrier b; b.bar = bar; b.x = xb_xcc_id(); b.st = st;
    if (threadIdx.x == 0) (void)xb_add(&bar[XB_XCNT(b.x)], 1u);
    return b;
}
__device__ __forceinline__ void xcd_barrier_complete(unsigned* bar, unsigned x, unsigned& nloc, unsigned& nx) {
    const unsigned G = gridDim.x * gridDim.y * gridDim.z;
    unsigned sum, cnt, mine, sp = 0u;
    for (;;) {
        sum = 0u; cnt = 0u; mine = 0u;
#pragma unroll
        for (unsigned j = 0; j < 16; ++j) { const unsigned c = xb_ld(&bar[XB_XCNT(j)]); sum += c; cnt += (c > 0u) ? 1u : 0u; mine = (j == x) ? c : mine; }
        if (sum == G) break;
        __builtin_amdgcn_s_sleep(1);
        if ((++sp & 255u) == 0u) { if (xb_ld(&bar[XB_TMO])) break; if (sp > XB_SPIN_CAP) { atomicAdd(&bar[XB_TMO], 1u); break; } }
    }
    nloc = mine > 0u ? mine : 1u; nx = cnt > 0u ? cnt : 1u;
}

__device__ __forceinline__ void xcd_barrier(const XcdBarrier& b) {
    asm volatile("s_waitcnt vmcnt(0)" ::: "memory");
    __syncthreads();
    if (threadIdx.x == 0) {
        unsigned* bar = b.bar;
        __builtin_amdgcn_s_waitcnt(0);
        unsigned nloc = b.st[0], nx = b.st[1];
        if (nloc == 0u) { xcd_barrier_complete(bar, b.x, nloc, nx); b.st[0] = nloc; b.st[1] = nx; }
        const unsigned old = xb_add(&bar[XB_XSUB(b.x)], 1u);
        const unsigned gen = old / nloc;
        if (old + 1u == (gen + 1u) * nloc) {
            __builtin_amdgcn_fence(__ATOMIC_RELEASE, "agent");
            asm volatile("s_waitcnt vmcnt(0)" ::: "memory");
            const unsigned og = xb_add(&bar[XB_TOP], 1u);
            const unsigned tg = og / nx;
            if (og + 1u == (tg + 1u) * nx) xb_add(&bar[XB_TOPGEN], 1u);
            else XB_SPIN(xb_ld(&bar[XB_TOPGEN]) == tg, bar);
            __builtin_amdgcn_fence(__ATOMIC_ACQUIRE, "agent");
            xb_add(&bar[XB_XGEN(b.x)], 1u);
            asm volatile("s_waitcnt vmcnt(0)" ::: "memory");
        } else {
            XB_SPIN(xb_ld(&bar[XB_XGEN(b.x)]) == gen, bar);
            __builtin_amdgcn_fence(__ATOMIC_ACQUIRE, "agent");
            asm volatile("s_waitcnt vmcnt(0)" ::: "memory");
        }
    }
    __syncthreads();
}
constexpr int LDS_BYTES = 147456;
constexpr int NPHASES = 14;
#ifndef PHMASK
#define PHMASK 0x3fff
#endif
#ifndef PHREP
#define PHREP 0
#endif
#ifndef RES_ALIGN
#define RES_ALIGN true
#endif
#ifndef MK_SINGLE
#define MK_SINGLE 1
#endif

constexpr int RS_OFF = 131072 + 256;
__device__ __forceinline__ void rs_table(LAS unsigned char* lds, const float* SS, int N) {
    pg8::StaticOrder S; S.init(MROWS, N, (int)gridDim.x, (int)blockIdx.x); LAS float* RS = (LAS float*)(lds + RS_OFF); pg8::Unit u;
    for (int idx = threadIdx.x; ; idx += NTHREADS) { const int ui = idx >> 8; if (ui >= 11 || !S.next(ui, u)) break; RS[idx] = pg8::row_rs_g(SS, u.pm * 256 + (idx & 255)); }
    __syncthreads();
}
template <class Epi, bool ALIGN = true> __device__ __forceinline__ void run_gemm(LAS unsigned char* lds, const bf16* Aop, const bf16* Bt, int N, int K, const Epi& E) {
    pg8::Gemm g{Aop, Bt, MROWS, N, K}; pg8::StaticOrder S; S.init(MROWS, N, (int)gridDim.x, (int)blockIdx.x);
    pg8::gemm_phase<Epi, pg8::StaticOrder, ALIGN, true>(lds, g, S, E);
}

__global__ void __launch_bounds__(NTHREADS, 2) mk_fwd(Args args) {
    extern __shared__ __attribute__((aligned(16))) unsigned char lds_raw[];
    LAS unsigned char* lds = (LAS unsigned char*)lds_raw;
    cg::grid_group grid = cg::this_grid();
    volatile LAS unsigned* MISC = (volatile LAS unsigned*)(lds + 131072);
    if (threadIdx.x < 32) MISC[threadIdx.x] = 0u;
    __syncthreads();
    XcdBarrier xbar = xcd_barrier_post((unsigned*)(args.ws + WS_CTL) + 4096, MISC + 8);
    const int tid = threadIdx.x, lane = tid & 63, wave = __builtin_amdgcn_readfirstlane(tid >> 6);
    const int gw = blockIdx.x * NWAVES + wave, NGW = gridDim.x * NWAVES;
    unsigned char* ws = args.ws;
    const int lo = args.ph_lo, hi = args.ph_hi;
#define PH_BEGIN(k) if (lo <= (k) && (k) < hi) { if ((k) > lo) { if ((k) == lo + 1) grid.sync(); else xcd_barrier(xbar); } for (int rep_ = 0; rep_ < ((((PHREP) >> (k)) & 1) ? 2 : 1); ++rep_) { __syncthreads(); if constexpr ((PHMASK >> (k)) & 1) {
#define PH_END }}}
    float* const SS = (float*)(ws + WS_SS); constexpr size_t SSN = (size_t)MROWS * 16;
    bf16* const XN = (bf16*)(ws + WS_XN);
    PH_BEGIN(0) p0_prologue(args, lds, wave, lane); PH_END
    const LAS float* RSL = (const LAS float*)(lds + RS_OFF);
    PH_BEGIN(1) { rs_table(lds, SS, AB_IN); pg8::EpiProj0 E{(bf16*)(ws + WS_PROJ0), (const float*)(ws + TAB_RCOS), (const float*)(ws + TAB_RSIN), RSL};
                  run_gemm(lds, XN, (const bf16*)(ws + W_ABIN), AB_IN, 1024, E); } PH_END
    PH_BEGIN(2) { for (int it = blockIdx.x; it < 1024; it += gridDim.x) lru_item(args, lds, it, 0); ret_kv_run(args, lds, (int)blockIdx.x, (int)gridDim.x, 2048); } PH_END
    PH_BEGIN(3) {
                  for (int it = blockIdx.x; it < 1024; it += gridDim.x) lru_item(args, lds, it, 1);
                  const int per = (2048 + (int)gridDim.x - 1) / (int)gridDim.x, i0 = (int)blockIdx.x * per;
                  const int i1 = (i0 + per < 2048) ? i0 + per : 2048;
                  if (i0 < i1) { RetPre R; ret_out_pre(args, i0, true, R);
                      for (int it = i0; it < i1; ++it) { const int nx = (it + 1 < i1) ? it + 1 : -1; ret_out_item(args, lds, it, it == i0 || (it & 31) == 0, R, nx, nx >= 0 && (nx & 31) == 0); } } } PH_END
    PH_BEGIN(4) { pg8::EpiResid E{args.in[I_X], args.out, XN, SS + SSN}; run_gemm<pg8::EpiResid, RES_ALIGN>(lds, (const bf16*)(ws + WS_CAT), (const bf16*)(ws + W_ABOUT), 1024, 1024, E); } PH_END
    PH_BEGIN(5) { rs_table(lds, SS + SSN, 2 * FFH); pg8::EpiFfnUp E{(bf16*)(ws + WS_ACT), FFH, RSL}; run_gemm(lds, XN, (const bf16*)(ws + W_F13), 2 * FFH, 1024, E); } PH_END
    PH_BEGIN(6) { pg8::EpiResid E{args.out, args.out, XN, SS + 2 * SSN}; run_gemm<pg8::EpiResid, RES_ALIGN>(lds, (const bf16*)(ws + WS_ACT), (const bf16*)(ws + W_F2), 1024, FFH, E); } PH_END
    PH_BEGIN(7) { rs_table(lds, SS + 2 * SSN, NSA_INP); pg8::EpiNsaIn E{(bf16*)(ws + WS_Q), (bf16*)(ws + WS_KV6), (float*)(ws + WS_GATES), (bf16*)(ws + WS_VTS), (bf16*)(ws + WS_VTW), (const float*)(ws + TAB_NCOS), (const float*)(ws + TAB_NSIN), RSL};
                  run_gemm(lds, XN, (const bf16*)(ws + W_NSAIN), NSA_INP, 1024, E); } PH_END
    PH_BEGIN(8) { cmp_bias_to_lds(args, lds); for (int it = blockIdx.x; it < 256; it += gridDim.x) cmp_item(args, lds, it); } PH_END
    PH_BEGIN(9) { if (gridDim.x == 256) {
                      const int grp = (int)blockIdx.x >> 5, bg = (int)blockIdx.x & 31;
                      for (int i = 0; i < 8; ++i) { const int qt = (i & 1) ? 8 * i + 7 - grp : 8 * i + grp; nsa_item2(args, lds, qt * 32 + bg); } }
                  else for (int it = blockIdx.x; it < 2048; it += gridDim.x) nsa_item2(args, lds, it); } PH_END
    PH_BEGIN(10) { pg8::EpiResid E{args.out, args.out, XN, SS + 3 * SSN}; run_gemm<pg8::EpiResid, RES_ALIGN>(lds, (const bf16*)(ws + WS_CAT), (const bf16*)(ws + W_NSAOUT), 1024, 1024, E); } PH_END
    PH_BEGIN(11) { rs_table(lds, SS + 3 * SSN, 2 * FFH); pg8::EpiFfnUp E{(bf16*)(ws + WS_ACT), FFH, RSL}; run_gemm(lds, XN, (const bf16*)(ws + W_F13) + (size_t)2 * FFH * 1024, 2 * FFH, 1024, E); } PH_END
    PH_BEGIN(12) { pg8::EpiResid E{args.out, args.out, nullptr, nullptr}; run_gemm<pg8::EpiResid, RES_ALIGN>(lds, (const bf16*)(ws + WS_ACT), (const bf16*)(ws + W_F2) + (size_t)1024 * FFH, 1024, FFH, E); } PH_END
    PH_BEGIN(13) final_norm_phase(args.out, args.in[I_FINAL_NORM], gw, NGW, lane); PH_END
}

extern "C" void kernel_launch(void* const* d_in, const int* in_sizes, int n_in, void* d_out, int out_size, void* d_ws, size_t ws_size, hipStream_t stream) {
    static int grid = 0;
    if (grid == 0) {
        if (n_in != 24 || out_size != MROWS * DM || ws_size < WS_END) { fprintf(stderr, "kernel_launch: unexpected shapes (n_in %d out %d ws %zu)\n", n_in, out_size, ws_size); grid = -1; return; }
        int dev = 0, cus = 0, per_cu = 0;
        if (hipGetDevice(&dev) != hipSuccess || hipDeviceGetAttribute(&cus, hipDeviceAttributeMultiprocessorCount, dev) != hipSuccess) { grid = -1; return; }
        if (hipFuncSetAttribute((const void*)mk_fwd, hipFuncAttributeMaxDynamicSharedMemorySize, LDS_BYTES) != hipSuccess) { fprintf(stderr, "kernel_launch: hipFuncSetAttribute failed\n"); grid = -1; return; }
        if (hipOccupancyMaxActiveBlocksPerMultiprocessor(&per_cu, (const void*)mk_fwd, NTHREADS, LDS_BYTES) != hipSuccess || per_cu < 1) { fprintf(stderr, "kernel_launch: occupancy query says %d\n", per_cu); per_cu = 1; }
        (void)hipGetLastError();
        grid = cus;
    }
    if (grid < 0) return;
    if (hipMemsetAsync((char*)d_ws + WS_CTL, 0, 65536, stream) != hipSuccess) { fprintf(stderr, "kernel_launch: memset failed\n"); return; }
    Args a{};
    for (int i = 0; i < 24; ++i) a.in[i] = (const float*)d_in[i];
    a.out = (float*)d_out; a.ws = (unsigned char*)d_ws;
#if MK_SINGLE
    a.ph_lo = 0; a.ph_hi = NPHASES;
    void* kargs[] = {&a};
    hipError_t e = hipLaunchCooperativeKernel((const void*)mk_fwd, dim3(grid), dim3(NTHREADS), kargs, LDS_BYTES, stream);
    if (e != hipSuccess) fprintf(stderr, "kernel_launch: cooperative launch failed: %s (grid %d)\n", hipGetErrorString(e), grid);
#else
    for (int ph = 0; ph < NPHASES; ++ph) { a.ph_lo = ph; a.ph_hi = ph + 1; hipLaunchKernelGGL(mk_fwd, dim3(grid), dim3(NTHREADS), LDS_BYTES, stream, a); }
#endif
}
```

```cpp
#include <hip/hip_runtime.h>
#include <hip/hip_cooperative_groups.h>
#include <cstdio>
#include <cstdint>
namespace cg = cooperative_groups;
namespace pg8 {
#define PG8_LAS __attribute__((address_space(3)))
typedef unsigned short bf16_t;
typedef short bf16x8 __attribute__((ext_vector_type(8)));
typedef float f32x4 __attribute__((ext_vector_type(4)));
typedef unsigned u32x4 __attribute__((ext_vector_type(4)));
constexpr int BM = 256, BK = 64, HALF = 128, HTB = HALF * BK * 2  , STAGE_BYTES = 8 * HTB, NXCD = 8, WGM = 8;

__host__ __device__ __forceinline__ int lds_byte(int r, int c) { const int st = (r >> 4) * 2 + (c >> 5), rr = r & 15, cc = c & 31, ob = rr * 64 + cc * 2; return st * 1024 + (ob ^ (((ob >> 9) & 1) << 5)); }
__host__ __device__ __forceinline__ void stage_rc(int b, int& R, int& C) { const int st = b / 1024, sb = b % 1024, swz = sb ^ (((sb >> 9) & 1) << 5); R = (st >> 1) * 16 + swz / 64; C = (st & 1) * 32 + (swz % 64) / 2; }
__host__ __device__ __forceinline__ int perm32(int rho) { const int n = rho >> 4, i = rho & 15; return 8 * (i >> 2) + 4 * n + (i & 3); }

struct Unit { int pm, pn, ui; };
struct Gemm { const bf16_t* A; const bf16_t* Bt; int M, N, K; };

struct StaticOrder {
    int nM, nN, nwg, G, c;
    __host__ __device__ void init(int M, int N, int G_, int c_) { nM = M / BM; nN = N / BM; nwg = nM * nN; G = G_; c = c_; }
    __host__ __device__ bool next(int i, Unit& u) const {
        const long L = (long)i * G + c; if (L >= nwg) return false;
        int wgid = (int)L; { const int q = nwg / NXCD, r = nwg % NXCD, xcd = wgid % NXCD, off = wgid / NXCD; wgid = (xcd < r ? xcd * (q + 1) : r * (q + 1) + (xcd - r) * q) + off; }
        const int nig = WGM * nN, gid = wgid / nig, fm = gid * WGM, gsz = (nM - fm) < WGM ? (nM - fm) : WGM;
        u.pm = fm + ((wgid % nig) % gsz); u.pn = (wgid % nig) / gsz; u.ui = i; return true;
    }
    __device__ __forceinline__ void a_ready(const Unit&) const {}
    __device__ __forceinline__ void done(const Unit&) const {}
};

__device__ __forceinline__ unsigned cvt_pk_bf16(float lo, float hi) { unsigned r; asm volatile("v_cvt_pk_bf16_f32 %0, %1, %2" : "=v"(r) : "v"(lo), "v"(hi)); return r; }
typedef unsigned u32x2 __attribute__((ext_vector_type(2)));
__device__ __forceinline__ float sigmoid_f(float x) { return __builtin_amdgcn_rcpf(1.f + __builtin_amdgcn_exp2f(-1.4426950408889634f * x)); }
__device__ __forceinline__ float silu_f(float x) { return x * __builtin_amdgcn_rcpf(1.f + __builtin_amdgcn_exp2f(-1.4426950408889634f * x)); }
__device__ __forceinline__ u32x4 pack8(const f32x4 a, const f32x4 b) { u32x4 w; w.x = cvt_pk_bf16(a[0], a[1]); w.y = cvt_pk_bf16(a[2], a[3]); w.z = cvt_pk_bf16(b[0], b[1]); w.w = cvt_pk_bf16(b[2], b[3]); return w; }
__device__ __forceinline__ u32x2 pack4(const f32x4 a) { u32x2 w; w.x = cvt_pk_bf16(a[0], a[1]); w.y = cvt_pk_bf16(a[2], a[3]); return w; }

__device__ __forceinline__ float row_rs_g(const float* SS, int row) { const f32x4* p = (const f32x4*)(SS + (size_t)row * 16); const f32x4 a = p[0], b = p[1], c = p[2], d = p[3];
    const float t = ((a[0] + a[1]) + (a[2] + a[3])) + ((b[0] + b[1]) + (b[2] + b[3])) + ((c[0] + c[1]) + (c[2] + c[3])) + ((d[0] + d[1]) + (d[2] + d[3])); return 1.f / sqrtf(t * (1.f / 1024.f) + 1e-6f); }
struct EpiProj0 {
    static constexpr bool PERM = true, AFTER_DRAIN = false;
    bf16_t* P; const float* cosT; const float* sinT; const PG8_LAS float* RS;
    __device__ __forceinline__ void operator()(const f32x4 (&acc)[2][2][4][2], const Unit& u, int wr, int wc, int fr, int fq) const {
        const int row0 = u.pm * BM + wr * 64 + fr, colt = u.pn * BM + wc * 32 + 8 * fq;
        const bool rot = (u.pn >= 4 && u.pn < 8); const float sc = (u.pn >= 6 && u.pn < 8) ? 0.125f : 1.f;
#pragma unroll
        for (int ai = 0; ai < 2; ++ai)
#pragma unroll
            for (int m = 0; m < 4; ++m) { const int row = row0 + ai * HALF + m * 16, pos = row & 4095; bf16_t* rowp = P + (size_t)row * 3072; const float rs = RS[u.ui * 256 + (row & 255)];
#pragma unroll
                for (int bj = 0; bj < 2; ++bj) { const int col = colt + bj * HALF; const f32x4 v0 = acc[ai][bj][m][0] * rs, v1 = acc[ai][bj][m][1] * rs;
                    if (rot) { const int hc = col & 63, gi = hc >> 3, hb = col - hc;
                        const f32x4 c = *(const f32x4*)(cosT + pos * 32 + 4 * gi), s = *(const f32x4*)(sinT + pos * 32 + 4 * gi);
                        const f32x4 o1 = (v0 * c - v1 * s) * sc, o2 = (v1 * c + v0 * s) * sc;
                        *(u32x2*)(rowp + hb + 4 * gi) = pack4(o1); *(u32x2*)(rowp + hb + 32 + 4 * gi) = pack4(o2);
                    } else { *(u32x4*)(rowp + col) = pack8(v0, v1); } } }
    }
};
struct EpiNsaIn {
    static constexpr bool PERM = true, AFTER_DRAIN = false;
    bf16_t* Q; bf16_t* KV; float* G; bf16_t* VTS; bf16_t* VTW; const float* cosT; const float* sinT; const PG8_LAS float* RS;
    __device__ __forceinline__ void operator()(const f32x4 (&acc)[2][2][4][2], const Unit& u, int wr, int wc, int fr, int fq) const {
        const int row0 = u.pm * BM + wr * 64 + fr, pn = u.pn;
#pragma unroll
        for (int ai = 0; ai < 2; ++ai)
#pragma unroll
            for (int m = 0; m < 4; ++m) { const int row = row0 + ai * HALF + m * 16, pos = row & 4095; const float rs = RS[u.ui * 256 + (row & 255)];
#pragma unroll
                for (int bj = 0; bj < 2; ++bj) { const int lc = bj * HALF + wc * 32 + 8 * fq; const f32x4 v0 = acc[ai][bj][m][0] * rs, v1 = acc[ai][bj][m][1] * rs;
                    if (pn < 10) {
                        bf16_t* dst; bool rot; float sc;
                        if (pn < 4) { dst = Q + (size_t)row * 1024 + pn * 256 + lc; rot = true; sc = 0.125f * 1.4426950408889634f; }
                        else { const int j = pn - 4;
                            if (j == 3 || j == 5) {
                                bf16_t* vt = (j == 3 ? VTS : VTW) + ((size_t)((row >> 12) * 4 + (lc >> 6)) * 64 + (lc & 63)) * 4096 + pos; const u32x4 w8 = pack8(v0, v1); const unsigned wv[4] = {w8.x, w8.y, w8.z, w8.w};
#pragma unroll
                                for (int i = 0; i < 4; ++i) { vt[(size_t)(2 * i) * 4096] = (bf16_t)(wv[i] & 0xffffu); vt[(size_t)(2 * i + 1) * 4096] = (bf16_t)(wv[i] >> 16); }
                                continue; }
                            dst = KV + (size_t)row * 1536 + j * 256 + lc; rot = (j == 2 || j == 4); sc = 1.f; }
                        const int hc = lc & 63;
                        if (rot && hc < 16) { const int gi = hc >> 3;
                            const f32x4 c = *(const f32x4*)(cosT + pos * 8 + 4 * gi), s = *(const f32x4*)(sinT + pos * 8 + 4 * gi);
                            const f32x4 o1 = (v0 * c - v1 * s) * sc, o2 = (v1 * c + v0 * s) * sc;
                            bf16_t* hbp = dst - hc; *(u32x2*)(hbp + 4 * gi) = pack4(o1); *(u32x2*)(hbp + 8 + 4 * gi) = pack4(o2);
                        } else { *(u32x4*)dst = pack8(v0 * sc, v1 * sc); }
                    } else if (lc < 48) {
                        float* gp = G + (size_t)row * 48 + lc; f32x4 a, b;
#pragma unroll
                        for (int i = 0; i < 4; ++i) { a[i] = sigmoid_f(v0[i]); b[i] = sigmoid_f(v1[i]); }
                        *(f32x4*)gp = a; *(f32x4*)(gp + 4) = b; } } }
    }
};
struct EpiFfnUp {
    static constexpr bool PERM = true, AFTER_DRAIN = false;
    bf16_t* ACT; int ld; const PG8_LAS float* RS;
    __device__ __forceinline__ void operator()(const f32x4 (&acc)[2][2][4][2], const Unit& u, int wr, int wc, int fr, int fq) const {
        const int row0 = u.pm * BM + wr * 64 + fr, col = u.pn * 128 + wc * 32 + 8 * fq;
#pragma unroll
        for (int ai = 0; ai < 2; ++ai)
#pragma unroll
            for (int m = 0; m < 4; ++m) { const int row = row0 + ai * HALF + m * 16; f32x4 h0, h1; const float rs = RS[u.ui * 256 + (row & 255)];
#pragma unroll
                for (int i = 0; i < 4; ++i) { h0[i] = silu_f(acc[ai][0][m][0][i] * rs) * (acc[ai][1][m][0][i] * rs); h1[i] = silu_f(acc[ai][0][m][1][i] * rs) * (acc[ai][1][m][1][i] * rs); }
                *(u32x4*)(ACT + (size_t)row * ld + col) = pack8(h0, h1); }
    }
};
struct EpiResid {
    static constexpr bool PERM = true, AFTER_DRAIN = false;
    const float* base; float* out; bf16_t* HB; float* SS;
    __device__ __forceinline__ void operator()(const f32x4 (&acc)[2][2][4][2], const Unit& u, int wr, int wc, int fr, int fq) const {
        const int row0 = u.pm * BM + wr * 64 + fr, col0 = u.pn * BM + wc * 32 + 8 * fq;
#pragma unroll
        for (int ai = 0; ai < 2; ++ai) {
            f32x4 pre[4][2][2];
#pragma unroll
            for (int m = 0; m < 4; ++m) { const size_t off = (size_t)(row0 + ai * HALF + m * 16) * 1024 + col0;
#pragma unroll
                for (int bj = 0; bj < 2; ++bj) { pre[m][bj][0] = *(const f32x4*)(base + off + bj * HALF); pre[m][bj][1] = *(const f32x4*)(base + off + bj * HALF + 4); } }
            asm volatile("" ::: "memory");
#pragma unroll
            for (int m = 0; m < 4; ++m) { const int row = row0 + ai * HALF + m * 16; const size_t off = (size_t)row * 1024 + col0; float ssq = 0.f;
#pragma unroll
                for (int bj = 0; bj < 2; ++bj) { const size_t o = off + bj * HALF; const f32x4 v0 = pre[m][bj][0] + acc[ai][bj][m][0], v1 = pre[m][bj][1] + acc[ai][bj][m][1];
                    *(f32x4*)(out + o) = v0; *(f32x4*)(out + o + 4) = v1;
                    if (HB) { *(u32x4*)(HB + o) = pack8(v0, v1); ssq += ((v0[0] * v0[0] + v0[1] * v0[1]) + (v0[2] * v0[2] + v0[3] * v0[3])) + ((v1[0] * v1[0] + v1[1] * v1[1]) + (v1[2] * v1[2] + v1[3] * v1[3])); } }
                if (HB) { ssq += __shfl_xor(ssq, 16); ssq += __shfl_xor(ssq, 32); if (fq == 0) SS[(size_t)row * 16 + u.pn * 4 + wc] = ssq; } }
            asm volatile("" ::: "memory");
        }
    }
};
template <class Epi, class Sched, bool ALIGN_EPI = false, bool SP2 = false>
__device__ __forceinline__ void gemm_phase(PG8_LAS unsigned char* lds, const Gemm g, const Sched& S, const Epi& E) {
    const int tid = threadIdx.x, wid = __builtin_amdgcn_readfirstlane(tid >> 6), lane = tid & 63, wr = wid >> 2, wc = wid & 3, fr = lane & 15, fq = lane >> 4;
    const int K = g.K, nt = K / BK;
    unsigned voffA[2], voffB[2];
#pragma unroll
    for (int i = 0; i < 2; ++i) { int R, C; stage_rc(tid * 16 + i * 8192, R, C); const int Rb = Epi::PERM ? ((R & ~31) + perm32(R & 31)) : R;
        voffA[i] = (unsigned)(R * K + C) * 2u; voffB[i] = (unsigned)(Rb * K + C) * 2u; }
    const size_t kstep = (size_t)(BK * 2);
    const size_t hstep = (size_t)HALF * K * 2;
    const size_t tstep = 2 * hstep;
    const unsigned ldsw = (unsigned)wid * 1024u;
    const int aoff = lds_byte(wr * 64 + fr, fq * 8), boff = lds_byte(wc * 32 + fr, fq * 8);
#define PG8_SA(b, h) (((b) * 2 + (h)) * HTB)
#define PG8_SB(b, h) ((4 + (b) * 2 + (h)) * HTB)
#define PG8_STAGE(bufoff, gbase, voff) do { _Pragma("unroll") for (int _i = 0; _i < 2; ++_i) \
        __builtin_amdgcn_global_load_lds((const unsigned*)((const char*)(gbase) + (voff)[_i]), (PG8_LAS unsigned*)(lds + (bufoff) + ldsw + _i * 8192), 16, 0, 0); } while (0)
#define PG8_LDA(dst, b, h) do { _Pragma("unroll") for (int m = 0; m < 4; ++m) _Pragma("unroll") for (int k = 0; k < 2; ++k) dst[m][k] = *(const PG8_LAS bf16x8*)(lds + PG8_SA(b, h) + aoff + m * 2048 + k * 1024); } while (0)
#define PG8_LDB(dst, b, h) do { _Pragma("unroll") for (int n = 0; n < 2; ++n) _Pragma("unroll") for (int k = 0; k < 2; ++k) dst[n][k] = *(const PG8_LAS bf16x8*)(lds + PG8_SB(b, h) + boff + n * 2048 + k * 1024); } while (0)
#define PG8_MMA(ai, bj, At, Bt) do { __builtin_amdgcn_s_setprio(1); _Pragma("unroll") for (int m = 0; m < 4; ++m) _Pragma("unroll") for (int n = 0; n < 2; ++n) _Pragma("unroll") for (int k = 0; k < 2; ++k) \
        acc[ai][bj][m][n] = __builtin_amdgcn_mfma_f32_16x16x32_bf16(Bt[n][k], At[m][k], acc[ai][bj][m][n], 0, 0, 0); __builtin_amdgcn_s_setprio(0); } while (0)
#define PG8_WAIT_V(n) asm volatile("s_waitcnt vmcnt(" #n ")" ::: "memory")
#define PG8_WAIT_L(n) asm volatile("s_waitcnt lgkmcnt(" #n ")" ::: "memory")
#define PG8_BAR __builtin_amdgcn_s_barrier()
#define PG8_SCHED __builtin_amdgcn_sched_barrier(0)
    Unit cur, nxt; int ui = 0;
    if (!S.next(0, cur)) return;
    f32x4 acc[2][2][4][2];
#pragma unroll
    for (int a = 0; a < 2; ++a)
#pragma unroll
        for (int b = 0; b < 2; ++b)
#pragma unroll
            for (int m = 0; m < 4; ++m)
#pragma unroll
                for (int n = 0; n < 2; ++n) acc[a][b][m][n] = (f32x4){0.f, 0.f, 0.f, 0.f};
    bf16x8 At[4][2], B0[2][2], B1[2][2];
    const char* cA = (const char*)g.A + (size_t)cur.pm * tstep; const char* cB = (const char*)g.Bt + (size_t)cur.pn * tstep;
    S.a_ready(cur);
    if constexpr (SP2) {
        PG8_STAGE(PG8_SB(0, 0), cB, voffB); PG8_STAGE(PG8_SB(0, 1), cB + hstep, voffB); PG8_STAGE(PG8_SA(0, 0), cA, voffA); PG8_STAGE(PG8_SA(0, 1), cA + hstep, voffA);
        if (wr == 1) PG8_BAR;
        PG8_WAIT_V(2); PG8_BAR;
        PG8_STAGE(PG8_SB(1, 0), cB + kstep, voffB); PG8_STAGE(PG8_SA(1, 0), cA + kstep, voffA); PG8_STAGE(PG8_SB(1, 1), cB + hstep + kstep, voffB);
        PG8_WAIT_V(6); PG8_BAR;
    } else {
        PG8_STAGE(PG8_SB(0, 0), cB, voffB); PG8_STAGE(PG8_SA(0, 0), cA, voffA); PG8_STAGE(PG8_SB(0, 1), cB + hstep, voffB); PG8_STAGE(PG8_SA(0, 1), cA + hstep, voffA);
        if (wr == 1) PG8_BAR;
        PG8_WAIT_V(4); PG8_BAR;
        PG8_STAGE(PG8_SB(1, 0), cB + kstep, voffB); PG8_STAGE(PG8_SA(1, 0), cA + kstep, voffA); PG8_STAGE(PG8_SB(1, 1), cB + hstep + kstep, voffB);
        PG8_WAIT_V(6); PG8_BAR;
    }
    for (;;) {
        const bool has_next = S.next(ui + 1, nxt);
        const char* nA = has_next ? (const char*)g.A + (size_t)nxt.pm * tstep : cA; const char* nB = has_next ? (const char*)g.Bt + (size_t)nxt.pn * tstep : cB;
        for (int t = 0; t < nt; t += 2) {
            const bool last = (t == nt - 2);
            const char* a1 = cA + (size_t)(t + 1) * kstep;
            const char* a2 = last ? nA : cA + (size_t)(t + 2) * kstep; const char* b2 = last ? nB : cB + (size_t)(t + 2) * kstep;
            const char* a3 = a2 + kstep; const char* b3 = b2 + kstep;
            if (last && has_next) S.a_ready(nxt);
            if constexpr (SP2) {
            PG8_LDB(B0, 0, 0); PG8_LDB(B1, 0, 1); PG8_SCHED; PG8_LDA(At, 0, 0); PG8_STAGE(PG8_SA(1, 1), a1 + hstep, voffA);
            PG8_WAIT_V(8); PG8_WAIT_L(0); PG8_BAR; PG8_MMA(0, 0, At, B0); PG8_MMA(0, 1, At, B1); PG8_BAR; PG8_SCHED;
            PG8_LDA(At, 0, 1); PG8_STAGE(PG8_SB(0, 0), b2, voffB); PG8_STAGE(PG8_SB(0, 1), b2 + hstep, voffB); PG8_STAGE(PG8_SA(0, 0), a2, voffA);
            PG8_WAIT_V(8); PG8_WAIT_L(0); PG8_BAR; PG8_MMA(1, 0, At, B0); PG8_MMA(1, 1, At, B1); PG8_BAR; PG8_SCHED;
            PG8_LDB(B0, 1, 0); PG8_LDB(B1, 1, 1); PG8_SCHED; PG8_LDA(At, 1, 0); PG8_STAGE(PG8_SA(0, 1), a2 + hstep, voffA);
            PG8_WAIT_V(8); PG8_WAIT_L(0); PG8_BAR; PG8_MMA(0, 0, At, B0); PG8_MMA(0, 1, At, B1); PG8_BAR; PG8_SCHED;
            PG8_LDA(At, 1, 1); PG8_STAGE(PG8_SB(1, 0), b3, voffB); PG8_STAGE(PG8_SB(1, 1), b3 + hstep, voffB); PG8_STAGE(PG8_SA(1, 0), a3, voffA);
            PG8_WAIT_V(8); PG8_WAIT_L(0); PG8_BAR; PG8_MMA(1, 0, At, B0); PG8_MMA(1, 1, At, B1); PG8_BAR; PG8_SCHED;
            } else {
            PG8_LDB(B0, 0, 0); PG8_SCHED; PG8_LDA(At, 0, 0); PG8_STAGE(PG8_SA(1, 1), a1 + hstep, voffA);
            PG8_WAIT_L(8); PG8_BAR; PG8_WAIT_L(0); PG8_MMA(0, 0, At, B0); PG8_BAR; PG8_SCHED;
            PG8_LDB(B1, 0, 1); PG8_STAGE(PG8_SB(0, 0), b2, voffB);
            PG8_BAR; PG8_WAIT_L(0); PG8_MMA(0, 1, At, B1); PG8_BAR;
            PG8_LDA(At, 0, 1); PG8_STAGE(PG8_SA(0, 0), a2, voffA);
            PG8_BAR; PG8_WAIT_L(0); PG8_MMA(1, 0, At, B0); PG8_BAR; PG8_SCHED;
            PG8_STAGE(PG8_SB(0, 1), b2 + hstep, voffB);
            PG8_WAIT_V(6); PG8_BAR; PG8_MMA(1, 1, At, B1); PG8_BAR;
            PG8_LDB(B0, 1, 0); PG8_SCHED; PG8_LDA(At, 1, 0); PG8_STAGE(PG8_SA(0, 1), a2 + hstep, voffA);
            PG8_WAIT_L(8); PG8_BAR; PG8_WAIT_L(0); PG8_MMA(0, 0, At, B0); PG8_BAR; PG8_SCHED;
            PG8_LDB(B1, 1, 1); PG8_STAGE(PG8_SB(1, 0), b3, voffB);
            PG8_BAR; PG8_WAIT_L(0); PG8_MMA(0, 1, At, B1); PG8_BAR;
            PG8_LDA(At, 1, 1); PG8_STAGE(PG8_SA(1, 0), a3, voffA);
            PG8_BAR; PG8_WAIT_L(0); PG8_MMA(1, 0, At, B0); PG8_BAR; PG8_SCHED;
            PG8_STAGE(PG8_SB(1, 1), b3 + hstep, voffB);
            PG8_WAIT_V(6); PG8_BAR; PG8_MMA(1, 1, At, B1); PG8_BAR;
            }
        }
        if constexpr (ALIGN_EPI) { if (wr == 0) PG8_BAR; }
        if constexpr (!Epi::AFTER_DRAIN) { E(acc, cur, wr, wc, fr, fq); S.done(cur); }
        if (!has_next) break;
#pragma unroll
        for (int a = 0; a < 2; ++a)
#pragma unroll
            for (int b = 0; b < 2; ++b)
#pragma unroll
                for (int m = 0; m < 4; ++m)
#pragma unroll
                    for (int n = 0; n < 2; ++n) acc[a][b][m][n] = (f32x4){0.f, 0.f, 0.f, 0.f};
        cur = nxt; cA = nA; cB = nB; ++ui;
        if constexpr (ALIGN_EPI) { if (wr == 1) PG8_BAR; }
    }
    PG8_WAIT_V(0);
    if constexpr (!ALIGN_EPI) { if (wr == 0) PG8_BAR; }
    PG8_BAR;
    if constexpr (Epi::AFTER_DRAIN) { E.fused(acc, cur, wr, wc, fr, fq, lds, wid, lane); S.done(cur); }
#undef PG8_SA
#undef PG8_SB
#undef PG8_STAGE
#undef PG8_LDA
#undef PG8_LDB
#undef PG8_MMA
#undef PG8_WAIT_V
#undef PG8_WAIT_L
#undef PG8_BAR
#undef PG8_SCHED
}
}
#define LAS __attribute__((address_space(3)))
typedef unsigned short bf16;
typedef unsigned v4u __attribute__((ext_vector_type(4)));
typedef unsigned v2u __attribute__((ext_vector_type(2)));
typedef float f32x4 __attribute__((ext_vector_type(4)));
typedef short bf16x8 __attribute__((ext_vector_type(8)));

constexpr int NWAVES = 8, NTHREADS = 512;
constexpr int BATCH = 8, SEQ = 4096, DM = 1024, MROWS = BATCH * SEQ;
constexpr int AB_IN = 3072, FFH = 2816, NSA_IN = 2608, NSA_INP = 2816;
constexpr float EPSF = 1e-6f, NEGF = -1e30f, BIGF = 1e30f, LOG2E = 1.4426950408889634f;

constexpr size_t MiB = 1u << 20;
constexpr size_t WS_CTL = 0;
constexpr size_t WS_TAB = 1 * MiB;
constexpr size_t TAB_RCOS = WS_TAB, TAB_RSIN = TAB_RCOS + 4096 * 32 * 4, TAB_NCOS = TAB_RSIN + 4096 * 32 * 4, TAB_NSIN = TAB_NCOS + 4096 * 8 * 4, TAB_CB = TAB_NSIN + 4096 * 8 * 4;
constexpr size_t WS_W = 4 * MiB;
constexpr size_t W_ABIN = WS_W, W_ABOUT = W_ABIN + 6 * MiB, W_NSAIN = W_ABOUT + 2 * MiB, W_NSAOUT = W_NSAIN + 6 * MiB, W_F13 = W_NSAOUT + 2 * MiB  , W_F2 = W_F13 + 22 * MiB  ,
                 W_CK1 = W_F2 + 11 * MiB  , W_CV1 = W_CK1 + 256 * 1024, W_CK2 = W_CV1 + 256 * 1024  , W_CV2 = W_CK2 + 8192, W_GATE = W_CV2 + 8192  , W_END = W_GATE + 131072;
static_assert(W_END <= 64 * MiB, "weights");
constexpr size_t WS_XN = 64 * MiB;
constexpr size_t WS_CAT = 128 * MiB;
constexpr size_t WS_BIG = 192 * MiB;
constexpr size_t WS_PROJ0 = WS_BIG, WS_ACT = WS_BIG;
constexpr size_t WS_Q = WS_BIG, WS_KV6 = WS_BIG + 64 * MiB, WS_GATES = WS_KV6 + 96 * MiB, WS_KC = WS_GATES + 6 * MiB, WS_VCT = WS_KC + 1 * MiB, WS_VTS = WS_VCT + 1 * MiB, WS_VTW = WS_VTS + 16 * MiB;
constexpr size_t WS_KVT = 384 * MiB;
constexpr size_t WS_LSUM = 416 * MiB;
constexpr size_t WS_SS = 418 * MiB;
constexpr size_t WS_END = 428 * MiB;
static_assert(WS_VTW + 16 * MiB <= WS_KVT + 32 * MiB && WS_LSUM + 2 * MiB <= WS_SS && WS_PROJ0 + (size_t)MROWS * AB_IN * 2 <= WS_KVT, "ws map");

__device__ __forceinline__ float bf2f(bf16 v) { return __uint_as_float((unsigned)v << 16); }
__device__ __forceinline__ unsigned f2bf(float f) { unsigned u = __float_as_uint(f); return (u + 0x7fffu + ((u >> 16) & 1u)) >> 16; }
__device__ __forceinline__ unsigned pk2(float lo, float hi) { return f2bf(lo) | (f2bf(hi) << 16); }

__device__ __forceinline__ float gelu_tanh(float x) { const float u = 0.7978845608028654f * (x + 0.044715f * x * x * x); const float e = __expf(2.f * u); const float th = 1.f - 2.f / (e + 1.f); return 0.5f * x * (1.f + th); }
__device__ __forceinline__ float sigm(float x) { return 1.f / (1.f + __expf(-x)); }
__device__ __forceinline__ f32x4 mfma16(bf16x8 a, bf16x8 b, f32x4 c) { return __builtin_amdgcn_mfma_f32_16x16x32_bf16(a, b, c, 0, 0, 0); }
#define DPPF(x_, ctrl_) __int_as_float(__builtin_amdgcn_update_dpp(0, __float_as_int(x_), (ctrl_), 0xF, 0xF, true))
__device__ __forceinline__ float qsum4(float v) { v += DPPF(v, 0xB1); v += DPPF(v, 0x4E); return v; }
__device__ __forceinline__ float gsum16(float v) { v += DPPF(v, 0x128); v += DPPF(v, 0x124); v += DPPF(v, 0x122); v += DPPF(v, 0x121); return v; }
__device__ __forceinline__ float rows4_sum(float v) {
    auto a = __builtin_amdgcn_permlane16_swap(__float_as_uint(v), __float_as_uint(v), false, false); v = __uint_as_float(a[0]) + __uint_as_float(a[1]);
    auto c = __builtin_amdgcn_permlane32_swap(__float_as_uint(v), __float_as_uint(v), false, false); return __uint_as_float(c[0]) + __uint_as_float(c[1]); }
__device__ __forceinline__ float wave_sum(float v) { return rows4_sum(gsum16(v)); }

struct Args { const float* in[24]; float* out; unsigned char* ws; int ph_lo, ph_hi; };
enum { I_X = 0, I_ATTN_NORM, I_AB_W_IN, I_CONV_W, I_CONV_B, I_GA_W, I_GA_B, I_GX_W, I_GX_B, I_LAM, I_AB_W_OUT, I_NSA_W_IN, I_PE_K, I_K_W1, I_K_W2, I_PE_V, I_V_W1, I_V_W2, I_NSA_W_OUT,
       I_FFN_NORM, I_FFN_W1, I_FFN_W3, I_FFN_W2, I_FINAL_NORM };

struct P0Desc { const float* colp; const float* gain; bf16* wt; int ld, K, k0, d0; };
__device__ __forceinline__ void p0_decode(const Args& A, unsigned char* ws, int it, int lane, P0Desc& D) {
    constexpr int I_ABIN = 16 * (AB_IN / 32), I_SQ = 16 * 32, I_NSAIN = 16 * (NSA_INP / 32), I_F13 = 16 * (FFH / 32), I_F2 = (FFH / 64) * 32, I_C1 = 32 * 2, I_C2 = 2;
    int r = it, mapk = 0, Ndst = 1024, half = 0; const float* W; D.gain = nullptr; D.K = 1024;
    if (r < I_ABIN) { W = A.in[I_AB_W_IN]; D.ld = AB_IN; Ndst = AB_IN; D.wt = (bf16*)(ws + W_ABIN); D.gain = A.in[I_ATTN_NORM]; mapk = 1; }
    else if ((r -= I_ABIN) < I_SQ) { W = A.in[I_AB_W_OUT]; D.ld = 1024; D.wt = (bf16*)(ws + W_ABOUT); }
    else if ((r -= I_SQ) < I_NSAIN) { W = A.in[I_NSA_W_IN]; D.ld = NSA_IN; Ndst = NSA_INP; D.wt = (bf16*)(ws + W_NSAIN); D.gain = A.in[I_ATTN_NORM] + DM; mapk = 2; }
    else if ((r -= I_NSAIN) < I_SQ) { W = A.in[I_NSA_W_OUT]; D.ld = 1024; D.wt = (bf16*)(ws + W_NSAOUT); }
    else if ((r -= I_SQ) < 4 * I_F13) { const int q = r / I_F13; r -= q * I_F13; const int L = q & 1; half = q >> 1;
        W = A.in[half ? I_FFN_W3 : I_FFN_W1] + (size_t)L * 1024 * FFH; D.ld = FFH; Ndst = FFH; D.wt = (bf16*)(ws + W_F13) + (size_t)L * 2 * FFH * 1024; D.gain = A.in[I_FFN_NORM] + L * DM; mapk = 3; }
    else if ((r -= 4 * I_F13) < 2 * I_F2) { const int L = r / I_F2; r -= L * I_F2; W = A.in[I_FFN_W2] + (size_t)L * FFH * 1024; D.ld = 1024; D.K = FFH; D.wt = (bf16*)(ws + W_F2) + (size_t)L * 1024 * FFH; }
    else if ((r -= 2 * I_F2) < 2 * I_C1) { const int v = r / I_C1; r -= v * I_C1; W = A.in[v ? I_V_W1 : I_K_W1]; D.ld = 64; Ndst = 64; D.K = 2048; D.wt = (bf16*)(ws + (v ? W_CV1 : W_CK1)); }
    else { r -= 2 * I_C1; const int v = r / I_C2; r -= v * I_C2; W = A.in[v ? I_V_W2 : I_K_W2]; D.ld = 64; Ndst = 64; D.K = 64; D.wt = (bf16*)(ws + (v ? W_CV2 : W_CK2)); }
    const int nblk = Ndst / 32, kb = r / nblk, nb = r % nblk, n0 = 32 * nb, c = n0 + (lane & 31); D.k0 = 64 * kb; D.d0 = n0; int sc = c;
    if (mapk == 1) { if (c >= 1024 && c < 2048) { const int hc = c & 63, gi = hc >> 3, e = hc & 7; sc = (c - hc) + (e < 4 ? 4 * gi + e : 32 + 4 * gi + (e - 4)); } }
    else if (mapk == 2) { if (c >= NSA_IN) sc = -1; else if (c < 1024 || (c >= 1536 && c < 1792) || (c >= 2048 && c < 2304)) { const int hc = c & 63; if (hc < 16) { const int gi = hc >> 3, e = hc & 7; sc = (c - hc) + (e < 4 ? 4 * gi + e : 8 + 4 * gi + (e - 4)); } } }
    else if (mapk == 3) D.d0 = 256 * (n0 >> 7) + (n0 & 127) + 128 * half;
    D.colp = (sc < 0) ? nullptr : W + sc;
}
__device__ __forceinline__ void p0_load(const P0Desc& D, float (&tv)[32], int lane) {
#pragma unroll
    for (int i = 0; i < 32; ++i) { const int kk = 2 * i + (lane >> 5); tv[i] = D.colp ? D.colp[(size_t)(D.k0 + kk) * D.ld] : 0.f; }
}
__device__ __forceinline__ void p0_store(const P0Desc& D, const float (&tv)[32], LAS float* scr, int lane) {
    if (D.gain) {
#pragma unroll
        for (int i = 0; i < 32; ++i) { const int kk = 2 * i + (lane >> 5); scr[kk * 33 + (lane & 31)] = tv[i] * D.gain[D.k0 + kk]; }
    } else {
#pragma unroll
        for (int i = 0; i < 32; ++i) { const int kk = 2 * i + (lane >> 5); scr[kk * 33 + (lane & 31)] = tv[i]; } }
    asm volatile("s_waitcnt lgkmcnt(0)" ::: "memory");
    const int c = lane & 7;
#pragma unroll
    for (int j = 0; j < 4; ++j) { const int n = (lane >> 3) + 8 * j; const LAS float* s = scr + (8 * c) * 33 + n;
        v4u o; o.x = pk2(s[0 * 33], s[1 * 33]); o.y = pk2(s[2 * 33], s[3 * 33]); o.z = pk2(s[4 * 33], s[5 * 33]); o.w = pk2(s[6 * 33], s[7 * 33]);
        *(v4u*)(D.wt + (size_t)(D.d0 + n) * D.K + D.k0 + 8 * c) = o; }
    asm volatile("s_waitcnt lgkmcnt(0)" ::: "memory");
}

__device__ __forceinline__ void final_norm_phase(float* h, const float* gain, int gw, int NGW, int lane) {
    for (int m = gw; m < MROWS; m += 8 * NGW) {
        f32x4 v[8][4]; float ss[8];
#pragma unroll
        for (int u = 0; u < 8; ++u) { const f32x4* xr = (const f32x4*)(h + (size_t)(m + u * NGW) * DM) + lane;
#pragma unroll
            for (int j = 0; j < 4; ++j) v[u][j] = xr[64 * j]; }
#pragma unroll
        for (int u = 0; u < 8; ++u) { float s = 0.f;
#pragma unroll
            for (int j = 0; j < 4; ++j) s += (v[u][j].x * v[u][j].x + v[u][j].y * v[u][j].y) + (v[u][j].z * v[u][j].z + v[u][j].w * v[u][j].w);
            ss[u] = 1.f / sqrtf(wave_sum(s) * (1.f / DM) + EPSF); }
        const f32x4* gr = (const f32x4*)gain + lane; f32x4 g[4];
#pragma unroll
        for (int j = 0; j < 4; ++j) g[j] = gr[64 * j];
#pragma unroll
        for (int u = 0; u < 8; ++u) { f32x4* o = (f32x4*)(h + (size_t)(m + u * NGW) * DM) + lane; const float rs = ss[u];
#pragma unroll
            for (int j = 0; j < 4; ++j) o[64 * j] = v[u][j] * rs * g[j]; }
    }
}

__device__ __forceinline__ void cast_stats_phase(const float* src, bf16* dst, float* SS, int gw, int NGW, int lane) {
    for (int m = gw; m < MROWS; m += 8 * NGW) {
        f32x4 v[8][4];
#pragma unroll
        for (int u = 0; u < 8; ++u) { const f32x4* xr = (const f32x4*)(src + (size_t)(m + u * NGW) * DM) + lane;
#pragma unroll
            for (int j = 0; j < 4; ++j) v[u][j] = xr[64 * j]; }
#pragma unroll
        for (int u = 0; u < 8; ++u) { float s = 0.f; unsigned long long* o8 = (unsigned long long*)(dst + (size_t)(m + u * NGW) * DM) + lane;
#pragma unroll
            for (int j = 0; j < 4; ++j) { s += (v[u][j].x * v[u][j].x + v[u][j].y * v[u][j].y) + (v[u][j].z * v[u][j].z + v[u][j].w * v[u][j].w);
                o8[64 * j] = (unsigned long long)pk2(v[u][j].x, v[u][j].y) | ((unsigned long long)pk2(v[u][j].z, v[u][j].w) << 32); }
            s = wave_sum(s); if (lane < 16) SS[(size_t)(m + u * NGW) * 16 + lane] = (lane == 0) ? s : 0.f; }
    }
}
__device__ __forceinline__ void p0_prologue(const Args& A, LAS unsigned char* lds, int wave, int lane) {
    unsigned char* ws = A.ws;
    LAS float* scr = (LAS float*)(lds + wave * 16384);
    const int gw = blockIdx.x * NWAVES + wave, NGW = gridDim.x * NWAVES;
    {   constexpr int I_ABIN = 16 * (AB_IN / 32), I_SQ = 16 * 32, I_NSAIN = 16 * (NSA_INP / 32), I_F13 = 16 * (FFH / 32), I_F2 = (FFH / 64) * 32, I_C1 = 32 * 2, I_C2 = 2;
        constexpr int NITEMS = I_ABIN + I_SQ + I_NSAIN + I_SQ + 4 * I_F13 + 2 * I_F2 + 2 * I_C1 + 2 * I_C2;
        P0Desc D0, D1; float ta[32], tb[32]; int it = gw;
        if (it < NITEMS) { p0_decode(A, ws, it, lane, D0); p0_load(D0, ta, lane); }
        while (it < NITEMS) {
            const int it1 = it + NGW; const bool has1 = it1 < NITEMS;
            if (has1) { p0_decode(A, ws, it1, lane, D1); p0_load(D1, tb, lane); }
            p0_store(D0, ta, scr, lane);
            if (!has1) break;
            const int it2 = it1 + NGW; const bool has2 = it2 < NITEMS;
            if (has2) { p0_decode(A, ws, it2, lane, D0); p0_load(D0, ta, lane); }
            p0_store(D1, tb, scr, lane);
            if (!has2) break;
            it = it2; } }
    {   const int gt = blockIdx.x * NTHREADS + threadIdx.x, NT = gridDim.x * NTHREADS;
        float* rc = (float*)(ws + TAB_RCOS); float* rsn = (float*)(ws + TAB_RSIN); float* nc = (float*)(ws + TAB_NCOS); float* ns = (float*)(ws + TAB_NSIN);
        for (int e = gt; e < 4096 * 40; e += NT) {
            const int pos = e / 40, i = e % 40; double inv;
            if (i < 32) inv = exp(-9.210340371976184 * ((double)i / 32.0));
            else inv = exp(-13.122363377404328 * ((double)(i - 32) / 8.0));
            double tr = (double)pos * inv * 0.15915494309189535; tr -= floor(tr);
            const float ft = (float)tr; const float sv = __builtin_amdgcn_sinf(ft), cv = __builtin_amdgcn_cosf(ft);
            if (i < 32) { rc[pos * 32 + i] = cv; rsn[pos * 32 + i] = sv; } else { nc[pos * 8 + (i - 32)] = cv; ns[pos * 8 + (i - 32)] = sv; }
        }
    }
    {   const int gt = blockIdx.x * NTHREADS + threadIdx.x, NT = gridDim.x * NTHREADS; bf16* GW = (bf16*)(ws + W_GATE);
        for (int e = gt; e < 2 * 8 * 4096; e += NT) { const int gate = e >> 15, r = e & 32767, n = r >> 12, jj = (r >> 6) & 63, ii = r & 63;
            GW[e] = (bf16)f2bf(A.in[gate ? I_GX_W : I_GA_W][n * 4096 + ii * 64 + jj]); } }
    for (int it = gw; it < 64; it += NGW) { const int which = it >> 5, ch = it & 31; const float* pe = A.in[which ? I_PE_V : I_PE_K] + ch * 64; const float* w1 = A.in[which ? I_V_W1 : I_K_W1] + (size_t)ch * 64 * 64 + lane;
        float s = 0.f;
#pragma unroll 16
        for (int k = 0; k < 64; ++k) s += pe[k] * w1[k * 64];
        ((float*)(ws + TAB_CB))[128 + it * 64 + lane] = s; }
    cast_stats_phase(A.in[I_X], (bf16*)(ws + WS_XN), (float*)(ws + WS_SS), gw, NGW, lane);
}

__device__ __forceinline__ float fsigm(float x) { return __builtin_amdgcn_rcpf(1.f + __builtin_amdgcn_exp2f(-LOG2E * x)); }
__device__ __forceinline__ void lru_item(const Args& A, LAS unsigned char* lds, int item, int mode) {
    LAS bf16* WT = (LAS bf16*)lds; LAS float* RAW = (LAS float*)(lds + 18432); LAS bf16* XB = (LAS bf16*)(lds + 18432 + 17408); LAS float* G = (LAS float*)(lds + 18432 + 17408 + 9216);
    LAS float* PH = G + 8192; LAS float* CAR = PH + 1024;
    const int tid = threadIdx.x, lane = tid & 63, j = tid & 63, tg = tid >> 6, w = tg, lr = lane & 15, lq = lane >> 4;
    const int b = item >> 7, n = (item >> 4) & 7, seg = item & 15, c = n * 64 + j;
    const bf16* P0 = (const bf16*)(A.ws + WS_PROJ0); bf16* CAT = (bf16*)(A.ws + WS_CAT); float* LS = (float*)(A.ws + WS_LSUM);
    __syncthreads();
    const float gab = A.in[I_GA_B][c], gxb = A.in[I_GX_B][c], lam = A.in[I_LAM][c];
    const float sp8 = 8.f * LOG2E * log1pf(expf(-lam));
    const float cw0 = A.in[I_CONV_W][c], cw1 = A.in[I_CONV_W][512 + c], cw2 = A.in[I_CONV_W][1024 + c], cw3 = A.in[I_CONV_W][1536 + c], cb = A.in[I_CONV_B][c];
    float carry = 0.f, ptot = 1.f;
    if (mode == 1) { float pp[15], hh[15];
#pragma unroll
        for (int s2 = 0; s2 < 15; ++s2) { pp[s2] = 1.f; hh[s2] = 0.f; if (s2 < seg) { const float* q = LS + ((size_t)(b * 16 + s2) * 512 + c) * 2; pp[s2] = q[0]; hh[s2] = q[1]; } }
#pragma unroll
        for (int s2 = 0; s2 < 15; ++s2) carry = pp[s2] * carry + hh[s2]; }
    if (tg == 0) CAR[j] = carry;
    __syncthreads();
    bf16x8 bfr[4][2];
#pragma unroll
    for (int nt = 0; nt < 4; ++nt)
#pragma unroll
        for (int ks = 0; ks < 2; ++ks) bfr[nt][ks] = *(const bf16x8*)((const bf16*)(A.ws + W_GATE) + (size_t)(((w & 1) * 8 + n) * 64 + 16 * nt + lr) * 64 + 32 * ks + 8 * lq);
    const bf16* xrb = P0 + (size_t)(b * SEQ) * AB_IN + 512 + c;
    bf16 rawn[9];
#pragma unroll
    for (int i = 0; i < 9; ++i) { const int r = tg + 8 * i, t = seg * 256 - 3 + r; rawn[i] = (r < 67 && t >= 0) ? xrb[(size_t)t * AB_IN] : (bf16)0; }
    for (int sub = 0; sub < 4; ++sub) {
        const int t0 = seg * 256 + sub * 64;
        bf16 yv[8];
        if (mode == 1) {
#pragma unroll
            for (int q = 0; q < 8; ++q) yv[q] = P0[((size_t)b * SEQ + t0 + tg * 8 + q) * AB_IN + c]; }
#pragma unroll
        for (int i = 0; i < 9; ++i) { const int r = tg + 8 * i; if (r < 67) RAW[r * 64 + j] = bf2f(rawn[i]); }
        if (sub < 3) {
#pragma unroll
            for (int i = 0; i < 9; ++i) { const int r = tg + 8 * i, t = t0 + 64 - 3 + r; rawn[i] = (r < 67) ? xrb[(size_t)t * AB_IN] : (bf16)0; } }
        __syncthreads();
        float xv[8];
#pragma unroll
        for (int q = 0; q < 8; ++q) { const int tt = tg * 8 + q; const float x = cb + cw0 * RAW[tt * 64 + j] + cw1 * RAW[(tt + 1) * 64 + j] + cw2 * RAW[(tt + 2) * 64 + j] + cw3 * RAW[(tt + 3) * 64 + j]; xv[q] = x; XB[tt * 72 + j] = (bf16)f2bf(x); }
        __syncthreads();
        {
            const int mt = w >> 1; bf16x8 af[2];
#pragma unroll
            for (int ks = 0; ks < 2; ++ks) af[ks] = *(const LAS bf16x8*)(XB + (16 * mt + lr) * 72 + 32 * ks + 8 * lq);
            LAS float* Gw = G + (w & 1) * 4096 + (16 * mt + 4 * lq) * 64 + lr;
#pragma unroll
            for (int nt = 0; nt < 4; ++nt) { f32x4 acc = mfma16(af[0], bfr[nt][0], (f32x4){0.f, 0.f, 0.f, 0.f}); acc = mfma16(af[1], bfr[nt][1], acc);
#pragma unroll
                for (int r = 0; r < 4; ++r) Gw[r * 64 + 16 * nt] = acc[r]; } }
        __syncthreads();
        float av[8], uv[8]; float Pl = 1.f, Hl = 0.f;
#pragma unroll
        for (int q = 0; q < 8; ++q) { const int tt = tg * 8 + q; const float r = fsigm(G[tt * 64 + j] + gab), ig = fsigm(G[4096 + tt * 64 + j] + gxb);
            const float a = __builtin_amdgcn_exp2f(-sp8 * r); const float mult = sqrtf(fmaf(-a, a, 1.f));
            av[q] = a; uv[q] = mult * (ig * xv[q]); Hl = a * Hl + uv[q]; Pl *= a; }
        PH[(tg * 64 + j) * 2] = Pl; PH[(tg * 64 + j) * 2 + 1] = Hl;
        __syncthreads();
        float cin = CAR[j];
        {   float pp[7], hh[7];
#pragma unroll
            for (int g2 = 0; g2 < 7; ++g2) { pp[g2] = PH[(g2 * 64 + j) * 2]; hh[g2] = PH[(g2 * 64 + j) * 2 + 1]; }
#pragma unroll
            for (int g2 = 0; g2 < 7; ++g2) if (g2 < tg) cin = pp[g2] * cin + hh[g2]; }
#pragma unroll
        for (int q = 0; q < 8; ++q) { cin = av[q] * cin + uv[q];
            if (mode == 1) { const size_t row = (size_t)b * SEQ + t0 + tg * 8 + q; const float y = bf2f(yv[q]); const float u = 0.7978845608028654f * (y + 0.044715f * y * y * y);
                CAT[row * DM + c] = (bf16)f2bf(cin * y * fsigm(2.f * u)); } }
        __syncthreads();
        if (tg == 7) { CAR[j] = cin; if (mode == 0) { float pt = 1.f;
#pragma unroll
                for (int g2 = 0; g2 < 8; ++g2) pt *= PH[(g2 * 64 + j) * 2]; ptot *= pt; } }
    }
    if (mode == 0 && tg == 7) { float* q = LS + ((size_t)(b * 16 + seg) * 512 + c) * 2; q[0] = ptot; q[1] = CAR[j]; }
}

__device__ __forceinline__ float ret_log_g(int h) { return log1pf(-exp2f(-5.f - (float)h)); }
__device__ __forceinline__ void ret_kv_load(const bf16* P0, int item, int tid, v4u (&kraw)[2], v4u (&vraw)[2]) {
    const int b = item >> 8, h = (item >> 5) & 7, m = item & 31; const size_t row0 = (size_t)b * SEQ + m * 128;
#pragma unroll
    for (int rep = 0; rep < 2; ++rep) { const bf16* rp = P0 + (row0 + (tid >> 3) + 64 * rep) * AB_IN + h * 64 + 8 * (tid & 7); kraw[rep] = *(const v4u*)(rp + 1536); vraw[rep] = *(const v4u*)(rp + 2048); }
}
__device__ __forceinline__ void ret_kv_run(const Args& A, LAS unsigned char* lds, int first, int stride, int end) {
    LAS bf16* VT = (LAS bf16*)lds; LAS bf16* KT = VT + 64 * 136;
    const int tid = threadIdx.x, lane = tid & 63, w = tid >> 6, lr = lane & 15, lq = lane >> 4;
    const bf16* P0 = (const bf16*)(A.ws + WS_PROJ0); float* KVT = (float*)(A.ws + WS_KVT);
    v4u kraw[2], vraw[2];
    if (first < end) ret_kv_load(P0, first, tid, kraw, vraw);
    for (int item = first; item < end; item += stride) {
        const int b = item >> 8, h = (item >> 5) & 7, m = item & 31; const float l2g = ret_log_g(h) * LOG2E;
        __syncthreads();
#pragma unroll
        for (int rep = 0; rep < 2; ++rep) { const int jj = (tid >> 3) + 64 * rep, e8 = tid & 7; const float dec = __builtin_amdgcn_exp2f((float)(127 - jj) * l2g);
            const unsigned kw[4] = {kraw[rep].x, kraw[rep].y, kraw[rep].z, kraw[rep].w}, vw[4] = {vraw[rep].x, vraw[rep].y, vraw[rep].z, vraw[rep].w};
#pragma unroll
            for (int i = 0; i < 4; ++i) { VT[(8 * e8 + 2 * i) * 136 + jj] = (bf16)(vw[i] & 0xffffu); VT[(8 * e8 + 2 * i + 1) * 136 + jj] = (bf16)(vw[i] >> 16);
                KT[(8 * e8 + 2 * i) * 136 + jj] = (bf16)f2bf(bf2f((bf16)(kw[i] & 0xffffu)) * dec); KT[(8 * e8 + 2 * i + 1) * 136 + jj] = (bf16)f2bf(bf2f((bf16)(kw[i] >> 16)) * dec); } }
        if (item + stride < end) ret_kv_load(P0, item + stride, tid, kraw, vraw);
        __syncthreads();
        const int et = w >> 1, dt0 = (w & 1) * 2; f32x4 acc[2] = {(f32x4){0.f, 0.f, 0.f, 0.f}, (f32x4){0.f, 0.f, 0.f, 0.f}};
#pragma unroll
        for (int ks = 0; ks < 4; ++ks) { const bf16x8 af = *(const LAS bf16x8*)(VT + (16 * et + lr) * 136 + 32 * ks + 8 * lq);
#pragma unroll
            for (int dd = 0; dd < 2; ++dd) { const bf16x8 bfr = *(const LAS bf16x8*)(KT + (16 * (dt0 + dd) + lr) * 136 + 32 * ks + 8 * lq); acc[dd] = mfma16(af, bfr, acc[dd]); } }
        float* o = KVT + ((size_t)((b * 8 + h) * 32 + m)) * 4096;
#pragma unroll
        for (int dd = 0; dd < 2; ++dd)
#pragma unroll
            for (int r = 0; r < 4; ++r) o[(16 * et + 4 * lq + r) * 64 + 16 * (dt0 + dd) + lr] = acc[dd][r];
    }
}
constexpr int VT_LD = 136, ST_LD = 72, PW_LD = 72;
struct RetPre { v4u vraw[2]; f32x4 ka, kc; };
__device__ __forceinline__ void ret_out_pre(const Args& A, int item, bool first, RetPre& R) {
    const int tid = threadIdx.x, b = item >> 8, h = (item >> 5) & 7, n = item & 31; const bf16* P0 = (const bf16*)(A.ws + WS_PROJ0); const float* KVT = (const float*)(A.ws + WS_KVT); const size_t row0 = (size_t)b * SEQ + n * 128;
#pragma unroll
    for (int rep = 0; rep < 2; ++rep) R.vraw[rep] = *(const v4u*)(P0 + (row0 + (tid >> 3) + 64 * rep) * AB_IN + 2048 + h * 64 + 8 * (tid & 7));
    const float* kp = KVT + ((size_t)((b * 8 + h) * 32)) * 4096 + tid * 8; R.ka = (f32x4){0.f, 0.f, 0.f, 0.f}; R.kc = R.ka;
    if (!first) { R.ka = *(const f32x4*)(kp + (size_t)(n - 1) * 4096); R.kc = *(const f32x4*)(kp + (size_t)(n - 1) * 4096 + 4); }
}
__device__ __forceinline__ void ret_out_item(const Args& A, LAS unsigned char* lds, int item, bool first, RetPre& R, int next_item, bool next_first) {
    LAS bf16* VT = (LAS bf16*)lds;
    LAS bf16* STT = VT + 64 * VT_LD;
    LAS bf16* PWall = STT + 64 * ST_LD;
    const int tid = threadIdx.x, lane = tid & 63, w = tid >> 6, lr = lane & 15, lq = lane >> 4, b = item >> 8, h = (item >> 5) & 7, n = item & 31;
    const bf16* P0 = (const bf16*)(A.ws + WS_PROJ0); const float* KVT = (const float*)(A.ws + WS_KVT); bf16* CAT = (bf16*)(A.ws + WS_CAT);
    const float lg = ret_log_g(h), l2g = lg * LOG2E;
    const size_t row0 = (size_t)b * SEQ + n * 128;
    const v4u vraw[2] = {R.vraw[0], R.vraw[1]}; const f32x4 ka = R.ka, kc = R.kc;
    const float* kp = KVT + ((size_t)((b * 8 + h) * 32)) * 4096 + tid * 8;
    bf16x8 qa[2], kf[2][4][2];
#pragma unroll
    for (int ks = 0; ks < 2; ++ks) qa[ks] = *(const bf16x8*)(P0 + (row0 + 16 * w + lr) * AB_IN + 1024 + h * 64 + 32 * ks + 8 * lq);
    const int ntile = (w >= 4) ? 2 : 1;
#pragma unroll
    for (int jt = 0; jt < 2; ++jt) if (jt < ntile) {
#pragma unroll
        for (int nt = 0; nt < 4; ++nt) { const bf16* kq = P0 + (row0 + 64 * jt + 16 * nt + lr) * AB_IN + 1536 + h * 64 + 8 * lq; kf[jt][nt][0] = *(const bf16x8*)kq; kf[jt][nt][1] = *(const bf16x8*)(kq + 32); } }
    bf16 gv[4][4];
#pragma unroll
    for (int r = 0; r < 4; ++r)
#pragma unroll
        for (int ct = 0; ct < 4; ++ct) gv[r][ct] = P0[(row0 + 16 * w + lq * 4 + r) * AB_IN + 2560 + h * 64 + 16 * ct + lr];
    __syncthreads();
#pragma unroll
    for (int rep = 0; rep < 2; ++rep) { const int jj = (tid >> 3) + 64 * rep, e8 = tid & 7; const unsigned wv[4] = {vraw[rep].x, vraw[rep].y, vraw[rep].z, vraw[rep].w};
#pragma unroll
        for (int i = 0; i < 4; ++i) { VT[(8 * e8 + 2 * i) * VT_LD + jj] = (bf16)(wv[i] & 0xffffu); VT[(8 * e8 + 2 * i + 1) * VT_LD + jj] = (bf16)(wv[i] >> 16); } }
    {   LAS float* SF = (LAS float*)(PWall + 8 * 16 * PW_LD);
        float st[8]; const float cd = expf(128.f * lg);
        if (first) {
#pragma unroll
            for (int i = 0; i < 8; ++i) st[i] = 0.f;
            int m = 0;
            for (; m + 4 <= n; m += 4) { f32x4 a[4], c[4];
#pragma unroll
                for (int u = 0; u < 4; ++u) { a[u] = *(const f32x4*)(kp + (size_t)(m + u) * 4096); c[u] = *(const f32x4*)(kp + (size_t)(m + u) * 4096 + 4); }
#pragma unroll
                for (int u = 0; u < 4; ++u) { st[0] = st[0] * cd + a[u].x; st[1] = st[1] * cd + a[u].y; st[2] = st[2] * cd + a[u].z; st[3] = st[3] * cd + a[u].w; st[4] = st[4] * cd + c[u].x; st[5] = st[5] * cd + c[u].y; st[6] = st[6] * cd + c[u].z; st[7] = st[7] * cd + c[u].w; } }
            for (; m < n; ++m) { const f32x4 a = *(const f32x4*)(kp + (size_t)m * 4096), c = *(const f32x4*)(kp + (size_t)m * 4096 + 4);
                st[0] = st[0] * cd + a.x; st[1] = st[1] * cd + a.y; st[2] = st[2] * cd + a.z; st[3] = st[3] * cd + a.w; st[4] = st[4] * cd + c.x; st[5] = st[5] * cd + c.y; st[6] = st[6] * cd + c.z; st[7] = st[7] * cd + c.w; }
        } else {
            const f32x4 p0 = *(const LAS f32x4*)(SF + tid * 8), p1 = *(const LAS f32x4*)(SF + tid * 8 + 4);
            st[0] = p0.x * cd + ka.x; st[1] = p0.y * cd + ka.y; st[2] = p0.z * cd + ka.z; st[3] = p0.w * cd + ka.w; st[4] = p1.x * cd + kc.x; st[5] = p1.y * cd + kc.y; st[6] = p1.z * cd + kc.z; st[7] = p1.w * cd + kc.w; }
        *(LAS f32x4*)(SF + tid * 8) = (f32x4){st[0], st[1], st[2], st[3]}; *(LAS f32x4*)(SF + tid * 8 + 4) = (f32x4){st[4], st[5], st[6], st[7]};
        const int e = tid >> 3, d0 = (tid & 7) * 8; v4u o; o.x = pk2(st[0], st[1]); o.y = pk2(st[2], st[3]); o.z = pk2(st[4], st[5]); o.w = pk2(st[6], st[7]);
        *(LAS v4u*)(STT + e * ST_LD + d0) = o; }
    __syncthreads();
    if (next_item >= 0) ret_out_pre(A, next_item, next_first, R);
    LAS bf16* PW = PWall + w * 16 * PW_LD;
    f32x4 O1[4], O2[4];
#pragma unroll
    for (int ct = 0; ct < 4; ++ct) { O1[ct] = (f32x4){0.f, 0.f, 0.f, 0.f}; O2[ct] = (f32x4){0.f, 0.f, 0.f, 0.f}; }
#pragma unroll
    for (int jt = 0; jt < 2; ++jt) if (jt < ntile) {
        f32x4 s[4];
#pragma unroll
        for (int nt = 0; nt < 4; ++nt) { s[nt] = mfma16(qa[0], kf[jt][nt][0], (f32x4){0.f, 0.f, 0.f, 0.f}); s[nt] = mfma16(qa[1], kf[jt][nt][1], s[nt]); }
#pragma unroll
        for (int nt = 0; nt < 4; ++nt)
#pragma unroll
            for (int r = 0; r < 4; ++r) { const int i = 16 * w + lq * 4 + r, jj = 64 * jt + 16 * nt + lr, dd = i - jj;
                const float p = (dd >= 0) ? s[nt][r] * __builtin_amdgcn_exp2f((float)dd * l2g) : 0.f; PW[(lq * 4 + r) * PW_LD + 16 * nt + lr] = (bf16)f2bf(p); }
        bf16x8 pa[2];
#pragma unroll
        for (int ks = 0; ks < 2; ++ks) pa[ks] = *(const LAS bf16x8*)(PW + lr * PW_LD + 32 * ks + 8 * lq);
#pragma unroll
        for (int ct = 0; ct < 4; ++ct)
#pragma unroll
            for (int ks = 0; ks < 2; ++ks) { const bf16x8 vb = *(const LAS bf16x8*)(VT + (16 * ct + lr) * VT_LD + 64 * jt + 32 * ks + 8 * lq); O1[ct] = mfma16(pa[ks], vb, O1[ct]); }
    }
#pragma unroll
    for (int ct = 0; ct < 4; ++ct)
#pragma unroll
        for (int ks = 0; ks < 2; ++ks) { const bf16x8 sb = *(const LAS bf16x8*)(STT + (16 * ct + lr) * ST_LD + 32 * ks + 8 * lq); O2[ct] = mfma16(qa[ks], sb, O2[ct]); }
#pragma unroll
    for (int r = 0; r < 4; ++r) { const int i = 16 * w + lq * 4 + r; const float qd = __builtin_amdgcn_exp2f((float)(i + 1) * l2g);
        float o[4]; float sm = 0.f;
#pragma unroll
        for (int ct = 0; ct < 4; ++ct) { o[ct] = O1[ct][r] + qd * O2[ct][r]; sm += o[ct]; }
        const float mean = gsum16(sm) * (1.f / 64.f); float vs = 0.f;
#pragma unroll
        for (int ct = 0; ct < 4; ++ct) { o[ct] -= mean; vs += o[ct] * o[ct]; }
        const float rstd = 1.f / sqrtf(gsum16(vs) * (1.f / 64.f) + EPSF);
        const size_t row = row0 + i;
#pragma unroll
        for (int ct = 0; ct < 4; ++ct) { const int e = 16 * ct + lr; const float g = bf2f(gv[r][ct]); CAT[row * DM + 512 + h * 64 + e] = (bf16)f2bf(o[ct] * rstd * (g * sigm(g))); } }
}
__device__ __forceinline__ void cmp_bias_to_lds(const Args& A, LAS unsigned char* lds) {
    const float* CB = (const float*)(A.ws + TAB_CB); const int tid = threadIdx.x;
    if (tid < 128) { float s = 0.f;
#pragma unroll
        for (int ch = 0; ch < 32; ++ch) s += CB[128 + ((tid >> 6) * 32 + ch) * 64 + (tid & 63)];
        ((LAS float*)(lds + 40960))[tid] = s; }
    __syncthreads();
}
__device__ __forceinline__ void cmp_item(const Args& A, LAS unsigned char* lds, int item) {
    LAS float* RED = (LAS float*)lds; LAS bf16* HID = (LAS bf16*)(lds + 32768);
    const int tid = threadIdx.x, lane = tid & 63, w = tid >> 6, lr = lane & 15, lq = lane >> 4;
    const int cgrp = item & 3, kv = (item >> 2) & 1, g = (item >> 3) & 3, b = item >> 5;
    const bf16* W1T = (const bf16*)(A.ws + (kv ? W_CV1 : W_CK1)); const bf16* W2T = (const bf16*)(A.ws + (kv ? W_CV2 : W_CK2)); const bf16* KV6 = (const bf16*)(A.ws + WS_KV6);
    bf16* KC = (bf16*)(A.ws + WS_KC); bf16* VCT = (bf16*)(A.ws + WS_VCT); const float* NC = (const float*)(A.ws + TAB_NCOS); const float* NS = (const float*)(A.ws + TAB_NSIN);
    bf16x8 bw[4][2][4];
#pragma unroll
    for (int lt = 0; lt < 4; ++lt)
#pragma unroll
        for (int ks = 0; ks < 2; ++ks)
#pragma unroll
            for (int nt = 0; nt < 4; ++nt) bw[lt][ks][nt] = *(const bf16x8*)(W1T + (size_t)(16 * nt + lr) * 2048 + (4 * w + lt) * 64 + 32 * ks + 8 * lq);
    bf16x8 w2f[2] = {(bf16x8){0, 0, 0, 0, 0, 0, 0, 0}, (bf16x8){0, 0, 0, 0, 0, 0, 0, 0}};
    if (w < 4) {
#pragma unroll
        for (int ks = 0; ks < 2; ++ks) w2f[ks] = *(const bf16x8*)(W2T + (16 * w + lr) * 64 + 32 * ks + 8 * lq); }
    bf16x8 af[4][2];
#define CMP_LOADA(ct_) do { const int c_ = 16 * (ct_) + lr; _Pragma("unroll") for (int lt = 0; lt < 4; ++lt) { int tok = 16 * c_ + 4 * w + lt; tok = tok > SEQ - 1 ? SEQ - 1 : tok; \
        const bf16* arow = KV6 + ((size_t)b * SEQ + tok) * 1536 + kv * 256 + g * 64; _Pragma("unroll") for (int ks = 0; ks < 2; ++ks) af[lt][ks] = *(const bf16x8*)(arow + 32 * ks + 8 * lq); } } while (0)
    CMP_LOADA(4 * cgrp);
    for (int ti = 0; ti < 4; ++ti) { const int ctile = 4 * cgrp + ti;
        f32x4 acc[4];
#pragma unroll
        for (int nt = 0; nt < 4; ++nt) acc[nt] = (f32x4){0.f, 0.f, 0.f, 0.f};
#pragma unroll
        for (int lt = 0; lt < 4; ++lt)
#pragma unroll
            for (int ks = 0; ks < 2; ++ks)
#pragma unroll
                for (int nt = 0; nt < 4; ++nt) acc[nt] = mfma16(af[lt][ks], bw[lt][ks][nt], acc[nt]);
        __syncthreads();
        if (ti < 3) CMP_LOADA(ctile + 1);
#pragma unroll
        for (int nt = 0; nt < 4; ++nt)
#pragma unroll
            for (int r = 0; r < 4; ++r) RED[(w * 16 + lq * 4 + r) * 64 + 16 * nt + lr] = acc[nt][r];
        __syncthreads();
#pragma unroll
        for (int rep = 0; rep < 2; ++rep) { const int e = tid + rep * NTHREADS, row = e >> 6, col = e & 63; float s = ((const LAS float*)(lds + 40960))[kv * 64 + col];
#pragma unroll
            for (int w2 = 0; w2 < 8; ++w2) s += RED[(w2 * 16 + row) * 64 + col];
            HID[row * 72 + col] = (bf16)f2bf(gelu_tanh(s)); }
        __syncthreads();
        if (w < 4) {
            f32x4 o = (f32x4){0.f, 0.f, 0.f, 0.f};
#pragma unroll
            for (int ks = 0; ks < 2; ++ks) { const bf16x8 a = *(const LAS bf16x8*)(HID + lr * 72 + 32 * ks + 8 * lq); o = mfma16(a, w2f[ks], o); }
#pragma unroll
            for (int r = 0; r < 4; ++r) { const int cc = 16 * ctile + lq * 4 + r, dim = 16 * w + lr; float val = o[r];
                if (kv == 0) {
                    if (w == 0) { const float partner = DPPF(val, 0x128);   int pos = 16 * cc + 31; pos = pos > SEQ - 1 ? SEQ - 1 : pos; const int f = lr & 7; const float cs = NC[pos * 8 + f], sn = NS[pos * 8 + f];
                        val = (lr < 8) ? (val * cs - partner * sn) : (val * cs + partner * sn); }
                    KC[((size_t)(b * 256 + cc) * 4 + g) * 64 + dim] = (bf16)f2bf(val);
                } else VCT[((size_t)(b * 4 + g) * 64 + dim) * 256 + cc] = (bf16)f2bf(val); }
        }
    }
#undef CMP_LOADA
}
typedef float f32x2 __attribute__((ext_vector_type(2))); typedef __bf16 bf16x2_t __attribute__((ext_vector_type(2)));
__device__ __forceinline__ unsigned cvtpk(float lo, float hi) { f32x2 v = {lo, hi}; bf16x2_t b = __builtin_convertvector(v, bf16x2_t); return __builtin_bit_cast(unsigned, b); }
__device__ __forceinline__ float vmax3(float a, float b, float c) { float r; asm("v_max3_f32 %0, %1, %2, %3" : "=v"(r) : "v"(a), "v"(b), "v"(c)); return r; }
__device__ __forceinline__ float vmax2(float a, float b) { float r; asm("v_max_f32_e32 %0, %1, %2" : "=v"(r) : "v"(a), "v"(b)); return r; }
__device__ __forceinline__ float colmax4(float v) {
    auto a = __builtin_amdgcn_permlane16_swap(__float_as_uint(v), __float_as_uint(v), false, false); v = vmax2(__uint_as_float(a[0]), __uint_as_float(a[1]));
    auto c = __builtin_amdgcn_permlane32_swap(__float_as_uint(v), __float_as_uint(v), false, false); return vmax2(__uint_as_float(c[0]), __uint_as_float(c[1])); }
__device__ __forceinline__ float colsum4(float v) { return rows4_sum(v); }
struct NsaSt { float mhat[2], l[2], invl[2]; f32x4 O[4][2]; };
template <int MODE>
__device__ __forceinline__ void nsa_softmax(NsaSt& S, f32x4 (&st)[4], const int nq, const int klo, const int khi, const bool colok, const int kb, LAS float* PSrow, const int lr, const int lq, bf16x8& p0, bf16x8& p1) {
    if (MODE <= 2) {
        const unsigned span = (khi >= klo) ? (unsigned)(khi - klo) : 0u; const int base = (khi >= klo) ? kb - klo : -0x40000000;
#pragma unroll
        for (int mt = 0; mt < 4; ++mt)
#pragma unroll
            for (int r = 0; r < 4; ++r) { const bool ok = (unsigned)(base + 32 * (mt >> 1) + 4 * (mt & 1) + r) <= span; st[mt][r] = ok ? st[mt][r] : NEGF; } }
    if (MODE != 1) {
        float a = st[0][0];
        asm volatile("s_nop 15\n\ts_nop 1\n\tv_max3_f32 %0, %0, %1, %2\n\tv_max3_f32 %0, %0, %3, %4\n\tv_max3_f32 %0, %0, %5, %6\n\tv_max3_f32 %0, %0, %7, %8\n\tv_max3_f32 %0, %0, %9, %10\n\tv_max3_f32 %0, %0, %11, %12\n\tv_max3_f32 %0, %0, %13, %14\n\tv_max_f32_e32 %0, %0, %15"
                     : "+v"(a) : "v"(st[0][1]), "v"(st[0][2]), "v"(st[0][3]), "v"(st[1][0]), "v"(st[1][1]), "v"(st[1][2]), "v"(st[1][3]), "v"(st[2][0]), "v"(st[2][1]), "v"(st[2][2]),
                       "v"(st[2][3]), "v"(st[3][0]), "v"(st[3][1]), "v"(st[3][2]), "v"(st[3][3]));
        a = colok ? a : NEGF; const float tmax = colmax4(a);
        if (__any(tmax > 8.f)) { const float dl = (tmax > 8.f) ? tmax : 0.f, f = __builtin_amdgcn_exp2f(-dl); S.mhat[nq] += dl; S.l[nq] *= f;
#pragma unroll
            for (int mt = 0; mt < 4; ++mt) st[mt] -= dl;
            if (MODE >= 2) {
#pragma unroll
                for (int ct = 0; ct < 4; ++ct) S.O[ct][nq] *= f; } }
    }
#pragma unroll
    for (int mt = 0; mt < 4; ++mt)
#pragma unroll
        for (int r = 0; r < 4; ++r) st[mt][r] = __builtin_amdgcn_exp2f(st[mt][r]);
    if (MODE == 1) {
#pragma unroll
        for (int mt = 0; mt < 4; ++mt) st[mt] *= S.invl[nq];
#pragma unroll
        for (int mt = 0; mt < 4; ++mt) { f32x4 hs = st[mt];
#pragma unroll
            for (int r = 0; r < 4; ++r) hs[r] = qsum4(hs[r]);
            if ((lr & 3) == 0) *(LAS f32x4*)(PSrow + (4 * nq + (lr >> 2)) * 256 + 32 * (mt >> 1) + 4 * (mt & 1) + 8 * lq) = hs; }
    } else { f32x2 a2 = (f32x2){st[0][0], st[0][1]} + (f32x2){st[0][2], st[0][3]};
#pragma unroll
        for (int mt = 1; mt < 4; ++mt) { a2 += (f32x2){st[mt][0], st[mt][1]}; a2 += (f32x2){st[mt][2], st[mt][3]}; }
        const float ls = a2.x + a2.y; S.l[nq] += colok ? ls : 0.f; }
    if (MODE >= 1) {
#pragma unroll
        for (int kk = 0; kk < 2; ++kk) { const f32x4 a = st[2 * kk], c = st[2 * kk + 1]; v4u pk; pk.x = cvtpk(a[0], a[1]); pk.y = cvtpk(a[2], a[3]); pk.z = cvtpk(c[0], c[1]); pk.w = cvtpk(c[2], c[3]);
            if (MODE >= 2 && !colok) pk = (v4u){0u, 0u, 0u, 0u};
            if (kk == 0) p0 = __builtin_bit_cast(bf16x8, pk); else p1 = __builtin_bit_cast(bf16x8, pk); } }
}
template <int MODE>
__device__ __forceinline__ void nsa_full(NsaSt& S, const bf16x8 (&qf)[2][2], const LAS unsigned char* kbuf, const int koff, const int voff, const int klo0, const int klo1, const int khi0, const int khi1, const bool col0, const bool col1,
                                          const int kb, LAS float* PSrow, const int lr, const int lq) {
    bf16x8 kf[4][2];
#pragma unroll
    for (int mt = 0; mt < 4; ++mt) { kf[mt][0] = *(const LAS bf16x8*)(kbuf + 4096 * (mt >> 1) + 512 * (mt & 1) + koff); kf[mt][1] = *(const LAS bf16x8*)(kbuf + 4096 * (mt >> 1) + 512 * (mt & 1) + (koff ^ 64)); }
    f32x4 st0[4], st1[4];
    {   const float n0 = -S.mhat[0], n1 = -S.mhat[1]; const f32x4 negm0 = (f32x4){n0, n0, n0, n0}, negm1 = (f32x4){n1, n1, n1, n1};
#pragma unroll
        for (int mt = 0; mt < 4; ++mt) st0[mt] = mfma16(kf[mt][0], qf[0][0], negm0);
#pragma unroll
        for (int mt = 0; mt < 4; ++mt) st0[mt] = mfma16(kf[mt][1], qf[0][1], st0[mt]);
#pragma unroll
        for (int mt = 0; mt < 4; ++mt) st1[mt] = mfma16(kf[mt][0], qf[1][0], negm1);
#pragma unroll
        for (int mt = 0; mt < 4; ++mt) st1[mt] = mfma16(kf[mt][1], qf[1][1], st1[mt]); }
    __builtin_amdgcn_sched_barrier(0);
    bf16x8 p0, p1; bf16x8 vf[4][2];
    nsa_softmax<MODE>(S, st0, 0, klo0, khi0, col0, kb, PSrow, lr, lq, p0, p1);
    if (MODE >= 1) {
        const LAS unsigned char* vbuf = kbuf + 8192;
#pragma unroll
        for (int ct = 0; ct < 4; ++ct)
#pragma unroll
            for (int kk = 0; kk < 2; ++kk) vf[ct][kk] = *(const LAS bf16x8*)(vbuf + 2048 * ct + (voff ^ (64 * kk)));
#pragma unroll
        for (int ct = 0; ct < 4; ++ct) { S.O[ct][0] = mfma16(vf[ct][0], p0, S.O[ct][0]); S.O[ct][0] = mfma16(vf[ct][1], p1, S.O[ct][0]); } }
    __builtin_amdgcn_sched_barrier(0);
    nsa_softmax<MODE>(S, st1, 1, klo1, khi1, col1, kb, PSrow, lr, lq, p0, p1);
    if (MODE >= 1) {
#pragma unroll
        for (int ct = 0; ct < 4; ++ct) { S.O[ct][1] = mfma16(vf[ct][0], p0, S.O[ct][1]); S.O[ct][1] = mfma16(vf[ct][1], p1, S.O[ct][1]); } }
}
__device__ __forceinline__ void nsa_item2(const Args& A, LAS unsigned char* lds, int item) {
    const int tid = threadIdx.x, lane = tid & 63, w = tid >> 6, lr = lane & 15, lq = lane >> 4;
    const int qt = item >> 5, b = (item >> 2) & 7, g = item & 3, t0 = qt * 64, cur = qt;
    const bf16* Qb = (const bf16*)(A.ws + WS_Q); const bf16* KV6 = (const bf16*)(A.ws + WS_KV6); const bf16* KC = (const bf16*)(A.ws + WS_KC); const bf16* VCT = (const bf16*)(A.ws + WS_VCT);
    const bf16* VTS = (const bf16*)(A.ws + WS_VTS); const bf16* VTW = (const bf16*)(A.ws + WS_VTW); const float* GT = (const float*)(A.ws + WS_GATES); bf16* ATT = (bf16*)(A.ws + WS_CAT);
    LAS float* PS = (LAS float*)(lds + 65536) + w * 2048;
    const int head = 4 * g + (lr & 3);
#define NSA_QPOS(nq_) (t0 + 8 * w + 4 * (nq_) + (lr >> 2))
    bf16x8 qf[2][2]; float gtv[2][3];
#pragma unroll
    for (int nq = 0; nq < 2; ++nq) { const size_t row = (size_t)b * SEQ + NSA_QPOS(nq);
#pragma unroll
        for (int ks = 0; ks < 2; ++ks) qf[nq][ks] = *(const bf16x8*)(Qb + row * 1024 + head * 64 + 32 * ks + 8 * lq);
#pragma unroll
        for (int i = 0; i < 3; ++i) gtv[nq][i] = GT[row * 48 + head * 3 + i]; }
    const int ncv = ((t0 + 63 - 31) >> 4) + 1, ncmp = (ncv + 63) >> 6;
    const int lo = cur >= 8 ? cur - 8 : 0;
    const int n1 = ncmp, n2 = 2 * ncmp, n3 = n2 + cur + 1, n4 = n3 + (cur - lo + 1);
    const int srow = 8 * w + (lane >> 3), schv = (lane & 7) ^ ((srow >> 1) & 7), schk = (lane & 7) ^ (((srow & 3) >> 1) | (((srow >> 3) & 3) << 1));
    const bf16* kcb = KC + ((size_t)(b * 256) * 4 + g) * 64; const bf16* vcb = VCT + (size_t)((b * 4 + g) * 64) * 256;
    const bf16* ksb = KV6 + (size_t)b * SEQ * 1536 + 2 * 256 + g * 64; const bf16* kwb = ksb + 2 * 256;
    const bf16* vsb = VTS + (size_t)((b * 4 + g) * 64) * SEQ; const bf16* vwb = VTW + (size_t)((b * 4 + g) * 64) * SEQ;
    const unsigned sk16 = (unsigned)schk * 16u, sv16 = (unsigned)schv * 16u, srw = (unsigned)srow;
    const unsigned lds0 = (unsigned)(unsigned long)lds + (unsigned)w * 1024u;
#define NSA_GATE(nq_, i_) (gtv[nq_][i_])
#define NSA_GLDS(gp_, vo_, la_) do { unsigned keep_; asm volatile("s_mov_b32 %0, m0\n\ts_mov_b32 m0, %3\n\ts_nop 0\n\tglobal_load_lds_dwordx4 %1, %2\n\ts_mov_b32 m0, %0" : "=&s"(keep_) : "v"(vo_), "s"(gp_), "s"(la_) : "memory"); } while (0)
#define NSA_ISSUE(s_, slot_) do { const int s__ = (s_); const bf16* kp_; const bf16* vp_; unsigned ko_, vo_; \
        if (s__ < n2) { const int kt_ = s__ < n1 ? s__ : s__ - n1; kp_ = kcb + (size_t)(64 * kt_) * 256; vp_ = vcb + 64 * kt_; ko_ = srw * 512u + sk16; vo_ = srw * 512u + sv16; } \
        else if (s__ < n3) { const int kt_ = s__ - n2; kp_ = ksb + (size_t)(64 * kt_) * 1536; vp_ = vsb + 64 * kt_; ko_ = srw * 3072u + sk16; vo_ = srw * 8192u + sv16; } \
        else { const int kt_ = lo + s__ - n3; kp_ = kwb + (size_t)(64 * kt_) * 1536; vp_ = vwb + 64 * kt_; ko_ = srw * 3072u + sk16; vo_ = srw * 8192u + sv16; } \
        const unsigned la_ = (unsigned)__builtin_amdgcn_readfirstlane(lds0 + (unsigned)(slot_) * 16384u); NSA_GLDS(kp_, ko_, la_); NSA_GLDS(vp_, vo_, la_ + 8192u); } while (0)
#define NSA_WAITBAR(N) asm volatile("s_waitcnt vmcnt(" #N ") lgkmcnt(0)\n\ts_barrier" ::: "memory")
    asm volatile("s_waitcnt vmcnt(0)" ::: "memory");
    __syncthreads();
#pragma unroll
    for (int i = 0; i < 8; ++i) *(LAS f32x4*)(PS + (i * 64 + lane) * 4) = (f32x4){0.f, 0.f, 0.f, 0.f};
    NSA_ISSUE(0, 0); if (n1 >= 2) NSA_ISSUE(1, 1);
    NsaSt S;
    LAS f32x4* OUTL = (LAS f32x4*)PS + lane;
#pragma unroll
    for (int nq = 0; nq < 2; ++nq) { S.mhat[nq] = 0.f; S.l[nq] = 0.f; S.invl[nq] = 0.f;
#pragma unroll
        for (int ct = 0; ct < 4; ++ct) S.O[ct][nq] = (f32x4){0.f, 0.f, 0.f, 0.f}; }
    unsigned long long mym[2] = {0ull, 0ull};
#pragma unroll
    for (int nq = 0; nq < 2; ++nq)
#pragma unroll
        for (int ks = 0; ks < 2; ++ks) asm volatile("" : "+v"(qf[nq][ks]));
#pragma unroll
    for (int nq = 0; nq < 2; ++nq)
#pragma unroll
        for (int i = 0; i < 3; ++i) asm volatile("" : "+v"(gtv[nq][i]));
    NSA_WAITBAR(0);
    const int xk = ((lr & 3) >> 1) | ((lr >> 2) << 1), xv = (lr >> 1) & 7;
    const int koff = (8 * (lr >> 2) + (lr & 3)) * 128 + ((lq ^ xk) << 4);
    const int voff = lr * 128 + ((lq ^ xv) << 4);
    const int wi0 = n3 + (cur >= 8 ? 1 : 0);
#define NSA_GSZ(t_) (((t_) >= n4) ? 0 : ((t_) < n1) ? (((t_) + 1 < n1) ? 2 : 1) : ((t_) < n2) ? (((t_) + 1 < n2) ? 2 : 1) : (((t_) < n3 - 1) ? (((t_) + 1 < n3 - 1) ? 2 : 1) : (((t_) >= wi0 && (t_) < n4 - 1) ? (((t_) + 1 < n4 - 1) ? 2 : 1) : 1)))
#define NSA_TILE(MODE_, s_, slot_, kt_, PSrow_) do { const int s__s = (s_), kt__ = (kt_); const LAS unsigned char* kbuf = lds + (slot_) * 16384; const int kb = 64 * kt__ + 8 * lq; \
        int klo0, klo1, khi0, khi1; bool col0 = true, col1 = true; { const int qp0 = NSA_QPOS(0), qp1 = NSA_QPOS(1); \
            if (MODE_ < 2) { klo0 = 0; klo1 = 0; khi0 = (qp0 >= 31) ? ((qp0 - 31) >> 4) : -1; khi1 = (qp1 >= 31) ? ((qp1 - 31) >> 4) : -1; } \
            else if (s__s < n3) { col0 = (mym[0] >> kt__) & 1ull; col1 = (mym[1] >> kt__) & 1ull; klo0 = 0; klo1 = 0; khi0 = qp0; khi1 = qp1; } \
            else { klo0 = qp0 - 511; klo1 = qp1 - 511; khi0 = qp0; khi1 = qp1; } } \
        nsa_full<MODE_>(S, qf, kbuf, koff, voff, klo0, klo1, khi0, khi1, col0, col1, kb, (PSrow_), lr, lq); } while (0)
#define NSA_NEXT(t_, z_) do { const int nt_ = (t_) + (z_), z2_ = NSA_GSZ(nt_); if (z2_ >= 1) NSA_ISSUE(nt_, 2 * (gp ^ 1)); if (z2_ >= 2) NSA_ISSUE(nt_ + 1, 2 * (gp ^ 1) + 1); } while (0)
#define NSA_STEP(MODE_, s_, kt_, PSrow_) do { NSA_NEXT((s_), 1); NSA_TILE(MODE_, (s_), 2 * gp, (kt_), (PSrow_)); NSA_WAITBAR(0); gp ^= 1; } while (0)
#define NSA_PAIR(MODE_, s_, kt_) do { NSA_NEXT((s_), 2); NSA_TILE(MODE_, (s_), 2 * gp, (kt_), PS + 64 * (kt_)); NSA_TILE(MODE_, (s_) + 1, 2 * gp + 1, (kt_) + 1, PS + 64 * ((kt_) + 1)); NSA_WAITBAR(0); gp ^= 1; } while (0)
    int gp = 0;
    {   int s = 0; for (; s + 1 < n1; s += 2) NSA_PAIR(0, s, s);
        if (s < n1) NSA_STEP(0, s, s, PS); }
#pragma unroll
    for (int nq = 0; nq < 2; ++nq) { const float lf = colsum4(S.l[nq]); S.invl[nq] = lf > 0.f ? 1.f / lf : 0.f; }
    {   int s = n1; for (; s + 1 < n2; s += 2) NSA_PAIR(1, s, s - n1);
        if (s < n2) NSA_STEP(1, s, s - n1, PS + 64 * (s - n1)); }
    {
        unsigned uk[8], pref[8];
#pragma unroll
        for (int qi = 0; qi < 8; ++qi) { const int j = lane, qp = t0 + 8 * w + qi; const LAS float* base = PS + qi * 256;
            float imp = base[4 * j] + base[4 * j + 1] + base[4 * j + 2] + 0.5f * base[4 * j + 3]; if (j > 0) imp += 0.5f * base[4 * j - 1];
            const bool forced = (j == 0) || (j == cur) || (j == cur - 1), causal = (64 * j <= qp);
            const float val = forced ? BIGF : (causal ? imp : NEGF);
            const unsigned ub = __float_as_uint(val); uk[qi] = (ub & 0x80000000u) ? ~ub : (ub | 0x80000000u); pref[qi] = 0u; }
#pragma unroll 1
        for (int bit = 31; bit >= 0; --bit) {
#pragma unroll
            for (int qi = 0; qi < 8; ++qi) { const unsigned cand = pref[qi] | (1u << bit); if (__popcll(__ballot(uk[qi] >= cand)) >= 16) pref[qi] = cand; } }
#pragma unroll
        for (int qi = 0; qi < 8; ++qi) { const int j = lane;
            const unsigned long long gt = __ballot(uk[qi] > pref[qi]), eq = __ballot(uk[qi] == pref[qi]); const int need = 16 - __popcll(gt);
            const unsigned long long below = eq & ((1ull << j) - 1ull);
            const unsigned long long mk = gt | __ballot(uk[qi] == pref[qi] && __popcll(below) < need);
            if (qi == (lr >> 2)) mym[0] = mk; if (qi == 4 + (lr >> 2)) mym[1] = mk; }
#pragma unroll
        for (int nq = 0; nq < 2; ++nq) { S.mhat[nq] = 0.f; S.l[nq] = 0.f; const float g0 = NSA_GATE(nq, 0);
#pragma unroll
            for (int ct = 0; ct < 4; ++ct) { OUTL[(ct * 2 + nq) * 64] = S.O[ct][nq] * g0; S.O[ct][nq] = (f32x4){0.f, 0.f, 0.f, 0.f}; } }
    }
    {   int s = n2; for (; s + 1 < n3 - 1; s += 2) NSA_PAIR(3, s, s - n2);
        if (s < n3 - 1) NSA_STEP(3, s, s - n2, PS); }
    NSA_STEP(2, n3 - 1, cur, PS);
#pragma unroll
    for (int nq = 0; nq < 2; ++nq) { const float lf = colsum4(S.l[nq]); const float sc = NSA_GATE(nq, 1) / lf; S.mhat[nq] = 0.f; S.l[nq] = 0.f;
#pragma unroll
        for (int ct = 0; ct < 4; ++ct) { OUTL[(ct * 2 + nq) * 64] += S.O[ct][nq] * sc; S.O[ct][nq] = (f32x4){0.f, 0.f, 0.f, 0.f}; } }
    {   int s = n3; if (cur >= 8) { NSA_STEP(2, s, lo, PS); ++s; }
        for (; s + 1 < n4 - 1; s += 2) NSA_PAIR(3, s, lo + s - n3);
        if (s < n4 - 1) NSA_STEP(3, s, lo + s - n3, PS);
        NSA_STEP(2, n4 - 1, cur, PS); }
#undef NSA_STEP
#undef NSA_PAIR
#undef NSA_NEXT
#undef NSA_TILE
#undef NSA_GSZ
#undef NSA_ISSUE
#undef NSA_GLDS
#undef NSA_WAITBAR
#pragma unroll
    for (int nq = 0; nq < 2; ++nq) { const float lf = colsum4(S.l[nq]); const float sc = NSA_GATE(nq, 2) / lf; bf16* op = ATT + ((size_t)b * SEQ + NSA_QPOS(nq)) * 1024 + head * 64 + 4 * lq;
#pragma unroll
        for (int ct = 0; ct < 4; ++ct) { const f32x4 o = OUTL[(ct * 2 + nq) * 64] + S.O[ct][nq] * sc; v2u pk; pk.x = pk2(o[0], o[1]); pk.y = pk2(o[2], o[3]); *(v2u*)(op + 16 * ct) = pk; } }
#undef NSA_GATE
#undef NSA_QPOS
}
#define XB_TMO      128
#define XB_XCNT(j)  (256  + 64 * (j))
#define XB_XSUB(j)  (1280 + 64 * (j))
#define XB_XGEN(j)  (2304 + 64 * (j))
#define XB_TOP      3328
#define XB_TOPGEN   3392
#define XCD_BAR_WORDS 3456
#define XB_SPIN_CAP (1u << 18)

__device__ __forceinline__ unsigned xb_ld(unsigned* p)              { return __hip_atomic_load(p, __ATOMIC_RELAXED, __HIP_MEMORY_SCOPE_AGENT); }
__device__ __forceinline__ unsigned xb_add(unsigned* p, unsigned v) { return __hip_atomic_fetch_add(p, v, __ATOMIC_RELAXED, __HIP_MEMORY_SCOPE_AGENT); }
__device__ __forceinline__ unsigned xb_xcc_id() { return (unsigned)__builtin_amdgcn_s_getreg((3 << 11) | 20) & 0xFu; }
#define XB_SPIN(cond, bar) do { unsigned _sp = 0; while (cond) { __builtin_amdgcn_s_sleep(1); \
    if ((++_sp & 255u) == 0u) { if (xb_ld(&(bar)[XB_TMO])) break; if (_sp > XB_SPIN_CAP) { atomicAdd(&(bar)[XB_TMO], 1u); break; } } } } while (0)

struct XcdBarrier {
    unsigned* bar; unsigned x;
    volatile LAS unsigned* st;
};

__device__ __forceinline__ XcdBarrier xcd_barrier_post(unsigned* bar, volatile LAS unsigned* st) {
    XcdBarrier b; b.bar = bar; b.x = xb_xcc_id(); b.st = st;
    if (threadIdx.x == 0) (void)xb_add(&bar[XB_XCNT(b.x)], 1u);
    return b;
}
__device__ __forceinline__ void xcd_barrier_complete(unsigned* bar, unsigned x, unsigned& nloc, unsigned& nx) {
    const unsigned G = gridDim.x * gridDim.y * gridDim.z;
    unsigned sum, cnt, mine, sp = 0u;
    for (;;) {
        sum = 0u; cnt = 0u; mine = 0u;
#pragma unroll
        for (unsigned j = 0; j < 16; ++j) { const unsigned c = xb_ld(&bar[XB_XCNT(j)]); sum += c; cnt += (c > 0u) ? 1u : 0u; mine = (j == x) ? c : mine; }
        if (sum == G) break;
        __builtin_amdgcn_s_sleep(1);
        if ((++sp & 255u) == 0u) { if (xb_ld(&bar[XB_TMO])) break; if (sp > XB_SPIN_CAP) { atomicAdd(&bar[XB_TMO], 1u); break; } }
    }
    nloc = mine > 0u ? mine : 1u; nx = cnt > 0u ? cnt : 1u;
}

__device__ __forceinline__ void xcd_barrier(const XcdBarrier& b) {
    asm volatile("s_waitcnt vmcnt(0)" ::: "memory");
    __syncthreads();
    if (threadIdx.x == 0) {
        unsigned* bar = b.bar;
        __builtin_amdgcn_s_waitcnt(0);
        unsigned nloc = b.st[0], nx = b.st[1];
        if (nloc == 0u) { xcd_barrier_complete(bar, b.x, nloc, nx); b.st[0] = nloc; b.st[1] = nx; }
        const unsigned old = xb_add(&bar[XB_XSUB(b.x)], 1u);
        const unsigned gen = old / nloc;
        if (old + 1u == (gen + 1u) * nloc) {
            __builtin_amdgcn_fence(__ATOMIC_RELEASE, "agent");
            asm volatile("s_waitcnt vmcnt(0)" ::: "memory");
            const unsigned og = xb_add(&bar[XB_TOP], 1u);
            const unsigned tg = og / nx;
            if (og + 1u == (tg + 1u) * nx) xb_add(&bar[XB_TOPGEN], 1u);
            else XB_SPIN(xb_ld(&bar[XB_TOPGEN]) == tg, bar);
            __builtin_amdgcn_fence(__ATOMIC_ACQUIRE, "agent");
            xb_add(&bar[XB_XGEN(b.x)], 1u);
            asm volatile("s_waitcnt vmcnt(0)" ::: "memory");
        } else {
            XB_SPIN(xb_ld(&bar[XB_XGEN(b.x)]) == gen, bar);
            __builtin_amdgcn_fence(__ATOMIC_ACQUIRE, "agent");
            asm volatile("s_waitcnt vmcnt(0)" ::: "memory");
        }
    }
    __syncthreads();
}
constexpr int LDS_BYTES = 147456;
constexpr int NPHASES = 14;
#ifndef PHMASK
#define PHMASK 0x3fff
#endif
#ifndef PHREP
#define PHREP 0
#endif
#ifndef RES_ALIGN
#define RES_ALIGN true
#endif
#ifndef MK_SINGLE
#define MK_SINGLE 1
#endif

constexpr int RS_OFF = 131072 + 256;
__device__ __forceinline__ void rs_table(LAS unsigned char* lds, const float* SS, int N) {
    pg8::StaticOrder S; S.init(MROWS, N, (int)gridDim.x, (int)blockIdx.x); LAS float* RS = (LAS float*)(lds + RS_OFF); pg8::Unit u;
    for (int idx = threadIdx.x; ; idx += NTHREADS) { const int ui = idx >> 8; if (ui >= 11 || !S.next(ui, u)) break; RS[idx] = pg8::row_rs_g(SS, u.pm * 256 + (idx & 255)); }
    __syncthreads();
}
template <class Epi, bool ALIGN = true> __device__ __forceinline__ void run_gemm(LAS unsigned char* lds, const bf16* Aop, const bf16* Bt, int N, int K, const Epi& E) {
    pg8::Gemm g{Aop, Bt, MROWS, N, K}; pg8::StaticOrder S; S.init(MROWS, N, (int)gridDim.x, (int)blockIdx.x);
    pg8::gemm_phase<Epi, pg8::StaticOrder, ALIGN, true>(lds, g, S, E);
}

__global__ void __launch_bounds__(NTHREADS, 2) mk_fwd(Args args) {
    extern __shared__ __attribute__((aligned(16))) unsigned char lds_raw[];
    LAS unsigned char* lds = (LAS unsigned char*)lds_raw;
    cg::grid_group grid = cg::this_grid();
    volatile LAS unsigned* MISC = (volatile LAS unsigned*)(lds + 131072);
    if (threadIdx.x < 32) MISC[threadIdx.x] = 0u;
    __syncthreads();
    XcdBarrier xbar = xcd_barrier_post((unsigned*)(args.ws + WS_CTL) + 4096, MISC + 8);
    const int tid = threadIdx.x, lane = tid & 63, wave = __builtin_amdgcn_readfirstlane(tid >> 6);
    const int gw = blockIdx.x * NWAVES + wave, NGW = gridDim.x * NWAVES;
    unsigned char* ws = args.ws;
    const int lo = args.ph_lo, hi = args.ph_hi;
#define PH_BEGIN(k) if (lo <= (k) && (k) < hi) { if ((k) > lo) { if ((k) == lo + 1) grid.sync(); else xcd_barrier(xbar); } for (int rep_ = 0; rep_ < ((((PHREP) >> (k)) & 1) ? 2 : 1); ++rep_) { __syncthreads(); if constexpr ((PHMASK >> (k)) & 1) {
#define PH_END }}}
    float* const SS = (float*)(ws + WS_SS); constexpr size_t SSN = (size_t)MROWS * 16;
    bf16* const XN = (bf16*)(ws + WS_XN);
    PH_BEGIN(0) p0_prologue(args, lds, wave, lane); PH_END
    const LAS float* RSL = (const LAS float*)(lds + RS_OFF);
    PH_BEGIN(1) { rs_table(lds, SS, AB_IN); pg8::EpiProj0 E{(bf16*)(ws + WS_PROJ0), (const float*)(ws + TAB_RCOS), (const float*)(ws + TAB_RSIN), RSL};
                  run_gemm(lds, XN, (const bf16*)(ws + W_ABIN), AB_IN, 1024, E); } PH_END
    PH_BEGIN(2) { for (int it = blockIdx.x; it < 1024; it += gridDim.x) lru_item(args, lds, it, 0); ret_kv_run(args, lds, (int)blockIdx.x, (int)gridDim.x, 2048); } PH_END
    PH_BEGIN(3) {
                  for (int it = blockIdx.x; it < 1024; it += gridDim.x) lru_item(args, lds, it, 1);
                  const int per = (2048 + (int)gridDim.x - 1) / (int)gridDim.x, i0 = (int)blockIdx.x * per;
                  const int i1 = (i0 + per < 2048) ? i0 + per : 2048;
                  if (i0 < i1) { RetPre R; ret_out_pre(args, i0, true, R);
                      for (int it = i0; it < i1; ++it) { const int nx = (it + 1 < i1) ? it + 1 : -1; ret_out_item(args, lds, it, it == i0 || (it & 31) == 0, R, nx, nx >= 0 && (nx & 31) == 0); } } } PH_END
    PH_BEGIN(4) { pg8::EpiResid E{args.in[I_X], args.out, XN, SS + SSN}; run_gemm<pg8::EpiResid, RES_ALIGN>(lds, (const bf16*)(ws + WS_CAT), (const bf16*)(ws + W_ABOUT), 1024, 1024, E); } PH_END
    PH_BEGIN(5) { rs_table(lds, SS + SSN, 2 * FFH); pg8::EpiFfnUp E{(bf16*)(ws + WS_ACT), FFH, RSL}; run_gemm(lds, XN, (const bf16*)(ws + W_F13), 2 * FFH, 1024, E); } PH_END
    PH_BEGIN(6) { pg8::EpiResid E{args.out, args.out, XN, SS + 2 * SSN}; run_gemm<pg8::EpiResid, RES_ALIGN>(lds, (const bf16*)(ws + WS_ACT), (const bf16*)(ws + W_F2), 1024, FFH, E); } PH_END
    PH_BEGIN(7) { rs_table(lds, SS + 2 * SSN, NSA_INP); pg8::EpiNsaIn E{(bf16*)(ws + WS_Q), (bf16*)(ws + WS_KV6), (float*)(ws + WS_GATES), (bf16*)(ws + WS_VTS), (bf16*)(ws + WS_VTW), (const float*)(ws + TAB_NCOS), (const float*)(ws + TAB_NSIN), RSL};
                  run_gemm(lds, XN, (const bf16*)(ws + W_NSAIN), NSA_INP, 1024, E); } PH_END
    PH_BEGIN(8) { cmp_bias_to_lds(args, lds); for (int it = blockIdx.x; it < 256; it += gridDim.x) cmp_item(args, lds, it); } PH_END
    PH_BEGIN(9) { if (gridDim.x == 256) {
                      const int grp = (int)blockIdx.x >> 5, bg = (int)blockIdx.x & 31;
                      for (int i = 0; i < 8; ++i) { const int qt = (i & 1) ? 8 * i + 7 - grp : 8 * i + grp; nsa_item2(args, lds, qt * 32 + bg); } }
                  else for (int it = blockIdx.x; it < 2048; it += gridDim.x) nsa_item2(args, lds, it); } PH_END
    PH_BEGIN(10) { pg8::EpiResid E{args.out, args.out, XN, SS + 3 * SSN}; run_gemm<pg8::EpiResid, RES_ALIGN>(lds, (const bf16*)(ws + WS_CAT), (const bf16*)(ws + W_NSAOUT), 1024, 1024, E); } PH_END
    PH_BEGIN(11) { rs_table(lds, SS + 3 * SSN, 2 * FFH); pg8::EpiFfnUp E{(bf16*)(ws + WS_ACT), FFH, RSL}; run_gemm(lds, XN, (const bf16*)(ws + W_F13) + (size_t)2 * FFH * 1024, 2 * FFH, 1024, E); } PH_END
    PH_BEGIN(12) { pg8::EpiResid E{args.out, args.out, nullptr, nullptr}; run_gemm<pg8::EpiResid, RES_ALIGN>(lds, (const bf16*)(ws + WS_ACT), (const bf16*)(ws + W_F2) + (size_t)1024 * FFH, 1024, FFH, E); } PH_END
    PH_BEGIN(13) final_norm_phase(args.out, args.in[I_FINAL_NORM], gw, NGW, lane); PH_END
}

extern "C" void kernel_launch(void* const* d_in, const int* in_sizes, int n_in, void* d_out, int out_size, void* d_ws, size_t ws_size, hipStream_t stream) {
    static int grid = 0;
    if (grid == 0) {
        if (n_in != 24 || out_size != MROWS * DM || ws_size < WS_END) { fprintf(stderr, "kernel_launch: unexpected shapes (n_in %d out %d ws %zu)\n", n_in, out_size, ws_size); grid = -1; return; }
        int dev = 0, cus = 0, per_cu = 0;
        if (hipGetDevice(&dev) != hipSuccess || hipDeviceGetAttribute(&cus, hipDeviceAttributeMultiprocessorCount, dev) != hipSuccess) { grid = -1; return; }
        if (hipFuncSetAttribute((const void*)mk_fwd, hipFuncAttributeMaxDynamicSharedMemorySize, LDS_BYTES) != hipSuccess) { fprintf(stderr, "kernel_launch: hipFuncSetAttribute failed\n"); grid = -1; return; }
        if (hipOccupancyMaxActiveBlocksPerMultiprocessor(&per_cu, (const void*)mk_fwd, NTHREADS, LDS_BYTES) != hipSuccess || per_cu < 1) { fprintf(stderr, "kernel_launch: occupancy query says %d\n", per_cu); per_cu = 1; }
        (void)hipGetLastError();
        grid = cus;
    }
    if (grid < 0) return;
    if (hipMemsetAsync((char*)d_ws + WS_CTL, 0, 65536, stream) != hipSuccess) { fprintf(stderr, "kernel_launch: memset failed\n"); return; }
    Args a{};
    for (int i = 0; i < 24; ++i) a.in[i] = (const float*)d_in[i];
    a.out = (float*)d_out; a.ws = (unsigned char*)d_ws;
#if MK_SINGLE
    a.ph_lo = 0; a.ph_hi = NPHASES;
    void* kargs[] = {&a};
    hipError_t e = hipLaunchCooperativeKernel((const void*)mk_fwd, dim3(grid), dim3(NTHREADS), kargs, LDS_BYTES, stream);
    if (e != hipSuccess) fprintf(stderr, "kernel_launch: cooperative launch failed: %s (grid %d)\n", hipGetErrorString(e), grid);
#else
    for (int ph = 0; ph < NPHASES; ++ph) { a.ph_lo = ph; a.ph_hi = ph + 1; hipLaunchKernelGGL(mk_fwd, dim3(grid), dim3(NTHREADS), LDS_BYTES, stream, a); }
#endif
}
```

```cpp
#define PLACE_P2 "6"
#define PLACE_G 0
#define PLACE_N 0
#ifndef PLACE_G
#define PLACE_G 0
#endif
#ifndef PLACE_N
#define PLACE_N 0
#endif
#ifndef PLACE_B
#define PLACE_B 0
#endif
#ifndef PLACE_M
#define PLACE_M 0
#endif
#if PLACE_M
#define PLACE_MMA asm volatile(".p2align 3")
#else
#define PLACE_MMA do { } while (0)
#endif
#ifndef PLACE_P2
#define PLACE_P2 "3"
#endif
#define PLACE_ASM(k_) do { if ((k_) == 0) asm volatile(".p2align " PLACE_P2); else asm volatile(".p2align " PLACE_P2 "\n\ts_nop 0"); } while (0)
#include <hip/hip_runtime.h>
#include <hip/hip_cooperative_groups.h>
#include <cstdio>
#include <cstdint>
namespace cg = cooperative_groups;
#ifdef PROBE_T
#ifndef PROBE_BLK
#define PROBE_BLK 0
#endif
#ifndef PROBE_TID
#define PROBE_TID 0
#endif
__device__ float g_pr[16 * 8];
__device__ unsigned long long g_ts[16], g_te[16], g_tm[4];
#endif
namespace pg8 {
#define PG8_LAS __attribute__((address_space(3)))
typedef unsigned short bf16_t;
typedef short bf16x8 __attribute__((ext_vector_type(8)));
typedef float f32x4 __attribute__((ext_vector_type(4)));
typedef unsigned u32x4 __attribute__((ext_vector_type(4)));
constexpr int BM = 256, BK = 64, HALF = 128, HTB = HALF * BK * 2  , STAGE_BYTES = 8 * HTB, NXCD = 8, WGM = 8;

__host__ __device__ __forceinline__ int lds_byte(int r, int c) { const int st = (r >> 4) * 2 + (c >> 5), rr = r & 15, cc = c & 31, ob = rr * 64 + cc * 2; return st * 1024 + (ob ^ (((ob >> 9) & 1) << 5)); }
__host__ __device__ __forceinline__ void stage_rc(int b, int& R, int& C) { const int st = b / 1024, sb = b % 1024, swz = sb ^ (((sb >> 9) & 1) << 5); R = (st >> 1) * 16 + swz / 64; C = (st & 1) * 32 + (swz % 64) / 2; }
__host__ __device__ __forceinline__ int perm32(int rho) { const int n = rho >> 4, i = rho & 15; return 8 * (i >> 2) + 4 * n + (i & 3); }

struct Unit { int pm, pn, ui; };
struct Gemm { const bf16_t* A; const bf16_t* Bt; int M, N, K; };

struct StaticOrder {
    int nM, nN, nwg, G, c;
    __host__ __device__ void init(int M, int N, int G_, int c_) { nM = M / BM; nN = N / BM; nwg = nM * nN; G = G_; c = c_; }
    __host__ __device__ bool next(int i, Unit& u) const {
        const long L = (long)i * G + c; if (L >= nwg) return false;
        int wgid = (int)L; { const int q = nwg / NXCD, r = nwg % NXCD, xcd = wgid % NXCD, off = wgid / NXCD; wgid = (xcd < r ? xcd * (q + 1) : r * (q + 1) + (xcd - r) * q) + off; }
        const int nig = WGM * nN, gid = wgid / nig, fm = gid * WGM, gsz = (nM - fm) < WGM ? (nM - fm) : WGM;
        u.pm = fm + ((wgid % nig) % gsz); u.pn = (wgid % nig) / gsz; u.ui = i; return true;
    }
    __device__ __forceinline__ void a_ready(const Unit&) const {}
    __device__ __forceinline__ void done(const Unit&) const {}
};

__device__ __forceinline__ unsigned cvt_pk_bf16(float lo, float hi) { unsigned r; asm volatile("v_cvt_pk_bf16_f32 %0, %1, %2" : "=v"(r) : "v"(lo), "v"(hi)); return r; }
typedef unsigned u32x2 __attribute__((ext_vector_type(2)));
__device__ __forceinline__ float sigmoid_f(float x) { return __builtin_amdgcn_rcpf(1.f + __builtin_amdgcn_exp2f(-1.4426950408889634f * x)); }
__device__ __forceinline__ float silu_f(float x) { return x * __builtin_amdgcn_rcpf(1.f + __builtin_amdgcn_exp2f(-1.4426950408889634f * x)); }
__device__ __forceinline__ u32x4 pack8(const f32x4 a, const f32x4 b) { u32x4 w; w.x = cvt_pk_bf16(a[0], a[1]); w.y = cvt_pk_bf16(a[2], a[3]); w.z = cvt_pk_bf16(b[0], b[1]); w.w = cvt_pk_bf16(b[2], b[3]); return w; }
__device__ __forceinline__ u32x2 pack4(const f32x4 a) { u32x2 w; w.x = cvt_pk_bf16(a[0], a[1]); w.y = cvt_pk_bf16(a[2], a[3]); return w; }

__device__ __forceinline__ float row_rs_g(const float* SS, int row) { const f32x4* p = (const f32x4*)(SS + (size_t)row * 16); const f32x4 a = p[0], b = p[1], c = p[2], d = p[3];
    const float t = ((a[0] + a[1]) + (a[2] + a[3])) + ((b[0] + b[1]) + (b[2] + b[3])) + ((c[0] + c[1]) + (c[2] + c[3])) + ((d[0] + d[1]) + (d[2] + d[3])); return 1.f / sqrtf(t * (1.f / 1024.f) + 1e-6f); }
struct EpiProj0 {
    static constexpr bool PERM = true, AFTER_DRAIN = false;
    bf16_t* P; const float* cosT; const float* sinT; const PG8_LAS float* RS;
    __device__ __forceinline__ void operator()(const f32x4 (&acc)[2][2][4][2], const Unit& u, int wr, int wc, int fr, int fq) const {
        const int row0 = u.pm * BM + wr * 64 + fr, colt = u.pn * BM + wc * 32 + 8 * fq;
        const bool rot = (u.pn >= 4 && u.pn < 8); const float sc = (u.pn >= 6 && u.pn < 8) ? 0.125f : 1.f;
#pragma unroll
        for (int ai = 0; ai < 2; ++ai)
#pragma unroll
            for (int m = 0; m < 4; ++m) { const int row = row0 + ai * HALF + m * 16, pos = row & 4095; bf16_t* rowp = P + (size_t)row * 3072; const float rs = RS[u.ui * 256 + (row & 255)];
#pragma unroll
                for (int bj = 0; bj < 2; ++bj) { const int col = colt + bj * HALF; const f32x4 v0 = acc[ai][bj][m][0] * rs, v1 = acc[ai][bj][m][1] * rs;
                    if (rot) { const int hc = col & 63, gi = hc >> 3, hb = col - hc;
                        const f32x4 c = *(const f32x4*)(cosT + pos * 32 + 4 * gi), s = *(const f32x4*)(sinT + pos * 32 + 4 * gi);
                        const f32x4 o1 = (v0 * c - v1 * s) * sc, o2 = (v1 * c + v0 * s) * sc;
                        *(u32x2*)(rowp + hb + 4 * gi) = pack4(o1); *(u32x2*)(rowp + hb + 32 + 4 * gi) = pack4(o2);
                    } else { *(u32x4*)(rowp + col) = pack8(v0, v1); } } }
    }
};
struct EpiNsaIn {
    static constexpr bool PERM = true, AFTER_DRAIN = false;
    bf16_t* Q; bf16_t* KV; float* G; bf16_t* VTS; bf16_t* VTW; const float* cosT; const float* sinT; const PG8_LAS float* RS;
    __device__ __forceinline__ void operator()(const f32x4 (&acc)[2][2][4][2], const Unit& u, int wr, int wc, int fr, int fq) const {
        const int row0 = u.pm * BM + wr * 64 + fr, pn = u.pn;
#pragma unroll
        for (int ai = 0; ai < 2; ++ai)
#pragma unroll
            for (int m = 0; m < 4; ++m) { const int row = row0 + ai * HALF + m * 16, pos = row & 4095; const float rs = RS[u.ui * 256 + (row & 255)];
#pragma unroll
                for (int bj = 0; bj < 2; ++bj) { const int lc = bj * HALF + wc * 32 + 8 * fq; const f32x4 v0 = acc[ai][bj][m][0] * rs, v1 = acc[ai][bj][m][1] * rs;
                    if (pn < 10) {
                        bf16_t* dst; bool rot; float sc;
                        if (pn < 4) { dst = Q + (size_t)row * 1024 + pn * 256 + lc; rot = true; sc = 0.125f * 1.4426950408889634f; }
                        else { const int j = pn - 4;
                            if (j == 3 || j == 5) {
                                bf16_t* vt = (j == 3 ? VTS : VTW) + ((size_t)((row >> 12) * 4 + (lc >> 6)) * 64 + (lc & 63)) * 4096 + pos; const u32x4 w8 = pack8(v0, v1); const unsigned wv[4] = {w8.x, w8.y, w8.z, w8.w};
#pragma unroll
                                for (int i = 0; i < 4; ++i) { vt[(size_t)(2 * i) * 4096] = (bf16_t)(wv[i] & 0xffffu); vt[(size_t)(2 * i + 1) * 4096] = (bf16_t)(wv[i] >> 16); }
                                continue; }
                            dst = KV + (size_t)row * 1536 + j * 256 + lc; rot = (j == 2 || j == 4); sc = 1.f; }
                        const int hc = lc & 63;
                        if (rot && hc < 16) { const int gi = hc >> 3;
                            const f32x4 c = *(const f32x4*)(cosT + pos * 8 + 4 * gi), s = *(const f32x4*)(sinT + pos * 8 + 4 * gi);
                            const f32x4 o1 = (v0 * c - v1 * s) * sc, o2 = (v1 * c + v0 * s) * sc;
                            bf16_t* hbp = dst - hc; *(u32x2*)(hbp + 4 * gi) = pack4(o1); *(u32x2*)(hbp + 8 + 4 * gi) = pack4(o2);
                        } else { *(u32x4*)dst = pack8(v0 * sc, v1 * sc); }
                    } else if (lc < 48) {
                        float* gp = G + (size_t)row * 48 + lc; f32x4 a, b;
#pragma unroll
                        for (int i = 0; i < 4; ++i) { a[i] = sigmoid_f(v0[i]); b[i] = sigmoid_f(v1[i]); }
                        *(f32x4*)gp = a; *(f32x4*)(gp + 4) = b; } } }
    }
};
struct EpiFfnUp {
    static constexpr bool PERM = true, AFTER_DRAIN = false;
    bf16_t* ACT; int ld; const PG8_LAS float* RS;
    __device__ __forceinline__ void operator()(const f32x4 (&acc)[2][2][4][2], const Unit& u, int wr, int wc, int fr, int fq) const {
        const int row0 = u.pm * BM + wr * 64 + fr, col = u.pn * 128 + wc * 32 + 8 * fq;
#pragma unroll
        for (int ai = 0; ai < 2; ++ai)
#pragma unroll
            for (int m = 0; m < 4; ++m) { const int row = row0 + ai * HALF + m * 16; f32x4 h0, h1; const float rs = RS[u.ui * 256 + (row & 255)];
#pragma unroll
                for (int i = 0; i < 4; ++i) { h0[i] = silu_f(acc[ai][0][m][0][i] * rs) * (acc[ai][1][m][0][i] * rs); h1[i] = silu_f(acc[ai][0][m][1][i] * rs) * (acc[ai][1][m][1][i] * rs); }
                *(u32x4*)(ACT + (size_t)row * ld + col) = pack8(h0, h1); }
    }
};
struct EpiResid {
    static constexpr bool PERM = true, AFTER_DRAIN = false;
    const float* base; float* out; bf16_t* HB; float* SS;
    __device__ __forceinline__ void operator()(const f32x4 (&acc)[2][2][4][2], const Unit& u, int wr, int wc, int fr, int fq) const {
        const int row0 = u.pm * BM + wr * 64 + fr, col0 = u.pn * BM + wc * 32 + 8 * fq;
#pragma unroll
        for (int ai = 0; ai < 2; ++ai) {
            f32x4 pre[4][2][2];
#pragma unroll
            for (int m = 0; m < 4; ++m) { const size_t off = (size_t)(row0 + ai * HALF + m * 16) * 1024 + col0;
#pragma unroll
                for (int bj = 0; bj < 2; ++bj) { pre[m][bj][0] = *(const f32x4*)(base + off + bj * HALF); pre[m][bj][1] = *(const f32x4*)(base + off + bj * HALF + 4); } }
            asm volatile("" ::: "memory");
#pragma unroll
            for (int m = 0; m < 4; ++m) { const int row = row0 + ai * HALF + m * 16; const size_t off = (size_t)row * 1024 + col0; float ssq = 0.f;
#pragma unroll
                for (int bj = 0; bj < 2; ++bj) { const size_t o = off + bj * HALF; const f32x4 v0 = pre[m][bj][0] + acc[ai][bj][m][0], v1 = pre[m][bj][1] + acc[ai][bj][m][1];
                    if (out) { *(f32x4*)(out + o) = v0; *(f32x4*)(out + o + 4) = v1; }
                    if (HB) { *(u32x4*)(HB + o) = pack8(v0, v1); ssq += ((v0[0] * v0[0] + v0[1] * v0[1]) + (v0[2] * v0[2] + v0[3] * v0[3])) + ((v1[0] * v1[0] + v1[1] * v1[1]) + (v1[2] * v1[2] + v1[3] * v1[3])); } }
                if (HB) { ssq += __shfl_xor(ssq, 16); ssq += __shfl_xor(ssq, 32); if (fq == 0) SS[(size_t)row * 16 + u.pn * 4 + wc] = ssq; } }
            asm volatile("" ::: "memory");
        }
    }
};
template <bool OUT_F32> struct EpiResidB {
    static constexpr bool PERM = true, AFTER_DRAIN = false;
    const bf16_t* base; float* out; bf16_t* HB; float* SS;
    __device__ __forceinline__ void operator()(const f32x4 (&acc)[2][2][4][2], const Unit& u, int wr, int wc, int fr, int fq) const {
        const int row0 = u.pm * BM + wr * 64 + fr, col0 = u.pn * BM + wc * 32 + 8 * fq;
        u32x4 pre[2][4][2];
#pragma unroll
        for (int ai = 0; ai < 2; ++ai)
#pragma unroll
            for (int m = 0; m < 4; ++m) { const size_t off = (size_t)(row0 + ai * HALF + m * 16) * 1024 + col0;
#pragma unroll
                for (int bj = 0; bj < 2; ++bj) pre[ai][m][bj] = *(const u32x4*)(base + off + bj * HALF); }
        asm volatile("" ::: "memory");
#pragma unroll
        for (int ai = 0; ai < 2; ++ai)
#pragma unroll
            for (int m = 0; m < 4; ++m) { const int row = row0 + ai * HALF + m * 16; const size_t off = (size_t)row * 1024 + col0; float ssq = 0.f;
#pragma unroll
                for (int bj = 0; bj < 2; ++bj) { const size_t o = off + bj * HALF; const u32x4 w = pre[ai][m][bj];
                    const f32x4 b0 = {__uint_as_float(w.x << 16), __uint_as_float(w.x & 0xffff0000u), __uint_as_float(w.y << 16), __uint_as_float(w.y & 0xffff0000u)};
                    const f32x4 b1 = {__uint_as_float(w.z << 16), __uint_as_float(w.z & 0xffff0000u), __uint_as_float(w.w << 16), __uint_as_float(w.w & 0xffff0000u)};
                    const f32x4 v0 = b0 + acc[ai][bj][m][0], v1 = b1 + acc[ai][bj][m][1];
                    if constexpr (OUT_F32) { *(f32x4*)(out + o) = v0; *(f32x4*)(out + o + 4) = v1; }
                    else { *(u32x4*)(HB + o) = pack8(v0, v1); ssq += ((v0[0] * v0[0] + v0[1] * v0[1]) + (v0[2] * v0[2] + v0[3] * v0[3])) + ((v1[0] * v1[0] + v1[1] * v1[1]) + (v1[2] * v1[2] + v1[3] * v1[3])); } }
                if constexpr (!OUT_F32) { ssq += __shfl_xor(ssq, 16); ssq += __shfl_xor(ssq, 32); if (fq == 0) SS[(size_t)row * 16 + u.pn * 4 + wc] = ssq; } }
        asm volatile("" ::: "memory");
    }
};
template <class Epi, class Sched, bool ALIGN_EPI = false, bool SP2 = false>
__device__ __forceinline__ void gemm_phase(PG8_LAS unsigned char* lds, const Gemm g, const Sched& S, const Epi& E) {
    const int tid = threadIdx.x, wid = __builtin_amdgcn_readfirstlane(tid >> 6), lane = tid & 63, wr = wid >> 2, wc = wid & 3, fr = lane & 15, fq = lane >> 4;
    const int K = g.K, nt = K / BK;
    unsigned voffA[2], voffB[2];
#pragma unroll
    for (int i = 0; i < 2; ++i) { int R, C; stage_rc(tid * 16 + i * 8192, R, C); const int Rb = Epi::PERM ? ((R & ~31) + perm32(R & 31)) : R;
        voffA[i] = (unsigned)(R * K + C) * 2u; voffB[i] = (unsigned)(Rb * K + C) * 2u; }
    const size_t kstep = (size_t)(BK * 2);
    const size_t hstep = (size_t)HALF * K * 2;
    const size_t tstep = 2 * hstep;
    const unsigned ldsw = (unsigned)wid * 1024u;
    const int aoff = lds_byte(wr * 64 + fr, fq * 8), boff = lds_byte(wc * 32 + fr, fq * 8);
#define PG8_SA(b, h) (((b) * 2 + (h)) * HTB)
#define PG8_SB(b, h) ((4 + (b) * 2 + (h)) * HTB)
#define PG8_STAGE(bufoff, gbase, voff) do { _Pragma("unroll") for (int _i = 0; _i < 2; ++_i) \
        __builtin_amdgcn_global_load_lds((const unsigned*)((const char*)(gbase) + (voff)[_i]), (PG8_LAS unsigned*)(lds + (bufoff) + ldsw + _i * 8192), 16, 0, 0); } while (0)
#define PG8_LDA(dst, b, h) do { _Pragma("unroll") for (int m = 0; m < 4; ++m) _Pragma("unroll") for (int k = 0; k < 2; ++k) dst[m][k] = *(const PG8_LAS bf16x8*)(lds + PG8_SA(b, h) + aoff + m * 2048 + k * 1024); } while (0)
#define PG8_LDB(dst, b, h) do { _Pragma("unroll") for (int n = 0; n < 2; ++n) _Pragma("unroll") for (int k = 0; k < 2; ++k) dst[n][k] = *(const PG8_LAS bf16x8*)(lds + PG8_SB(b, h) + boff + n * 2048 + k * 1024); } while (0)
#define PG8_MMA(ai, bj, At, Bt) do { __builtin_amdgcn_s_setprio(1); PLACE_MMA; _Pragma("unroll") for (int m = 0; m < 4; ++m) _Pragma("unroll") for (int n = 0; n < 2; ++n) _Pragma("unroll") for (int k = 0; k < 2; ++k) \
        acc[ai][bj][m][n] = __builtin_amdgcn_mfma_f32_16x16x32_bf16(Bt[n][k], At[m][k], acc[ai][bj][m][n], 0, 0, 0); __builtin_amdgcn_s_setprio(0); } while (0)
#define PG8_WAIT_V(n) asm volatile("s_waitcnt vmcnt(" #n ")" ::: "memory")
#define PG8_WAIT_L(n) asm volatile("s_waitcnt lgkmcnt(" #n ")" ::: "memory")
#if PLACE_B
#define PG8_BAR do { asm volatile(".p2align 3\n\ts_nop 0"); __builtin_amdgcn_s_barrier(); } while (0)
#else
#define PG8_BAR __builtin_amdgcn_s_barrier()
#endif
#define PG8_SCHED __builtin_amdgcn_sched_barrier(0)
#ifdef PROBE_G
#define PT_NOW(t) asm volatile("s_memrealtime %0\n\ts_waitcnt lgkmcnt(0)" : "=s"(t) :: "memory")
    unsigned long long pt_start, pt0, pt1, pt_e = 0, pt_k0 = 0, pt_k4 = 0, pt_end; PT_NOW(pt_start);
#endif
    Unit cur, nxt; int ui = 0;
    if (!S.next(0, cur)) return;
    f32x4 acc[2][2][4][2];
#pragma unroll
    for (int a = 0; a < 2; ++a)
#pragma unroll
        for (int b = 0; b < 2; ++b)
#pragma unroll
            for (int m = 0; m < 4; ++m)
#pragma unroll
                for (int n = 0; n < 2; ++n) acc[a][b][m][n] = (f32x4){0.f, 0.f, 0.f, 0.f};
    bf16x8 At[4][2], B0[2][2], B1[2][2];
    const char* cA = (const char*)g.A + (size_t)cur.pm * tstep; const char* cB = (const char*)g.Bt + (size_t)cur.pn * tstep;
    S.a_ready(cur);
    if constexpr (SP2) {
        PG8_STAGE(PG8_SB(0, 0), cB, voffB); PG8_STAGE(PG8_SB(0, 1), cB + hstep, voffB); PG8_STAGE(PG8_SA(0, 0), cA, voffA); PG8_STAGE(PG8_SA(0, 1), cA + hstep, voffA);
        if (wr == 1) PG8_BAR;
        PG8_WAIT_V(2); PG8_BAR;
        PG8_STAGE(PG8_SB(1, 0), cB + kstep, voffB); PG8_STAGE(PG8_SA(1, 0), cA + kstep, voffA); PG8_STAGE(PG8_SB(1, 1), cB + hstep + kstep, voffB);
        PG8_WAIT_V(6); PG8_BAR;
    } else {
        PG8_STAGE(PG8_SB(0, 0), cB, voffB); PG8_STAGE(PG8_SA(0, 0), cA, voffA); PG8_STAGE(PG8_SB(0, 1), cB + hstep, voffB); PG8_STAGE(PG8_SA(0, 1), cA + hstep, voffA);
        if (wr == 1) PG8_BAR;
        PG8_WAIT_V(4); PG8_BAR;
        PG8_STAGE(PG8_SB(1, 0), cB + kstep, voffB); PG8_STAGE(PG8_SA(1, 0), cA + kstep, voffA); PG8_STAGE(PG8_SB(1, 1), cB + hstep + kstep, voffB);
        PG8_WAIT_V(6); PG8_BAR;
    }
    for (;;) {
        const bool has_next = S.next(ui + 1, nxt);
        const char* nA = has_next ? (const char*)g.A + (size_t)nxt.pm * tstep : cA; const char* nB = has_next ? (const char*)g.Bt + (size_t)nxt.pn * tstep : cB;
        for (int t = 0; t < nt; t += 2) {
            PLACE_ASM(PLACE_G);
            const bool last = (t == nt - 2);
#ifdef PROBE_G
            PT_NOW(pt0);
#endif
            const char* a1 = cA + (size_t)(t + 1) * kstep;
            const char* a2 = last ? nA : cA + (size_t)(t + 2) * kstep; const char* b2 = last ? nB : cB + (size_t)(t + 2) * kstep;
            const char* a3 = a2 + kstep; const char* b3 = b2 + kstep;
            if (last && has_next) S.a_ready(nxt);
            if constexpr (SP2) {
            PG8_LDB(B0, 0, 0); PG8_LDB(B1, 0, 1); PG8_SCHED; PG8_LDA(At, 0, 0); PG8_STAGE(PG8_SA(1, 1), a1 + hstep, voffA);
            PG8_WAIT_V(8); PG8_WAIT_L(0); PG8_BAR; PG8_MMA(0, 0, At, B0); PG8_MMA(0, 1, At, B1); PG8_BAR; PG8_SCHED;
            PG8_LDA(At, 0, 1); PG8_STAGE(PG8_SB(0, 0), b2, voffB); PG8_STAGE(PG8_SB(0, 1), b2 + hstep, voffB); PG8_STAGE(PG8_SA(0, 0), a2, voffA);
            PG8_WAIT_V(8); PG8_WAIT_L(0); PG8_BAR; PG8_MMA(1, 0, At, B0); PG8_MMA(1, 1, At, B1); PG8_BAR; PG8_SCHED;
            PG8_LDB(B0, 1, 0); PG8_LDB(B1, 1, 1); PG8_SCHED; PG8_LDA(At, 1, 0); PG8_STAGE(PG8_SA(0, 1), a2 + hstep, voffA);
            PG8_WAIT_V(8); PG8_WAIT_L(0); PG8_BAR; PG8_MMA(0, 0, At, B0); PG8_MMA(0, 1, At, B1); PG8_BAR; PG8_SCHED;
            PG8_LDA(At, 1, 1); PG8_STAGE(PG8_SB(1, 0), b3, voffB); PG8_STAGE(PG8_SB(1, 1), b3 + hstep, voffB); PG8_STAGE(PG8_SA(1, 0), a3, voffA);
            PG8_WAIT_V(8); PG8_WAIT_L(0); PG8_BAR; PG8_MMA(1, 0, At, B0); PG8_MMA(1, 1, At, B1); PG8_BAR; PG8_SCHED;
            } else {
            PG8_LDB(B0, 0, 0); PG8_SCHED; PG8_LDA(At, 0, 0); PG8_STAGE(PG8_SA(1, 1), a1 + hstep, voffA);
            PG8_WAIT_L(8); PG8_BAR; PG8_WAIT_L(0); PG8_MMA(0, 0, At, B0); PG8_BAR; PG8_SCHED;
            PG8_LDB(B1, 0, 1); PG8_STAGE(PG8_SB(0, 0), b2, voffB);
            PG8_BAR; PG8_WAIT_L(0); PG8_MMA(0, 1, At, B1); PG8_BAR;
            PG8_LDA(At, 0, 1); PG8_STAGE(PG8_SA(0, 0), a2, voffA);
            PG8_BAR; PG8_WAIT_L(0); PG8_MMA(1, 0, At, B0); PG8_BAR; PG8_SCHED;
            PG8_STAGE(PG8_SB(0, 1), b2 + hstep, voffB);
            PG8_WAIT_V(6); PG8_BAR; PG8_MMA(1, 1, At, B1); PG8_BAR;
            PG8_LDB(B0, 1, 0); PG8_SCHED; PG8_LDA(At, 1, 0); PG8_STAGE(PG8_SA(0, 1), a2 + hstep, voffA);
            PG8_WAIT_L(8); PG8_BAR; PG8_WAIT_L(0); PG8_MMA(0, 0, At, B0); PG8_BAR; PG8_SCHED;
            PG8_LDB(B1, 1, 1); PG8_STAGE(PG8_SB(1, 0), b3, voffB);
            PG8_BAR; PG8_WAIT_L(0); PG8_MMA(0, 1, At, B1); PG8_BAR;
            PG8_LDA(At, 1, 1); PG8_STAGE(PG8_SA(1, 0), a3, voffA);
            PG8_BAR; PG8_WAIT_L(0); PG8_MMA(1, 0, At, B0); PG8_BAR; PG8_SCHED;
            PG8_STAGE(PG8_SB(1, 1), b3 + hstep, voffB);
            PG8_WAIT_V(6); PG8_BAR; PG8_MMA(1, 1, At, B1); PG8_BAR;
            }
#ifdef PROBE_G
            PT_NOW(pt1); if (t == 0 && ui > 0) pt_k0 += pt1 - pt0; if (t == 4) pt_k4 += pt1 - pt0;
#endif
        }
#ifdef PROBE_G
        PT_NOW(pt0);
#endif
        if constexpr (ALIGN_EPI) { if (wr == 0) PG8_BAR; }
        if constexpr (!Epi::AFTER_DRAIN) { E(acc, cur, wr, wc, fr, fq); S.done(cur); }
#ifdef PROBE_G
        PT_NOW(pt1); pt_e += pt1 - pt0;
#endif
        if (!has_next) break;
#pragma unroll
        for (int a = 0; a < 2; ++a)
#pragma unroll
            for (int b = 0; b < 2; ++b)
#pragma unroll
                for (int m = 0; m < 4; ++m)
#pragma unroll
                    for (int n = 0; n < 2; ++n) acc[a][b][m][n] = (f32x4){0.f, 0.f, 0.f, 0.f};
        cur = nxt; cA = nA; cB = nB; ++ui;
        if constexpr (ALIGN_EPI) { if (wr == 1) PG8_BAR; }
    }
    PG8_WAIT_V(0);
    if constexpr (!ALIGN_EPI) { if (wr == 0) PG8_BAR; }
    PG8_BAR;
    if constexpr (Epi::AFTER_DRAIN) { E.fused(acc, cur, wr, wc, fr, fq, lds, wid, lane); S.done(cur); }
#ifdef PROBE_G
    PT_NOW(pt_end);
    if (blockIdx.x == PROBE_BLK && tid == PROBE_TID) { const unsigned ph = *(volatile PG8_LAS unsigned*)(lds + 131072 + 64); float* q = g_pr + ph * 8;
        q[0] = (float)(pt_end - pt_start) * 0.01f; q[1] = (float)pt_e * 0.01f; q[2] = (float)pt_k0 * 0.01f; q[3] = (float)pt_k4 * 0.01f; q[4] = (float)(ui + 1); }
#undef PT_NOW
#endif
#undef PG8_SA
#undef PG8_SB
#undef PG8_STAGE
#undef PG8_LDA
#undef PG8_LDB
#undef PG8_MMA
#undef PG8_WAIT_V
#undef PG8_WAIT_L
#undef PG8_BAR
#undef PG8_SCHED
}
}
#define LAS __attribute__((address_space(3)))
typedef unsigned short bf16;
typedef unsigned v4u __attribute__((ext_vector_type(4)));
typedef unsigned v2u __attribute__((ext_vector_type(2)));
typedef float f32x4 __attribute__((ext_vector_type(4)));
typedef short bf16x8 __attribute__((ext_vector_type(8)));

constexpr int NWAVES = 8, NTHREADS = 512;
constexpr int BATCH = 8, SEQ = 4096, DM = 1024, MROWS = BATCH * SEQ;
constexpr int AB_IN = 3072, FFH = 2816, NSA_IN = 2608, NSA_INP = 2816;
constexpr float EPSF = 1e-6f, NEGF = -1e30f, BIGF = 1e30f, LOG2E = 1.4426950408889634f;

constexpr size_t MiB = 1u << 20;
constexpr size_t WS_CTL = 0;
constexpr size_t WS_TAB = 1 * MiB;
constexpr size_t TAB_RCOS = WS_TAB, TAB_RSIN = TAB_RCOS + 4096 * 32 * 4, TAB_NCOS = TAB_RSIN + 4096 * 32 * 4, TAB_NSIN = TAB_NCOS + 4096 * 8 * 4, TAB_CB = TAB_NSIN + 4096 * 8 * 4;
constexpr size_t WS_W = 4 * MiB;
constexpr size_t W_ABIN = WS_W, W_ABOUT = W_ABIN + 6 * MiB, W_NSAIN = W_ABOUT + 2 * MiB, W_NSAOUT = W_NSAIN + 6 * MiB, W_F13 = W_NSAOUT + 2 * MiB  , W_F2 = W_F13 + 22 * MiB  ,
                 W_CK1 = W_F2 + 11 * MiB  , W_CV1 = W_CK1 + 256 * 1024, W_CK2 = W_CV1 + 256 * 1024  , W_CV2 = W_CK2 + 8192, W_GATE = W_CV2 + 8192  , W_END = W_GATE + 131072;
static_assert(W_END <= 64 * MiB, "weights");
constexpr size_t WS_XN = 64 * MiB;
constexpr size_t WS_CAT = 128 * MiB;
constexpr size_t WS_BIG = 192 * MiB;
constexpr size_t WS_PROJ0 = WS_BIG, WS_ACT = WS_BIG;
constexpr size_t WS_Q = WS_BIG, WS_KV6 = WS_BIG + 64 * MiB, WS_GATES = WS_KV6 + 96 * MiB, WS_KC = WS_GATES + 6 * MiB, WS_VCT = WS_KC + 1 * MiB, WS_VTS = WS_VCT + 1 * MiB, WS_VTW = WS_VTS + 16 * MiB;
constexpr size_t WS_KVT = 384 * MiB;
constexpr size_t WS_LSUM = 416 * MiB;
constexpr size_t WS_SS = 418 * MiB;
constexpr size_t WS_END = 428 * MiB;
static_assert(WS_VTW + 16 * MiB <= WS_KVT + 32 * MiB && WS_LSUM + 2 * MiB <= WS_SS && WS_PROJ0 + (size_t)MROWS * AB_IN * 2 <= WS_KVT, "ws map");

__device__ __forceinline__ float bf2f(bf16 v) { return __uint_as_float((unsigned)v << 16); }
__device__ __forceinline__ unsigned f2bf(float f) { unsigned u = __float_as_uint(f); return (u + 0x7fffu + ((u >> 16) & 1u)) >> 16; }
__device__ __forceinline__ unsigned pk2(float lo, float hi) { return f2bf(lo) | (f2bf(hi) << 16); }

__device__ __forceinline__ float gelu_tanh(float x) { const float u = 0.7978845608028654f * (x + 0.044715f * x * x * x); const float e = __expf(2.f * u); const float th = 1.f - 2.f / (e + 1.f); return 0.5f * x * (1.f + th); }
__device__ __forceinline__ float sigm(float x) { return 1.f / (1.f + __expf(-x)); }
__device__ __forceinline__ f32x4 mfma16(bf16x8 a, bf16x8 b, f32x4 c) { return __builtin_amdgcn_mfma_f32_16x16x32_bf16(a, b, c, 0, 0, 0); }
#define DPPF(x_, ctrl_) __int_as_float(__builtin_amdgcn_update_dpp(0, __float_as_int(x_), (ctrl_), 0xF, 0xF, true))
__device__ __forceinline__ float qsum4(float v) { v += DPPF(v, 0xB1); v += DPPF(v, 0x4E); return v; }
__device__ __forceinline__ float gsum16(float v) { v += DPPF(v, 0x128); v += DPPF(v, 0x124); v += DPPF(v, 0x122); v += DPPF(v, 0x121); return v; }
__device__ __forceinline__ float rows4_sum(float v) {
    auto a = __builtin_amdgcn_permlane16_swap(__float_as_uint(v), __float_as_uint(v), false, false); v = __uint_as_float(a[0]) + __uint_as_float(a[1]);
    auto c = __builtin_amdgcn_permlane32_swap(__float_as_uint(v), __float_as_uint(v), false, false); return __uint_as_float(c[0]) + __uint_as_float(c[1]); }
__device__ __forceinline__ float wave_sum(float v) { return rows4_sum(gsum16(v)); }

struct Args { const float* in[24]; float* out; unsigned char* ws; int ph_lo, ph_hi; };
enum { I_X = 0, I_ATTN_NORM, I_AB_W_IN, I_CONV_W, I_CONV_B, I_GA_W, I_GA_B, I_GX_W, I_GX_B, I_LAM, I_AB_W_OUT, I_NSA_W_IN, I_PE_K, I_K_W1, I_K_W2, I_PE_V, I_V_W1, I_V_W2, I_NSA_W_OUT,
       I_FFN_NORM, I_FFN_W1, I_FFN_W3, I_FFN_W2, I_FINAL_NORM };

struct P0Desc { const float* colp; const float* gain; bf16* wt; int ld, K, k0, d0; };
__device__ __forceinline__ void p0_decode(const Args& A, unsigned char* ws, int it, int lane, P0Desc& D) {
    constexpr int I_ABIN = 16 * (AB_IN / 32), I_SQ = 16 * 32, I_NSAIN = 16 * (NSA_INP / 32), I_F13 = 16 * (FFH / 32), I_F2 = (FFH / 64) * 32, I_C1 = 32 * 2, I_C2 = 2;
    int r = it, mapk = 0, Ndst = 1024, half = 0; const float* W; D.gain = nullptr; D.K = 1024;
    if (r < I_ABIN) { W = A.in[I_AB_W_IN]; D.ld = AB_IN; Ndst = AB_IN; D.wt = (bf16*)(ws + W_ABIN); D.gain = A.in[I_ATTN_NORM]; mapk = 1; }
    else if ((r -= I_ABIN) < I_SQ) { W = A.in[I_AB_W_OUT]; D.ld = 1024; D.wt = (bf16*)(ws + W_ABOUT); }
    else if ((r -= I_SQ) < I_NSAIN) { W = A.in[I_NSA_W_IN]; D.ld = NSA_IN; Ndst = NSA_INP; D.wt = (bf16*)(ws + W_NSAIN); D.gain = A.in[I_ATTN_NORM] + DM; mapk = 2; }
    else if ((r -= I_NSAIN) < I_SQ) { W = A.in[I_NSA_W_OUT]; D.ld = 1024; D.wt = (bf16*)(ws + W_NSAOUT); }
    else if ((r -= I_SQ) < 4 * I_F13) { const int q = r / I_F13; r -= q * I_F13; const int L = q & 1; half = q >> 1;
        W = A.in[half ? I_FFN_W3 : I_FFN_W1] + (size_t)L * 1024 * FFH; D.ld = FFH; Ndst = FFH; D.wt = (bf16*)(ws + W_F13) + (size_t)L * 2 * FFH * 1024; D.gain = A.in[I_FFN_NORM] + L * DM; mapk = 3; }
    else if ((r -= 4 * I_F13) < 2 * I_F2) { const int L = r / I_F2; r -= L * I_F2; W = A.in[I_FFN_W2] + (size_t)L * FFH * 1024; D.ld = 1024; D.K = FFH; D.wt = (bf16*)(ws + W_F2) + (size_t)L * 1024 * FFH; }
    else if ((r -= 2 * I_F2) < 2 * I_C1) { const int v = r / I_C1; r -= v * I_C1; W = A.in[v ? I_V_W1 : I_K_W1]; D.ld = 64; Ndst = 64; D.K = 2048; D.wt = (bf16*)(ws + (v ? W_CV1 : W_CK1)); }
    else { r -= 2 * I_C1; const int v = r / I_C2; r -= v * I_C2; W = A.in[v ? I_V_W2 : I_K_W2]; D.ld = 64; Ndst = 64; D.K = 64; D.wt = (bf16*)(ws + (v ? W_CV2 : W_CK2)); }
    const int nblk = Ndst / 32, kb = r / nblk, nb = r % nblk, n0 = 32 * nb, c = n0 + (lane & 31); D.k0 = 64 * kb; D.d0 = n0; int sc = c;
    if (mapk == 1) { if (c >= 1024 && c < 2048) { const int hc = c & 63, gi = hc >> 3, e = hc & 7; sc = (c - hc) + (e < 4 ? 4 * gi + e : 32 + 4 * gi + (e - 4)); } }
    else if (mapk == 2) { if (c >= NSA_IN) sc = -1; else if (c < 1024 || (c >= 1536 && c < 1792) || (c >= 2048 && c < 2304)) { const int hc = c & 63; if (hc < 16) { const int gi = hc >> 3, e = hc & 7; sc = (c - hc) + (e < 4 ? 4 * gi + e : 8 + 4 * gi + (e - 4)); } } }
    else if (mapk == 3) D.d0 = 256 * (n0 >> 7) + (n0 & 127) + 128 * half;
    D.colp = (sc < 0) ? nullptr : W + sc;
}
__device__ __forceinline__ void p0_load(const P0Desc& D, float (&tv)[32], int lane) {
#pragma unroll
    for (int i = 0; i < 32; ++i) { const int kk = 2 * i + (lane >> 5); tv[i] = D.colp ? D.colp[(size_t)(D.k0 + kk) * D.ld] : 0.f; }
}
__device__ __forceinline__ void p0_store(const P0Desc& D, const float (&tv)[32], LAS float* scr, int lane) {
    if (D.gain) {
#pragma unroll
        for (int i = 0; i < 32; ++i) { const int kk = 2 * i + (lane >> 5); scr[kk * 33 + (lane & 31)] = tv[i] * D.gain[D.k0 + kk]; }
    } else {
#pragma unroll
        for (int i = 0; i < 32; ++i) { const int kk = 2 * i + (lane >> 5); scr[kk * 33 + (lane & 31)] = tv[i]; } }
    asm volatile("s_waitcnt lgkmcnt(0)" ::: "memory");
    const int c = lane & 7;
#pragma unroll
    for (int j = 0; j < 4; ++j) { const int n = (lane >> 3) + 8 * j; const LAS float* s = scr + (8 * c) * 33 + n;
        v4u o; o.x = pk2(s[0 * 33], s[1 * 33]); o.y = pk2(s[2 * 33], s[3 * 33]); o.z = pk2(s[4 * 33], s[5 * 33]); o.w = pk2(s[6 * 33], s[7 * 33]);
        *(v4u*)(D.wt + (size_t)(D.d0 + n) * D.K + D.k0 + 8 * c) = o; }
    asm volatile("s_waitcnt lgkmcnt(0)" ::: "memory");
}

__device__ __forceinline__ void final_norm_phase_b(const bf16* hb, float* out, const float* gain, int gw, int NGW, int lane) {
    for (int m = gw; m < MROWS; m += 8 * NGW) {
        pg8::u32x4 v[8][2]; float ss[8];
#pragma unroll
        for (int u = 0; u < 8; ++u) { const pg8::u32x4* xr = (const pg8::u32x4*)(hb + (size_t)(m + u * NGW) * DM) + lane;
#pragma unroll
            for (int j = 0; j < 2; ++j) v[u][j] = xr[64 * j]; }
#pragma unroll
        for (int u = 0; u < 8; ++u) { float s = 0.f;
#pragma unroll
            for (int j = 0; j < 2; ++j)
#pragma unroll
                for (int e = 0; e < 4; ++e) { const float a = __uint_as_float(v[u][j][e] << 16), b = __uint_as_float(v[u][j][e] & 0xffff0000u); s += a * a + b * b; }
            ss[u] = 1.f / sqrtf(wave_sum(s) * (1.f / DM) + EPSF); }
        f32x4 g[2][2];
#pragma unroll
        for (int j = 0; j < 2; ++j) { g[j][0] = ((const f32x4*)gain)[(lane + 64 * j) * 2]; g[j][1] = ((const f32x4*)gain)[(lane + 64 * j) * 2 + 1]; }
#pragma unroll
        for (int u = 0; u < 8; ++u) { f32x4* o = (f32x4*)(out + (size_t)(m + u * NGW) * DM); const float rs = ss[u];
#pragma unroll
            for (int j = 0; j < 2; ++j) { const pg8::u32x4 w = v[u][j];
                const f32x4 a0 = {__uint_as_float(w.x << 16), __uint_as_float(w.x & 0xffff0000u), __uint_as_float(w.y << 16), __uint_as_float(w.y & 0xffff0000u)};
                const f32x4 a1 = {__uint_as_float(w.z << 16), __uint_as_float(w.z & 0xffff0000u), __uint_as_float(w.w << 16), __uint_as_float(w.w & 0xffff0000u)};
                o[(lane + 64 * j) * 2] = a0 * rs * g[j][0]; o[(lane + 64 * j) * 2 + 1] = a1 * rs * g[j][1]; } }
    }
}
__device__ __forceinline__ void final_norm_phase(float* h, const float* gain, int gw, int NGW, int lane) {
    for (int m = gw; m < MROWS; m += 8 * NGW) {
        f32x4 v[8][4]; float ss[8];
#pragma unroll
        for (int u = 0; u < 8; ++u) { const f32x4* xr = (const f32x4*)(h + (size_t)(m + u * NGW) * DM) + lane;
#pragma unroll
            for (int j = 0; j < 4; ++j) v[u][j] = xr[64 * j]; }
#pragma unroll
        for (int u = 0; u < 8; ++u) { float s = 0.f;
#pragma unroll
            for (int j = 0; j < 4; ++j) s += (v[u][j].x * v[u][j].x + v[u][j].y * v[u][j].y) + (v[u][j].z * v[u][j].z + v[u][j].w * v[u][j].w);
            ss[u] = 1.f / sqrtf(wave_sum(s) * (1.f / DM) + EPSF); }
        const f32x4* gr = (const f32x4*)gain + lane; f32x4 g[4];
#pragma unroll
        for (int j = 0; j < 4; ++j) g[j] = gr[64 * j];
#pragma unroll
        for (int u = 0; u < 8; ++u) { f32x4* o = (f32x4*)(h + (size_t)(m + u * NGW) * DM) + lane; const float rs = ss[u];
#pragma unroll
            for (int j = 0; j < 4; ++j) o[64 * j] = v[u][j] * rs * g[j]; }
    }
}

__device__ __forceinline__ void cast_stats_phase(const float* src, bf16* dst, float* SS, int gw, int NGW, int lane) {
    for (int m = gw; m < MROWS; m += 8 * NGW) {
        f32x4 v[8][4];
#pragma unroll
        for (int u = 0; u < 8; ++u) { const f32x4* xr = (const f32x4*)(src + (size_t)(m + u * NGW) * DM) + lane;
#pragma unroll
            for (int j = 0; j < 4; ++j) v[u][j] = xr[64 * j]; }
#pragma unroll
        for (int u = 0; u < 8; ++u) { float s = 0.f; unsigned long long* o8 = (unsigned long long*)(dst + (size_t)(m + u * NGW) * DM) + lane;
#pragma unroll
            for (int j = 0; j < 4; ++j) { s += (v[u][j].x * v[u][j].x + v[u][j].y * v[u][j].y) + (v[u][j].z * v[u][j].z + v[u][j].w * v[u][j].w);
                o8[64 * j] = (unsigned long long)pk2(v[u][j].x, v[u][j].y) | ((unsigned long long)pk2(v[u][j].z, v[u][j].w) << 32); }
            s = wave_sum(s); if (lane < 16) SS[(size_t)(m + u * NGW) * 16 + lane] = (lane == 0) ? s : 0.f; }
    }
}
__device__ __forceinline__ void p0_prologue(const Args& A, LAS unsigned char* lds, int wave, int lane) {
    unsigned char* ws = A.ws;
    LAS float* scr = (LAS float*)(lds + wave * 16384);
    const int gw = blockIdx.x * NWAVES + wave, NGW = gridDim.x * NWAVES;
    {   constexpr int I_ABIN = 16 * (AB_IN / 32), I_SQ = 16 * 32, I_NSAIN = 16 * (NSA_INP / 32), I_F13 = 16 * (FFH / 32), I_F2 = (FFH / 64) * 32, I_C1 = 32 * 2, I_C2 = 2;
        constexpr int NITEMS = I_ABIN + I_SQ + I_NSAIN + I_SQ + 4 * I_F13 + 2 * I_F2 + 2 * I_C1 + 2 * I_C2;
        P0Desc D0, D1; float ta[32], tb[32]; int it = gw;
        if (it < NITEMS) { p0_decode(A, ws, it, lane, D0); p0_load(D0, ta, lane); }
        while (it < NITEMS) {
            const int it1 = it + NGW; const bool has1 = it1 < NITEMS;
            if (has1) { p0_decode(A, ws, it1, lane, D1); p0_load(D1, tb, lane); }
            p0_store(D0, ta, scr, lane);
            if (!has1) break;
            const int it2 = it1 + NGW; const bool has2 = it2 < NITEMS;
            if (has2) { p0_decode(A, ws, it2, lane, D0); p0_load(D0, ta, lane); }
            p0_store(D1, tb, scr, lane);
            if (!has2) break;
            it = it2; } }
    {   const int gt = blockIdx.x * NTHREADS + threadIdx.x, NT = gridDim.x * NTHREADS;
        float* rc = (float*)(ws + TAB_RCOS); float* rsn = (float*)(ws + TAB_RSIN); float* nc = (float*)(ws + TAB_NCOS); float* ns = (float*)(ws + TAB_NSIN);
        for (int e = gt; e < 4096 * 40; e += NT) {
            const int pos = e / 40, i = e % 40; double inv;
            if (i < 32) inv = exp(-9.210340371976184 * ((double)i / 32.0));
            else inv = exp(-13.122363377404328 * ((double)(i - 32) / 8.0));
            double tr = (double)pos * inv * 0.15915494309189535; tr -= floor(tr);
            const float ft = (float)tr; const float sv = __builtin_amdgcn_sinf(ft), cv = __builtin_amdgcn_cosf(ft);
            if (i < 32) { rc[pos * 32 + i] = cv; rsn[pos * 32 + i] = sv; } else { nc[pos * 8 + (i - 32)] = cv; ns[pos * 8 + (i - 32)] = sv; }
        }
    }
    {   const int gt = blockIdx.x * NTHREADS + threadIdx.x, NT = gridDim.x * NTHREADS; bf16* GW = (bf16*)(ws + W_GATE);
        for (int e = gt; e < 2 * 8 * 4096; e += NT) { const int gate = e >> 15, r = e & 32767, n = r >> 12, jj = (r >> 6) & 63, ii = r & 63;
            GW[e] = (bf16)f2bf(A.in[gate ? I_GX_W : I_GA_W][n * 4096 + ii * 64 + jj]); } }
    for (int it = gw; it < 64; it += NGW) { const int which = it >> 5, ch = it & 31; const float* pe = A.in[which ? I_PE_V : I_PE_K] + ch * 64; const float* w1 = A.in[which ? I_V_W1 : I_K_W1] + (size_t)ch * 64 * 64 + lane;
        float s = 0.f;
#pragma unroll 16
        for (int k = 0; k < 64; ++k) s += pe[k] * w1[k * 64];
        ((float*)(ws + TAB_CB))[128 + it * 64 + lane] = s; }
    cast_stats_phase(A.in[I_X], (bf16*)(ws + WS_XN), (float*)(ws + WS_SS), gw, NGW, lane);
}

__device__ __forceinline__ float fsigm(float x) { return __builtin_amdgcn_rcpf(1.f + __builtin_amdgcn_exp2f(-LOG2E * x)); }
__device__ __forceinline__ void lru_chain_item(const Args& A, LAS unsigned char* lds, int item) {
    LAS float* RAW = (LAS float*)lds; LAS bf16* XB = (LAS bf16*)(lds + 33536); LAS float* G = (LAS float*)(lds + 33536 + 18432);
    LAS float* PH = G + 16384; LAS float* CAR = PH + 2048;
    const int tid = threadIdx.x, lane = tid & 63, j = tid & 63, tg = tid >> 6, w = tg, lr = lane & 15, lq = lane >> 4;
    const int chain = item & 63, b = chain >> 3, n = chain & 7, seg = item >> 6, c = n * 64 + j;
    const bf16* P0 = (const bf16*)(A.ws + WS_PROJ0); bf16* CAT = (bf16*)(A.ws + WS_CAT);
    unsigned long long* GR = (unsigned long long*)(A.ws + WS_CTL + 65536) + (size_t)(chain * 16) * 64;
    __syncthreads();
    const float gab = A.in[I_GA_B][c], gxb = A.in[I_GX_B][c], lam = A.in[I_LAM][c];
    const float sp8 = 8.f * LOG2E * log1pf(expf(-lam));
    const float cw0 = A.in[I_CONV_W][c], cw1 = A.in[I_CONV_W][512 + c], cw2 = A.in[I_CONV_W][1024 + c], cw3 = A.in[I_CONV_W][1536 + c], cb = A.in[I_CONV_B][c];
    bf16x8 bfr[4][2];
#pragma unroll
    for (int nt = 0; nt < 4; ++nt)
#pragma unroll
        for (int ks = 0; ks < 2; ++ks) bfr[nt][ks] = *(const bf16x8*)((const bf16*)(A.ws + W_GATE) + (size_t)(((w & 1) * 8 + n) * 64 + 16 * nt + lr) * 64 + 32 * ks + 8 * lq);
    const bf16* xrb = P0 + (size_t)(b * SEQ) * AB_IN + 512 + c;
    bf16 rawn[17];
#pragma unroll
    for (int i = 0; i < 17; ++i) { const int r = tg + 8 * i, t = seg * 256 - 3 + r; rawn[i] = (r < 131 && t >= 0) ? xrb[(size_t)t * AB_IN] : (bf16)0; }
    float av[2][16], uv[2][16]; unsigned yv[2][8];
#pragma unroll
    for (int sub = 0; sub < 2; ++sub) {
        const int t0 = seg * 256 + sub * 128;
#pragma unroll
        for (int i = 0; i < 17; ++i) { const int r = tg + 8 * i; if (r < 131) RAW[r * 64 + j] = bf2f(rawn[i]); }
        if (sub < 1) {
#pragma unroll
            for (int i = 0; i < 17; ++i) { const int r = tg + 8 * i, t = t0 + 128 - 3 + r; rawn[i] = (r < 131) ? xrb[(size_t)t * AB_IN] : (bf16)0; } }
#pragma unroll
        for (int q = 0; q < 8; ++q) { const bf16* yp = P0 + ((size_t)b * SEQ + t0 + tg * 16 + 2 * q) * AB_IN + c; yv[sub][q] = (unsigned)yp[0] | ((unsigned)yp[AB_IN] << 16); }
        __syncthreads();
        float xv[16];
#pragma unroll
        for (int q = 0; q < 16; ++q) { const int tt = tg * 16 + q; const float x = cb + cw0 * RAW[tt * 64 + j] + cw1 * RAW[(tt + 1) * 64 + j] + cw2 * RAW[(tt + 2) * 64 + j] + cw3 * RAW[(tt + 3) * 64 + j]; xv[q] = x; XB[tt * 72 + j] = (bf16)f2bf(x); }
        __syncthreads();
#pragma unroll
        for (int h = 0; h < 2; ++h) {
            const int mt = (w >> 1) + 4 * h; bf16x8 af[2];
#pragma unroll
            for (int ks = 0; ks < 2; ++ks) af[ks] = *(const LAS bf16x8*)(XB + (16 * mt + lr) * 72 + 32 * ks + 8 * lq);
            LAS float* Gw = G + (w & 1) * 8192 + (16 * mt + 4 * lq) * 64 + lr;
#pragma unroll
            for (int nt = 0; nt < 4; ++nt) { f32x4 acc = mfma16(af[0], bfr[nt][0], (f32x4){0.f, 0.f, 0.f, 0.f}); acc = mfma16(af[1], bfr[nt][1], acc);
#pragma unroll
                for (int r = 0; r < 4; ++r) Gw[r * 64 + 16 * nt] = acc[r]; } }
        __syncthreads();
        float Pl = 1.f, Hl = 0.f;
#pragma unroll
        for (int q = 0; q < 16; ++q) { const int tt = tg * 16 + q; const float r = fsigm(G[tt * 64 + j] + gab), ig = fsigm(G[8192 + tt * 64 + j] + gxb);
            const float a = __builtin_amdgcn_exp2f(-sp8 * r); const float mult = __builtin_amdgcn_sqrtf(fmaf(-a, a, 1.f));
            av[sub][q] = a; uv[sub][q] = mult * (ig * xv[q]); Hl = a * Hl + uv[sub][q]; Pl *= a; }
        PH[((sub * 8 + tg) * 64 + j) * 2] = Pl; PH[((sub * 8 + tg) * 64 + j) * 2 + 1] = Hl;
    }
    __syncthreads();
    if (tg == 7) {
        float P = 1.f, H = 0.f;
#pragma unroll
        for (int g2 = 0; g2 < 16; ++g2) { const float pg = PH[(g2 * 64 + j) * 2], hg = PH[(g2 * 64 + j) * 2 + 1]; H = pg * H + hg; P *= pg; }
        const int i4 = seg & 3, r4 = seg - i4;
        unsigned long long* GE = (unsigned long long*)(A.ws + WS_CTL + 65536 + 524288) + (size_t)(chain * 4) * 64;
        if (i4 < 3) __hip_atomic_store(GR + seg * 64 + j, ((unsigned long long)__float_as_uint(H) << 32) | (unsigned long long)__float_as_uint(P), __ATOMIC_RELAXED, __HIP_MEMORY_SCOPE_AGENT);
        unsigned long long xe = 0ull, xs[3] = {0ull, 0ull, 0ull};
        if (seg > 0) for (unsigned spins = 0; ; ) {
            bool ok0 = true;
            if (lane == 0) { if (r4 > 0) ok0 = ((unsigned)(__hip_atomic_load(GE + ((r4 >> 2) - 1) * 64, __ATOMIC_RELAXED, __HIP_MEMORY_SCOPE_AGENT) >> 32) != 0xffffffffu);
                if (i4 > 0) ok0 = ok0 && ((unsigned)__hip_atomic_load(GR + (seg - 1) * 64, __ATOMIC_RELAXED, __HIP_MEMORY_SCOPE_AGENT) != 0xffffffffu); }
            if (__all(ok0)) { bool ok = true;
                if (r4 > 0) { xe = __hip_atomic_load(GE + ((r4 >> 2) - 1) * 64 + j, __ATOMIC_RELAXED, __HIP_MEMORY_SCOPE_AGENT); ok = ok && ((unsigned)(xe >> 32) != 0xffffffffu); }
#pragma unroll
                for (int k = 0; k < 3; ++k) if (k < i4) { xs[k] = __hip_atomic_load(GR + (r4 + k) * 64 + j, __ATOMIC_RELAXED, __HIP_MEMORY_SCOPE_AGENT); ok = ok && ((unsigned)xs[k] != 0xffffffffu); }
                if (__all(ok)) break; }
            __builtin_amdgcn_s_sleep(2);
            if (++spins > (1u << 18)) break; }
        float hin = (r4 > 0) ? __uint_as_float((unsigned)xe) : 0.f;
#pragma unroll
        for (int k = 0; k < 3; ++k) if (k < i4) hin = __uint_as_float((unsigned)xs[k]) * hin + __uint_as_float((unsigned)(xs[k] >> 32));
        if (i4 == 3 && seg < 15) __hip_atomic_store(GE + (seg >> 2) * 64 + j, (unsigned long long)__float_as_uint(P * hin + H), __ATOMIC_RELAXED, __HIP_MEMORY_SCOPE_AGENT);
        CAR[j] = hin; }
    __syncthreads();
    float cin = CAR[j];
#pragma unroll
    for (int sub = 0; sub < 2; ++sub) {
        const int t0 = seg * 256 + sub * 128;
        {   float pp[7], hh[7];
#pragma unroll
            for (int g2 = 0; g2 < 7; ++g2) { pp[g2] = PH[((sub * 8 + g2) * 64 + j) * 2]; hh[g2] = PH[((sub * 8 + g2) * 64 + j) * 2 + 1]; }
#pragma unroll
            for (int g2 = 0; g2 < 7; ++g2) if (g2 < tg) cin = pp[g2] * cin + hh[g2]; }
#pragma unroll
        for (int q = 0; q < 16; ++q) { cin = av[sub][q] * cin + uv[sub][q];
            const size_t row = (size_t)b * SEQ + t0 + tg * 16 + q; const float y = __uint_as_float((q & 1) ? (yv[sub][q >> 1] & 0xffff0000u) : (yv[sub][q >> 1] << 16)); const float u = 0.7978845608028654f * (y + 0.044715f * y * y * y);
            CAT[row * DM + c] = (bf16)f2bf(cin * y * fsigm(2.f * u)); }
        if (sub == 0) {
            float pp[8], hh[8];
#pragma unroll
            for (int g2 = 1; g2 < 8; ++g2) { pp[g2] = PH[((g2) * 64 + j) * 2]; hh[g2] = PH[((g2) * 64 + j) * 2 + 1]; }
#pragma unroll
            for (int g2 = 1; g2 < 8; ++g2) if (g2 > tg) cin = pp[g2] * cin + hh[g2]; }
    }
}
__device__ __forceinline__ void lru_item(const Args& A, LAS unsigned char* lds, int item, int mode) {
    LAS float* RAW = (LAS float*)lds; LAS bf16* XB = (LAS bf16*)(lds + 33536); LAS float* G = (LAS float*)(lds + 33536 + 18432);
    LAS float* PH = G + 16384; LAS float* CAR = PH + 1024;
    const int tid = threadIdx.x, lane = tid & 63, j = tid & 63, tg = tid >> 6, w = tg, lr = lane & 15, lq = lane >> 4;
    const int b = item >> 7, n = (item >> 4) & 7, seg = item & 15, c = n * 64 + j;
    const bf16* P0 = (const bf16*)(A.ws + WS_PROJ0); bf16* CAT = (bf16*)(A.ws + WS_CAT); float* LS = (float*)(A.ws + WS_LSUM);
    __syncthreads();
    const float gab = A.in[I_GA_B][c], gxb = A.in[I_GX_B][c], lam = A.in[I_LAM][c];
    const float sp8 = 8.f * LOG2E * log1pf(expf(-lam));
    const float cw0 = A.in[I_CONV_W][c], cw1 = A.in[I_CONV_W][512 + c], cw2 = A.in[I_CONV_W][1024 + c], cw3 = A.in[I_CONV_W][1536 + c], cb = A.in[I_CONV_B][c];
    float carry = 0.f, ptot = 1.f;
    if (mode == 1) { float pp[15], hh[15];
#pragma unroll
        for (int s2 = 0; s2 < 15; ++s2) { pp[s2] = 1.f; hh[s2] = 0.f; if (s2 < seg) { const float* q = LS + ((size_t)(b * 16 + s2) * 512 + c) * 2; pp[s2] = q[0]; hh[s2] = q[1]; } }
#pragma unroll
        for (int s2 = 0; s2 < 15; ++s2) carry = pp[s2] * carry + hh[s2]; }
    if (tg == 0) CAR[j] = carry;
    __syncthreads();
    bf16x8 bfr[4][2];
#pragma unroll
    for (int nt = 0; nt < 4; ++nt)
#pragma unroll
        for (int ks = 0; ks < 2; ++ks) bfr[nt][ks] = *(const bf16x8*)((const bf16*)(A.ws + W_GATE) + (size_t)(((w & 1) * 8 + n) * 64 + 16 * nt + lr) * 64 + 32 * ks + 8 * lq);
    const bf16* xrb = P0 + (size_t)(b * SEQ) * AB_IN + 512 + c;
    bf16 rawn[17];
#pragma unroll
    for (int i = 0; i < 17; ++i) { const int r = tg + 8 * i, t = seg * 256 - 3 + r; rawn[i] = (r < 131 && t >= 0) ? xrb[(size_t)t * AB_IN] : (bf16)0; }
    for (int sub = 0; sub < 2; ++sub) {
        const int t0 = seg * 256 + sub * 128;
        bf16 yv[16];
        if (mode == 1) {
#pragma unroll
            for (int q = 0; q < 16; ++q) yv[q] = P0[((size_t)b * SEQ + t0 + tg * 16 + q) * AB_IN + c]; }
#pragma unroll
        for (int i = 0; i < 17; ++i) { const int r = tg + 8 * i; if (r < 131) RAW[r * 64 + j] = bf2f(rawn[i]); }
        if (sub < 1) {
#pragma unroll
            for (int i = 0; i < 17; ++i) { const int r = tg + 8 * i, t = t0 + 128 - 3 + r; rawn[i] = (r < 131) ? xrb[(size_t)t * AB_IN] : (bf16)0; } }
        __syncthreads();
        float xv[16];
#pragma unroll
        for (int q = 0; q < 16; ++q) { const int tt = tg * 16 + q; const float x = cb + cw0 * RAW[tt * 64 + j] + cw1 * RAW[(tt + 1) * 64 + j] + cw2 * RAW[(tt + 2) * 64 + j] + cw3 * RAW[(tt + 3) * 64 + j]; xv[q] = x; XB[tt * 72 + j] = (bf16)f2bf(x); }
        __syncthreads();
#pragma unroll
        for (int h = 0; h < 2; ++h) {
            const int mt = (w >> 1) + 4 * h; bf16x8 af[2];
#pragma unroll
            for (int ks = 0; ks < 2; ++ks) af[ks] = *(const LAS bf16x8*)(XB + (16 * mt + lr) * 72 + 32 * ks + 8 * lq);
            LAS float* Gw = G + (w & 1) * 8192 + (16 * mt + 4 * lq) * 64 + lr;
#pragma unroll
            for (int nt = 0; nt < 4; ++nt) { f32x4 acc = mfma16(af[0], bfr[nt][0], (f32x4){0.f, 0.f, 0.f, 0.f}); acc = mfma16(af[1], bfr[nt][1], acc);
#pragma unroll
                for (int r = 0; r < 4; ++r) Gw[r * 64 + 16 * nt] = acc[r]; } }
        __syncthreads();
        float av[16], uv[16]; float Pl = 1.f, Hl = 0.f;
#pragma unroll
        for (int q = 0; q < 16; ++q) { const int tt = tg * 16 + q; const float r = fsigm(G[tt * 64 + j] + gab), ig = fsigm(G[8192 + tt * 64 + j] + gxb);
            const float a = __builtin_amdgcn_exp2f(-sp8 * r); const float mult = __builtin_amdgcn_sqrtf(fmaf(-a, a, 1.f));
            av[q] = a; uv[q] = mult * (ig * xv[q]); Hl = a * Hl + uv[q]; Pl *= a; }
        PH[(tg * 64 + j) * 2] = Pl; PH[(tg * 64 + j) * 2 + 1] = Hl;
        __syncthreads();
        float cin = CAR[j];
        {   float pp[7], hh[7];
#pragma unroll
            for (int g2 = 0; g2 < 7; ++g2) { pp[g2] = PH[(g2 * 64 + j) * 2]; hh[g2] = PH[(g2 * 64 + j) * 2 + 1]; }
#pragma unroll
            for (int g2 = 0; g2 < 7; ++g2) if (g2 < tg) cin = pp[g2] * cin + hh[g2]; }
#pragma unroll
        for (int q = 0; q < 16; ++q) { cin = av[q] * cin + uv[q];
            if (mode == 1) { const size_t row = (size_t)b * SEQ + t0 + tg * 16 + q; const float y = bf2f(yv[q]); const float u = 0.7978845608028654f * (y + 0.044715f * y * y * y);
                CAT[row * DM + c] = (bf16)f2bf(cin * y * fsigm(2.f * u)); } }
        __syncthreads();
        if (tg == 7) { CAR[j] = cin; if (mode == 0) { float pt = 1.f;
#pragma unroll
                for (int g2 = 0; g2 < 8; ++g2) pt *= PH[(g2 * 64 + j) * 2]; ptot *= pt; } }
    }
    if (mode == 0 && tg == 7) { float* q = LS + ((size_t)(b * 16 + seg) * 512 + c) * 2; q[0] = ptot; q[1] = CAR[j]; }
}

__device__ __forceinline__ float ret_log_g(int h) { return log1pf(-exp2f(-5.f - (float)h)); }
__device__ __forceinline__ void ret_kv_load(const bf16* P0, int item, int tid, v4u (&kraw)[2], v4u (&vraw)[2]) {
    const int b = item >> 8, h = (item >> 5) & 7, m = item & 31; const size_t row0 = (size_t)b * SEQ + m * 128;
#pragma unroll
    for (int rep = 0; rep < 2; ++rep) { const bf16* rp = P0 + (row0 + (tid >> 3) + 64 * rep) * AB_IN + h * 64 + 8 * (tid & 7); kraw[rep] = *(const v4u*)(rp + 1536); vraw[rep] = *(const v4u*)(rp + 2048); }
}
__device__ __forceinline__ void ret_kv_run(const Args& A, LAS unsigned char* lds, int first, int stride, int end) {
    LAS bf16* VT = (LAS bf16*)lds; LAS bf16* KT = VT + 64 * 136;
    const int tid = threadIdx.x, lane = tid & 63, w = tid >> 6, lr = lane & 15, lq = lane >> 4;
    const bf16* P0 = (const bf16*)(A.ws + WS_PROJ0); float* KVT = (float*)(A.ws + WS_KVT);
    v4u kraw[2], vraw[2];
    if (first < end) ret_kv_load(P0, first, tid, kraw, vraw);
    for (int item = first; item < end; item += stride) {
        const int b = item >> 8, h = (item >> 5) & 7, m = item & 31; const float l2g = ret_log_g(h) * LOG2E;
        __syncthreads();
#pragma unroll
        for (int rep = 0; rep < 2; ++rep) { const int jj = (tid >> 3) + 64 * rep, e8 = tid & 7; const float dec = __builtin_amdgcn_exp2f((float)(127 - jj) * l2g);
            const unsigned kw[4] = {kraw[rep].x, kraw[rep].y, kraw[rep].z, kraw[rep].w}, vw[4] = {vraw[rep].x, vraw[rep].y, vraw[rep].z, vraw[rep].w};
#pragma unroll
            for (int i = 0; i < 4; ++i) { VT[(8 * e8 + 2 * i) * 136 + jj] = (bf16)(vw[i] & 0xffffu); VT[(8 * e8 + 2 * i + 1) * 136 + jj] = (bf16)(vw[i] >> 16);
                KT[(8 * e8 + 2 * i) * 136 + jj] = (bf16)f2bf(bf2f((bf16)(kw[i] & 0xffffu)) * dec); KT[(8 * e8 + 2 * i + 1) * 136 + jj] = (bf16)f2bf(bf2f((bf16)(kw[i] >> 16)) * dec); } }
        if (item + stride < end) ret_kv_load(P0, item + stride, tid, kraw, vraw);
        __syncthreads();
        const int et = w >> 1, dt0 = (w & 1) * 2; f32x4 acc[2] = {(f32x4){0.f, 0.f, 0.f, 0.f}, (f32x4){0.f, 0.f, 0.f, 0.f}};
#pragma unroll
        for (int ks = 0; ks < 4; ++ks) { const bf16x8 af = *(const LAS bf16x8*)(VT + (16 * et + lr) * 136 + 32 * ks + 8 * lq);
#pragma unroll
            for (int dd = 0; dd < 2; ++dd) { const bf16x8 bfr = *(const LAS bf16x8*)(KT + (16 * (dt0 + dd) + lr) * 136 + 32 * ks + 8 * lq); acc[dd] = mfma16(af, bfr, acc[dd]); } }
        float* o = KVT + ((size_t)((b * 8 + h) * 32 + m)) * 4096;
#pragma unroll
        for (int dd = 0; dd < 2; ++dd)
#pragma unroll
            for (int r = 0; r < 4; ++r) o[(16 * et + 4 * lq + r) * 64 + 16 * (dt0 + dd) + lr] = acc[dd][r];
    }
}
constexpr int VT_LD = 136, ST_LD = 72, PW_LD = 72;
struct RetPre { v4u vraw[2]; f32x4 ka, kc; };
__device__ __forceinline__ void ret_out_pre(const Args& A, int item, bool first, RetPre& R) {
    const int tid = threadIdx.x, b = item >> 8, h = (item >> 5) & 7, n = item & 31; const bf16* P0 = (const bf16*)(A.ws + WS_PROJ0); const float* KVT = (const float*)(A.ws + WS_KVT); const size_t row0 = (size_t)b * SEQ + n * 128;
#pragma unroll
    for (int rep = 0; rep < 2; ++rep) R.vraw[rep] = *(const v4u*)(P0 + (row0 + (tid >> 3) + 64 * rep) * AB_IN + 2048 + h * 64 + 8 * (tid & 7));
    const float* kp = KVT + ((size_t)((b * 8 + h) * 32)) * 4096 + tid * 8; R.ka = (f32x4){0.f, 0.f, 0.f, 0.f}; R.kc = R.ka;
    if (!first) { R.ka = *(const f32x4*)(kp + (size_t)(n - 1) * 4096); R.kc = *(const f32x4*)(kp + (size_t)(n - 1) * 4096 + 4); }
}
__device__ __forceinline__ void ret_out_item(const Args& A, LAS unsigned char* lds, int item, bool first, RetPre& R, int next_item, bool next_first) {
    LAS bf16* VT = (LAS bf16*)lds;
    LAS bf16* STT = VT + 64 * VT_LD;
    LAS bf16* PWall = STT + 64 * ST_LD;
    const int tid = threadIdx.x, lane = tid & 63, w = tid >> 6, lr = lane & 15, lq = lane >> 4, b = item >> 8, h = (item >> 5) & 7, n = item & 31;
    const bf16* P0 = (const bf16*)(A.ws + WS_PROJ0); const float* KVT = (const float*)(A.ws + WS_KVT); bf16* CAT = (bf16*)(A.ws + WS_CAT);
    const float lg = ret_log_g(h), l2g = lg * LOG2E;
    const size_t row0 = (size_t)b * SEQ + n * 128;
    const v4u vraw[2] = {R.vraw[0], R.vraw[1]}; const f32x4 ka = R.ka, kc = R.kc;
    const float* kp = KVT + ((size_t)((b * 8 + h) * 32)) * 4096 + tid * 8;
    bf16x8 qa[2], kf[2][4][2];
#pragma unroll
    for (int ks = 0; ks < 2; ++ks) qa[ks] = *(const bf16x8*)(P0 + (row0 + 16 * w + lr) * AB_IN + 1024 + h * 64 + 32 * ks + 8 * lq);
    const int ntile = (w >= 4) ? 2 : 1;
#pragma unroll
    for (int jt = 0; jt < 2; ++jt) if (jt < ntile) {
#pragma unroll
        for (int nt = 0; nt < 4; ++nt) { const bf16* kq = P0 + (row0 + 64 * jt + 16 * nt + lr) * AB_IN + 1536 + h * 64 + 8 * lq; kf[jt][nt][0] = *(const bf16x8*)kq; kf[jt][nt][1] = *(const bf16x8*)(kq + 32); } }
    bf16 gv[4][4];
#pragma unroll
    for (int r = 0; r < 4; ++r)
#pragma unroll
        for (int ct = 0; ct < 4; ++ct) gv[r][ct] = P0[(row0 + 16 * w + lq * 4 + r) * AB_IN + 2560 + h * 64 + 16 * ct + lr];
    __syncthreads();
#pragma unroll
    for (int rep = 0; rep < 2; ++rep) { const int jj = (tid >> 3) + 64 * rep, e8 = tid & 7; const unsigned wv[4] = {vraw[rep].x, vraw[rep].y, vraw[rep].z, vraw[rep].w};
#pragma unroll
        for (int i = 0; i < 4; ++i) { VT[(8 * e8 + 2 * i) * VT_LD + jj] = (bf16)(wv[i] & 0xffffu); VT[(8 * e8 + 2 * i + 1) * VT_LD + jj] = (bf16)(wv[i] >> 16); } }
    {   LAS float* SF = (LAS float*)(PWall + 8 * 16 * PW_LD);
        float st[8]; const float cd = expf(128.f * lg);
        if (first) {
#pragma unroll
            for (int i = 0; i < 8; ++i) st[i] = 0.f;
            int m = 0;
            for (; m + 4 <= n; m += 4) { f32x4 a[4], c[4];
#pragma unroll
                for (int u = 0; u < 4; ++u) { a[u] = *(const f32x4*)(kp + (size_t)(m + u) * 4096); c[u] = *(const f32x4*)(kp + (size_t)(m + u) * 4096 + 4); }
#pragma unroll
                for (int u = 0; u < 4; ++u) { st[0] = st[0] * cd + a[u].x; st[1] = st[1] * cd + a[u].y; st[2] = st[2] * cd + a[u].z; st[3] = st[3] * cd + a[u].w; st[4] = st[4] * cd + c[u].x; st[5] = st[5] * cd + c[u].y; st[6] = st[6] * cd + c[u].z; st[7] = st[7] * cd + c[u].w; } }
            for (; m < n; ++m) { const f32x4 a = *(const f32x4*)(kp + (size_t)m * 4096), c = *(const f32x4*)(kp + (size_t)m * 4096 + 4);
                st[0] = st[0] * cd + a.x; st[1] = st[1] * cd + a.y; st[2] = st[2] * cd + a.z; st[3] = st[3] * cd + a.w; st[4] = st[4] * cd + c.x; st[5] = st[5] * cd + c.y; st[6] = st[6] * cd + c.z; st[7] = st[7] * cd + c.w; }
        } else {
            const f32x4 p0 = *(const LAS f32x4*)(SF + tid * 8), p1 = *(const LAS f32x4*)(SF + tid * 8 + 4);
            st[0] = p0.x * cd + ka.x; st[1] = p0.y * cd + ka.y; st[2] = p0.z * cd + ka.z; st[3] = p0.w * cd + ka.w; st[4] = p1.x * cd + kc.x; st[5] = p1.y * cd + kc.y; st[6] = p1.z * cd + kc.z; st[7] = p1.w * cd + kc.w; }
        *(LAS f32x4*)(SF + tid * 8) = (f32x4){st[0], st[1], st[2], st[3]}; *(LAS f32x4*)(SF + tid * 8 + 4) = (f32x4){st[4], st[5], st[6], st[7]};
        const int e = tid >> 3, d0 = (tid & 7) * 8; v4u o; o.x = pk2(st[0], st[1]); o.y = pk2(st[2], st[3]); o.z = pk2(st[4], st[5]); o.w = pk2(st[6], st[7]);
        *(LAS v4u*)(STT + e * ST_LD + d0) = o; }
    __syncthreads();
    if (next_item >= 0) ret_out_pre(A, next_item, next_first, R);
    LAS bf16* PW = PWall + w * 16 * PW_LD;
    f32x4 O1[4], O2[4];
#pragma unroll
    for (int ct = 0; ct < 4; ++ct) { O1[ct] = (f32x4){0.f, 0.f, 0.f, 0.f}; O2[ct] = (f32x4){0.f, 0.f, 0.f, 0.f}; }
#pragma unroll
    for (int jt = 0; jt < 2; ++jt) if (jt < ntile) {
        f32x4 s[4];
#pragma unroll
        for (int nt = 0; nt < 4; ++nt) { s[nt] = mfma16(qa[0], kf[jt][nt][0], (f32x4){0.f, 0.f, 0.f, 0.f}); s[nt] = mfma16(qa[1], kf[jt][nt][1], s[nt]); }
#pragma unroll
        for (int nt = 0; nt < 4; ++nt)
#pragma unroll
            for (int r = 0; r < 4; ++r) { const int i = 16 * w + lq * 4 + r, jj = 64 * jt + 16 * nt + lr, dd = i - jj;
                const float p = (dd >= 0) ? s[nt][r] * __builtin_amdgcn_exp2f((float)dd * l2g) : 0.f; PW[(lq * 4 + r) * PW_LD + 16 * nt + lr] = (bf16)f2bf(p); }
        bf16x8 pa[2];
#pragma unroll
        for (int ks = 0; ks < 2; ++ks) pa[ks] = *(const LAS bf16x8*)(PW + lr * PW_LD + 32 * ks + 8 * lq);
#pragma unroll
        for (int ct = 0; ct < 4; ++ct)
#pragma unroll
            for (int ks = 0; ks < 2; ++ks) { const bf16x8 vb = *(const LAS bf16x8*)(VT + (16 * ct + lr) * VT_LD + 64 * jt + 32 * ks + 8 * lq); O1[ct] = mfma16(pa[ks], vb, O1[ct]); }
    }
#pragma unroll
    for (int ct = 0; ct < 4; ++ct)
#pragma unroll
        for (int ks = 0; ks < 2; ++ks) { const bf16x8 sb = *(const LAS bf16x8*)(STT + (16 * ct + lr) * ST_LD + 32 * ks + 8 * lq); O2[ct] = mfma16(qa[ks], sb, O2[ct]); }
#pragma unroll
    for (int r = 0; r < 4; ++r) { const int i = 16 * w + lq * 4 + r; const float qd = __builtin_amdgcn_exp2f((float)(i + 1) * l2g);
        float o[4]; float sm = 0.f;
#pragma unroll
        for (int ct = 0; ct < 4; ++ct) { o[ct] = O1[ct][r] + qd * O2[ct][r]; sm += o[ct]; }
        const float mean = gsum16(sm) * (1.f / 64.f); float vs = 0.f;
#pragma unroll
        for (int ct = 0; ct < 4; ++ct) { o[ct] -= mean; vs += o[ct] * o[ct]; }
        const float rstd = __builtin_amdgcn_rsqf(gsum16(vs) * (1.f / 64.f) + EPSF);
        const size_t row = row0 + i;
#pragma unroll
        for (int ct = 0; ct < 4; ++ct) { const int e = 16 * ct + lr; const float g = bf2f(gv[r][ct]); CAT[row * DM + 512 + h * 64 + e] = (bf16)f2bf(o[ct] * rstd * (g * fsigm(g))); } }
}
__device__ __forceinline__ void cmp_bias_to_lds(const Args& A, LAS unsigned char* lds) {
    const float* CB = (const float*)(A.ws + TAB_CB); const int tid = threadIdx.x;
    if (tid < 128) { float s = 0.f;
#pragma unroll
        for (int ch = 0; ch < 32; ++ch) s += CB[128 + ((tid >> 6) * 32 + ch) * 64 + (tid & 63)];
        ((LAS float*)(lds + 40960))[tid] = s; }
    __syncthreads();
}
__device__ __forceinline__ void cmp_item(const Args& A, LAS unsigned char* lds, int item) {
    LAS float* RED = (LAS float*)lds; LAS bf16* HID = (LAS bf16*)(lds + 32768);
    const int tid = threadIdx.x, lane = tid & 63, w = tid >> 6, lr = lane & 15, lq = lane >> 4;
    const int cgrp = item & 3, kv = (item >> 2) & 1, g = (item >> 3) & 3, b = item >> 5;
    const bf16* W1T = (const bf16*)(A.ws + (kv ? W_CV1 : W_CK1)); const bf16* W2T = (const bf16*)(A.ws + (kv ? W_CV2 : W_CK2)); const bf16* KV6 = (const bf16*)(A.ws + WS_KV6);
    bf16* KC = (bf16*)(A.ws + WS_KC); bf16* VCT = (bf16*)(A.ws + WS_VCT); const float* NC = (const float*)(A.ws + TAB_NCOS); const float* NS = (const float*)(A.ws + TAB_NSIN);
    bf16x8 bw[4][2][4];
#pragma unroll
    for (int lt = 0; lt < 4; ++lt)
#pragma unroll
        for (int ks = 0; ks < 2; ++ks)
#pragma unroll
            for (int nt = 0; nt < 4; ++nt) bw[lt][ks][nt] = *(const bf16x8*)(W1T + (size_t)(16 * nt + lr) * 2048 + (4 * w + lt) * 64 + 32 * ks + 8 * lq);
    bf16x8 w2f[2] = {(bf16x8){0, 0, 0, 0, 0, 0, 0, 0}, (bf16x8){0, 0, 0, 0, 0, 0, 0, 0}};
    if (w < 4) {
#pragma unroll
        for (int ks = 0; ks < 2; ++ks) w2f[ks] = *(const bf16x8*)(W2T + (16 * w + lr) * 64 + 32 * ks + 8 * lq); }
    bf16x8 af[4][2];
#define CMP_LOADA(ct_) do { const int c_ = 16 * (ct_) + lr; _Pragma("unroll") for (int lt = 0; lt < 4; ++lt) { int tok = 16 * c_ + 4 * w + lt; tok = tok > SEQ - 1 ? SEQ - 1 : tok; \
        const bf16* arow = KV6 + ((size_t)b * SEQ + tok) * 1536 + kv * 256 + g * 64; _Pragma("unroll") for (int ks = 0; ks < 2; ++ks) af[lt][ks] = *(const bf16x8*)(arow + 32 * ks + 8 * lq); } } while (0)
    CMP_LOADA(4 * cgrp);
    for (int ti = 0; ti < 4; ++ti) { const int ctile = 4 * cgrp + ti;
        f32x4 acc[4];
#pragma unroll
        for (int nt = 0; nt < 4; ++nt) acc[nt] = (f32x4){0.f, 0.f, 0.f, 0.f};
#pragma unroll
        for (int lt = 0; lt < 4; ++lt)
#pragma unroll
            for (int ks = 0; ks < 2; ++ks)
#pragma unroll
                for (int nt = 0; nt < 4; ++nt) acc[nt] = mfma16(af[lt][ks], bw[lt][ks][nt], acc[nt]);
        __syncthreads();
        if (ti < 3) CMP_LOADA(ctile + 1);
#pragma unroll
        for (int nt = 0; nt < 4; ++nt)
#pragma unroll
            for (int r = 0; r < 4; ++r) RED[(w * 16 + lq * 4 + r) * 64 + 16 * nt + lr] = acc[nt][r];
        __syncthreads();
#pragma unroll
        for (int rep = 0; rep < 2; ++rep) { const int e = tid + rep * NTHREADS, row = e >> 6, col = e & 63; float s = ((const LAS float*)(lds + 40960))[kv * 64 + col];
#pragma unroll
            for (int w2 = 0; w2 < 8; ++w2) s += RED[(w2 * 16 + row) * 64 + col];
            HID[row * 72 + col] = (bf16)f2bf(gelu_tanh(s)); }
        __syncthreads();
        if (w < 4) {
            f32x4 o = (f32x4){0.f, 0.f, 0.f, 0.f};
#pragma unroll
            for (int ks = 0; ks < 2; ++ks) { const bf16x8 a = *(const LAS bf16x8*)(HID + lr * 72 + 32 * ks + 8 * lq); o = mfma16(a, w2f[ks], o); }
#pragma unroll
            for (int r = 0; r < 4; ++r) { const int cc = 16 * ctile + lq * 4 + r, dim = 16 * w + lr; float val = o[r];
                if (kv == 0) {
                    if (w == 0) { const float partner = DPPF(val, 0x128);   int pos = 16 * cc + 31; pos = pos > SEQ - 1 ? SEQ - 1 : pos; const int f = lr & 7; const float cs = NC[pos * 8 + f], sn = NS[pos * 8 + f];
                        val = (lr < 8) ? (val * cs - partner * sn) : (val * cs + partner * sn); }
                    KC[((size_t)(b * 256 + cc) * 4 + g) * 64 + dim] = (bf16)f2bf(val);
                } else VCT[((size_t)(b * 4 + g) * 64 + dim) * 256 + cc] = (bf16)f2bf(val); }
        }
    }
#undef CMP_LOADA
}
typedef float f32x2 __attribute__((ext_vector_type(2))); typedef __bf16 bf16x2_t __attribute__((ext_vector_type(2)));
__device__ __forceinline__ unsigned cvtpk(float lo, float hi) { f32x2 v = {lo, hi}; bf16x2_t b = __builtin_convertvector(v, bf16x2_t); return __builtin_bit_cast(unsigned, b); }
__device__ __forceinline__ float vmax3(float a, float b, float c) { float r; asm("v_max3_f32 %0, %1, %2, %3" : "=v"(r) : "v"(a), "v"(b), "v"(c)); return r; }
__device__ __forceinline__ float vmax2(float a, float b) { float r; asm("v_max_f32_e32 %0, %1, %2" : "=v"(r) : "v"(a), "v"(b)); return r; }
__device__ __forceinline__ float colmax4(float v) {
    auto a = __builtin_amdgcn_permlane16_swap(__float_as_uint(v), __float_as_uint(v), false, false); v = vmax2(__uint_as_float(a[0]), __uint_as_float(a[1]));
    auto c = __builtin_amdgcn_permlane32_swap(__float_as_uint(v), __float_as_uint(v), false, false); return vmax2(__uint_as_float(c[0]), __uint_as_float(c[1])); }
__device__ __forceinline__ float colsum4(float v) { return rows4_sum(v); }
struct NsaSt { float mhat[2], l[2], invl[2]; f32x4 O[4][2]; };
template <int MODE>
__device__ __forceinline__ void nsa_softmax(NsaSt& S, f32x4 (&st)[4], const int nq, const int klo, const int khi, const bool colok, const int kb, LAS float* PSrow, const int lr, const int lq, bf16x8& p0, bf16x8& p1) {
    if (MODE <= 2) {
        const unsigned span = (khi >= klo) ? (unsigned)(khi - klo) : 0u; const int base = (khi >= klo) ? kb - klo : -0x40000000;
#pragma unroll
        for (int mt = 0; mt < 4; ++mt)
#pragma unroll
            for (int r = 0; r < 4; ++r) { const bool ok = (unsigned)(base + 32 * (mt >> 1) + 4 * (mt & 1) + r) <= span; st[mt][r] = ok ? st[mt][r] : NEGF; } }
    if (MODE != 1) {
        float a = st[0][0];
        asm volatile("s_nop 15\n\ts_nop 1\n\tv_max3_f32 %0, %0, %1, %2\n\tv_max3_f32 %0, %0, %3, %4\n\tv_max3_f32 %0, %0, %5, %6\n\tv_max3_f32 %0, %0, %7, %8\n\tv_max3_f32 %0, %0, %9, %10\n\tv_max3_f32 %0, %0, %11, %12\n\tv_max3_f32 %0, %0, %13, %14\n\tv_max_f32_e32 %0, %0, %15"
                     : "+v"(a) : "v"(st[0][1]), "v"(st[0][2]), "v"(st[0][3]), "v"(st[1][0]), "v"(st[1][1]), "v"(st[1][2]), "v"(st[1][3]), "v"(st[2][0]), "v"(st[2][1]), "v"(st[2][2]),
                       "v"(st[2][3]), "v"(st[3][0]), "v"(st[3][1]), "v"(st[3][2]), "v"(st[3][3]));
        a = colok ? a : NEGF; const float tmax = colmax4(a);
        if (__any(tmax > 8.f)) { const float dl = (tmax > 8.f) ? tmax : 0.f, f = __builtin_amdgcn_exp2f(-dl); S.mhat[nq] += dl; S.l[nq] *= f;
#pragma unroll
            for (int mt = 0; mt < 4; ++mt) st[mt] -= dl;
            if (MODE >= 2) {
#pragma unroll
                for (int ct = 0; ct < 4; ++ct) S.O[ct][nq] *= f; } }
    }
#pragma unroll
    for (int mt = 0; mt < 4; ++mt)
#pragma unroll
        for (int r = 0; r < 4; ++r) st[mt][r] = __builtin_amdgcn_exp2f(st[mt][r]);
    if (MODE == 1) {
#pragma unroll
        for (int mt = 0; mt < 4; ++mt) st[mt] *= S.invl[nq];
#pragma unroll
        for (int mt = 0; mt < 4; ++mt) { f32x4 hs = st[mt];
#pragma unroll
            for (int r = 0; r < 4; ++r) hs[r] = qsum4(hs[r]);
            if ((lr & 3) == 0) *(LAS f32x4*)(PSrow + (4 * nq + (lr >> 2)) * 256 + 32 * (mt >> 1) + 4 * (mt & 1) + 8 * lq) = hs; }
    } else { f32x2 a2 = (f32x2){st[0][0], st[0][1]} + (f32x2){st[0][2], st[0][3]};
#pragma unroll
        for (int mt = 1; mt < 4; ++mt) { a2 += (f32x2){st[mt][0], st[mt][1]}; a2 += (f32x2){st[mt][2], st[mt][3]}; }
        const float ls = a2.x + a2.y; S.l[nq] += colok ? ls : 0.f; }
    if (MODE >= 1) {
#pragma unroll
        for (int kk = 0; kk < 2; ++kk) { const f32x4 a = st[2 * kk], c = st[2 * kk + 1]; v4u pk; pk.x = cvtpk(a[0], a[1]); pk.y = cvtpk(a[2], a[3]); pk.z = cvtpk(c[0], c[1]); pk.w = cvtpk(c[2], c[3]);
            if (MODE >= 2 && !colok) pk = (v4u){0u, 0u, 0u, 0u};
            if (kk == 0) p0 = __builtin_bit_cast(bf16x8, pk); else p1 = __builtin_bit_cast(bf16x8, pk); } }
}
template <int MODE>
__device__ __forceinline__ bool nsa_softmax_fast(NsaSt& S, f32x4 (&st)[4], const int nq, const int klo, const int khi, const int kb, bf16x8& p0, bf16x8& p1) {
    if (MODE <= 2) {
        const unsigned span = (khi >= klo) ? (unsigned)(khi - klo) : 0u; const int base = (khi >= klo) ? kb - klo : -0x40000000;
#pragma unroll
        for (int mt = 0; mt < 4; ++mt)
#pragma unroll
            for (int r = 0; r < 4; ++r) { const bool ok = (unsigned)(base + 32 * (mt >> 1) + 4 * (mt & 1) + r) <= span; st[mt][r] = ok ? st[mt][r] : NEGF; } }
#pragma unroll
    for (int mt = 0; mt < 4; ++mt)
#pragma unroll
        for (int r = 0; r < 4; ++r) st[mt][r] = __builtin_amdgcn_exp2f(st[mt][r]);
    f32x2 a2 = (f32x2){st[0][0], st[0][1]} + (f32x2){st[0][2], st[0][3]};
#pragma unroll
    for (int mt = 1; mt < 4; ++mt) { a2 += (f32x2){st[mt][0], st[mt][1]}; a2 += (f32x2){st[mt][2], st[mt][3]}; }
    const float ls = a2.x + a2.y;
    if (__any(ls > 1.0995116e12f)) return true;
    S.l[nq] += ls;
    if (MODE >= 1) {
#pragma unroll
        for (int kk = 0; kk < 2; ++kk) { const f32x4 a = st[2 * kk], c = st[2 * kk + 1]; v4u pk; pk.x = cvtpk(a[0], a[1]); pk.y = cvtpk(a[2], a[3]); pk.z = cvtpk(c[0], c[1]); pk.w = cvtpk(c[2], c[3]);
            if (kk == 0) p0 = __builtin_bit_cast(bf16x8, pk); else p1 = __builtin_bit_cast(bf16x8, pk); } }
    return false;
}
template <int MODE>
__device__ __forceinline__ void nsa_full(NsaSt& S, const bf16x8 (&qf)[2][2], const LAS unsigned char* kbuf, const int koff, const int voff, const int klo0, const int klo1, const int khi0, const int khi1, const bool col0, const bool col1,
                                          const int kb, LAS float* PSrow, const int lr, const int lq) {
    bf16x8 kf[4][2];
#pragma unroll
    for (int mt = 0; mt < 4; ++mt) { kf[mt][0] = *(const LAS bf16x8*)(kbuf + 4096 * (mt >> 1) + 512 * (mt & 1) + koff); kf[mt][1] = *(const LAS bf16x8*)(kbuf + 4096 * (mt >> 1) + 512 * (mt & 1) + (koff ^ 64)); }
    f32x4 st0[4], st1[4];
    const float NINF = -__builtin_inff();
    {   const float n0 = col0 ? -S.mhat[0] : NINF, n1 = col1 ? -S.mhat[1] : NINF; const f32x4 negm0 = (f32x4){n0, n0, n0, n0}, negm1 = (f32x4){n1, n1, n1, n1};
#pragma unroll
        for (int mt = 0; mt < 4; ++mt) st0[mt] = mfma16(kf[mt][0], qf[0][0], negm0);
#pragma unroll
        for (int mt = 0; mt < 4; ++mt) st0[mt] = mfma16(kf[mt][1], qf[0][1], st0[mt]);
#pragma unroll
        for (int mt = 0; mt < 4; ++mt) st1[mt] = mfma16(kf[mt][0], qf[1][0], negm1);
#pragma unroll
        for (int mt = 0; mt < 4; ++mt) st1[mt] = mfma16(kf[mt][1], qf[1][1], st1[mt]); }
    __builtin_amdgcn_sched_barrier(0);
    bf16x8 p0, p1; bf16x8 vf[4][2];
#define NSA_SOFTMAX(st_, nq_, klo_, khi_, col_) do { \
        if constexpr (MODE == 1) nsa_softmax<MODE>(S, st_, nq_, klo_, khi_, col_, kb, PSrow, lr, lq, p0, p1); \
        else if (nsa_softmax_fast<MODE>(S, st_, nq_, klo_, khi_, kb, p0, p1)) {        \
            const float nn_ = (col_) ? -S.mhat[nq_] : NINF; const f32x4 ng_ = (f32x4){nn_, nn_, nn_, nn_}; \
            _Pragma("unroll") for (int mt = 0; mt < 4; ++mt) { const bf16x8 k0_ = *(const LAS bf16x8*)(kbuf + 4096 * (mt >> 1) + 512 * (mt & 1) + koff), k1_ = *(const LAS bf16x8*)(kbuf + 4096 * (mt >> 1) + 512 * (mt & 1) + (koff ^ 64)); \
                st_[mt] = mfma16(k0_, qf[nq_][0], ng_); st_[mt] = mfma16(k1_, qf[nq_][1], st_[mt]); } \
            nsa_softmax<MODE>(S, st_, nq_, klo_, khi_, col_, kb, PSrow, lr, lq, p0, p1); } } while (0)
    NSA_SOFTMAX(st0, 0, klo0, khi0, col0);
    if (MODE >= 1) {
        const LAS unsigned char* vbuf = kbuf + 8192;
#pragma unroll
        for (int ct = 0; ct < 4; ++ct)
#pragma unroll
            for (int kk = 0; kk < 2; ++kk) vf[ct][kk] = *(const LAS bf16x8*)(vbuf + 2048 * ct + (voff ^ (64 * kk)));
#pragma unroll
        for (int ct = 0; ct < 4; ++ct) { S.O[ct][0] = mfma16(vf[ct][0], p0, S.O[ct][0]); S.O[ct][0] = mfma16(vf[ct][1], p1, S.O[ct][0]); } }
    __builtin_amdgcn_sched_barrier(0);
    NSA_SOFTMAX(st1, 1, klo1, khi1, col1);
    if (MODE >= 1) {
#pragma unroll
        for (int ct = 0; ct < 4; ++ct) { S.O[ct][1] = mfma16(vf[ct][0], p0, S.O[ct][1]); S.O[ct][1] = mfma16(vf[ct][1], p1, S.O[ct][1]); } }
#undef NSA_SOFTMAX
}
#if defined(PROBE_T) && defined(PSEG)
#define PSEG_MARK(k) do { if ((k) == PSEG || (k) == PSEG + 1) { unsigned d_; asm volatile("s_waitcnt lgkmcnt(0)\n\ts_memrealtime s[90:91]\n\ts_waitcnt lgkmcnt(0)\n\ts_mov_b32 %0, s90" : "=s"(d_) :: "s90", "s91", "memory"); \
        if (threadIdx.x == 0) { volatile LAS unsigned* mw_ = (volatile LAS unsigned*)(lds + 131072); if ((k) == PSEG) mw_[21] = d_; else mw_[20] += d_ - mw_[21]; } } } while (0)
#else
#define PSEG_MARK(k) do { } while (0)
#endif
__device__ __forceinline__ void nsa_item2(const Args& A, LAS unsigned char* lds, int item) {
    const int tid = threadIdx.x, lane = tid & 63, w = tid >> 6, lr = lane & 15, lq = lane >> 4;
    const int qt = item >> 5, b = (item >> 2) & 7, g = item & 3, t0 = qt * 64, cur = qt;
    PSEG_MARK(0);
    const bf16* Qb = (const bf16*)(A.ws + WS_Q); const bf16* KV6 = (const bf16*)(A.ws + WS_KV6); const bf16* KC = (const bf16*)(A.ws + WS_KC); const bf16* VCT = (const bf16*)(A.ws + WS_VCT);
    const bf16* VTS = (const bf16*)(A.ws + WS_VTS); const bf16* VTW = (const bf16*)(A.ws + WS_VTW); const float* GT = (const float*)(A.ws + WS_GATES); bf16* ATT = (bf16*)(A.ws + WS_CAT);
    LAS float* PS = (LAS float*)(lds + 65536) + w * 2048;
    const int head = 4 * g + (lr & 3);
#define NSA_QPOS(nq_) (t0 + 8 * w + 4 * (nq_) + (lr >> 2))
    bf16x8 qf[2][2]; float gtv[2][3];
    const int ncv = ((t0 + 63 - 31) >> 4) + 1, ncmp = (ncv + 63) >> 6;
    const int lo = cur >= 8 ? cur - 8 : 0;
    const int n1 = ncmp, n2 = 2 * ncmp, n3 = n2 + cur + 1, n4 = n3 + (cur - lo + 1);
    const int srow = 8 * w + (lane >> 3), schv = (lane & 7) ^ ((srow >> 1) & 7), schk = (lane & 7) ^ (((srow & 3) >> 1) | (((srow >> 3) & 3) << 1));
    const bf16* kcb = KC + ((size_t)(b * 256) * 4 + g) * 64; const bf16* vcb = VCT + (size_t)((b * 4 + g) * 64) * 256;
    const bf16* ksb = KV6 + (size_t)b * SEQ * 1536 + 2 * 256 + g * 64; const bf16* kwb = ksb + 2 * 256;
    const bf16* vsb = VTS + (size_t)((b * 4 + g) * 64) * SEQ; const bf16* vwb = VTW + (size_t)((b * 4 + g) * 64) * SEQ;
    const unsigned sk16 = (unsigned)schk * 16u, sv16 = (unsigned)schv * 16u, srw = (unsigned)srow;
    const unsigned lds0 = (unsigned)(unsigned long)lds + (unsigned)w * 1024u;
#define NSA_GATE(nq_, i_) (gtv[nq_][i_])
#define NSA_GLDS(gp_, vo_, la_) do { unsigned keep_; asm volatile("s_mov_b32 %0, m0\n\ts_mov_b32 m0, %3\n\ts_nop 0\n\tglobal_load_lds_dwordx4 %1, %2\n\ts_mov_b32 m0, %0" : "=&s"(keep_) : "v"(vo_), "s"(gp_), "s"(la_) : "memory"); } while (0)
#define NSA_ISSUE(s_, slot_) do { const int s__ = (s_); const bf16* kp_; const bf16* vp_; unsigned ko_, vo_; \
        if (s__ < n2) { const int kt_ = s__ < n1 ? s__ : s__ - n1; kp_ = kcb + (size_t)(64 * kt_) * 256; vp_ = vcb + 64 * kt_; ko_ = srw * 512u + sk16; vo_ = srw * 512u + sv16; } \
        else if (s__ < n3) { const int kt_ = s__ - n2; kp_ = ksb + (size_t)(64 * kt_) * 1536; vp_ = vsb + 64 * kt_; ko_ = srw * 3072u + sk16; vo_ = srw * 8192u + sv16; } \
        else { const int kt_ = lo + s__ - n3; kp_ = kwb + (size_t)(64 * kt_) * 1536; vp_ = vwb + 64 * kt_; ko_ = srw * 3072u + sk16; vo_ = srw * 8192u + sv16; } \
        const unsigned la_ = (unsigned)__builtin_amdgcn_readfirstlane(lds0 + (unsigned)(slot_) * 16384u); NSA_GLDS(kp_, ko_, la_); NSA_GLDS(vp_, vo_, la_ + 8192u); } while (0)
#if defined(PROBE_T) && !defined(PSEG)
#ifndef PWSEL
#define PWSEL 2
#endif
#define PW_T0 "s_waitcnt lgkmcnt(0)\n\ts_memrealtime s[90:91]\n\ts_waitcnt lgkmcnt(0)\n\t"
#define PW_T1 "\n\ts_memrealtime s[92:93]\n\ts_waitcnt lgkmcnt(0)\n\ts_sub_u32 %0, s92, s90"
#define NSA_WAITBAR(N) do { unsigned d_; \
        if (PWSEL == 0) asm volatile(PW_T0 "s_waitcnt vmcnt(" #N ")" PW_T1 "\n\ts_barrier" : "=s"(d_) :: "s90", "s91", "s92", "s93", "memory"); \
        else if (PWSEL == 1) asm volatile("s_waitcnt vmcnt(" #N ")\n\t" PW_T0 "s_barrier" PW_T1 : "=s"(d_) :: "s90", "s91", "s92", "s93", "memory"); \
        else asm volatile(PW_T0 "s_waitcnt vmcnt(" #N ")\n\ts_barrier" PW_T1 : "=s"(d_) :: "s90", "s91", "s92", "s93", "memory"); if (tid == 0) ((volatile LAS unsigned*)(lds + 131072))[20] += d_; } while (0)
#else
#ifndef NSA_LAG
#define NSA_LAG 0
#endif
#define NSA_WAITBAR(N) do { asm volatile("s_waitcnt vmcnt(" #N ") lgkmcnt(0)\n\ts_barrier" ::: "memory"); if (NSA_LAG > 0 && w >= 4) __builtin_amdgcn_s_sleep(NSA_LAG); } while (0)
#endif
    NSA_ISSUE(0, 0); if (n1 >= 2) NSA_ISSUE(1, 1);
#pragma unroll
    for (int nq = 0; nq < 2; ++nq) { const size_t row = (size_t)b * SEQ + NSA_QPOS(nq);
#pragma unroll
        for (int ks = 0; ks < 2; ++ks) qf[nq][ks] = *(const bf16x8*)(Qb + row * 1024 + head * 64 + 32 * ks + 8 * lq);
#pragma unroll
        for (int i = 0; i < 3; ++i) gtv[nq][i] = GT[row * 48 + head * 3 + i]; }
#pragma unroll
    for (int i = 0; i < 8; ++i) *(LAS f32x4*)(PS + (i * 64 + lane) * 4) = (f32x4){0.f, 0.f, 0.f, 0.f};
    NsaSt S;
    LAS f32x4* OUTL = (LAS f32x4*)PS + lane;
#pragma unroll
    for (int nq = 0; nq < 2; ++nq) { S.mhat[nq] = 0.f; S.l[nq] = 0.f; S.invl[nq] = 0.f;
#pragma unroll
        for (int ct = 0; ct < 4; ++ct) S.O[ct][nq] = (f32x4){0.f, 0.f, 0.f, 0.f}; }
    unsigned long long mym[2] = {0ull, 0ull};
#pragma unroll
    for (int nq = 0; nq < 2; ++nq)
#pragma unroll
        for (int ks = 0; ks < 2; ++ks) asm volatile("" : "+v"(qf[nq][ks]));
#pragma unroll
    for (int nq = 0; nq < 2; ++nq)
#pragma unroll
        for (int i = 0; i < 3; ++i) asm volatile("" : "+v"(gtv[nq][i]));
    NSA_WAITBAR(0);
    const int xk = ((lr & 3) >> 1) | ((lr >> 2) << 1), xv = (lr >> 1) & 7;
    const int koff = (8 * (lr >> 2) + (lr & 3)) * 128 + ((lq ^ xk) << 4);
    const int voff = lr * 128 + ((lq ^ xv) << 4);
    const int wi0 = n3 + (cur >= 8 ? 1 : 0);
#define NSA_GSZ(t_) (((t_) >= n4) ? 0 : ((t_) < n1) ? (((t_) + 1 < n1) ? 2 : 1) : ((t_) < n2) ? (((t_) + 1 < n2) ? 2 : 1) : (((t_) < n3 - 1) ? (((t_) + 1 < n3 - 1) ? 2 : 1) : (((t_) >= wi0 && (t_) < n4 - 1) ? (((t_) + 1 < n4 - 1) ? 2 : 1) : 1)))
#define NSA_TILE(MODE_, s_, slot_, kt_, PSrow_) do { const int s__s = (s_), kt__ = (kt_); const LAS unsigned char* kbuf = lds + (slot_) * 16384; const int kb = 64 * kt__ + 8 * lq; \
        int klo0, klo1, khi0, khi1; bool col0 = true, col1 = true; { const int qp0 = NSA_QPOS(0), qp1 = NSA_QPOS(1); \
            if (MODE_ < 2) { klo0 = 0; klo1 = 0; khi0 = (qp0 >= 31) ? ((qp0 - 31) >> 4) : -1; khi1 = (qp1 >= 31) ? ((qp1 - 31) >> 4) : -1; } \
            else if (s__s < n3) { col0 = (mym[0] >> kt__) & 1ull; col1 = (mym[1] >> kt__) & 1ull; klo0 = 0; klo1 = 0; khi0 = qp0; khi1 = qp1; } \
            else { klo0 = qp0 - 511; klo1 = qp1 - 511; khi0 = qp0; khi1 = qp1; } } \
        nsa_full<MODE_>(S, qf, kbuf, koff, voff, klo0, klo1, khi0, khi1, col0, col1, kb, (PSrow_), lr, lq); } while (0)
#define NSA_NEXT(t_, z_) do { const int nt_ = (t_) + (z_), z2_ = NSA_GSZ(nt_); if (z2_ >= 1) NSA_ISSUE(nt_, 2 * (gp ^ 1)); if (z2_ >= 2) NSA_ISSUE(nt_ + 1, 2 * (gp ^ 1) + 1); } while (0)
#define NSA_STEP(MODE_, s_, kt_, PSrow_) do { PLACE_ASM(PLACE_N); NSA_NEXT((s_), 1); NSA_TILE(MODE_, (s_), 2 * gp, (kt_), (PSrow_)); NSA_WAITBAR(0); gp ^= 1; } while (0)
#define NSA_PAIR(MODE_, s_, kt_) do { PLACE_ASM(PLACE_N); NSA_NEXT((s_), 2); NSA_TILE(MODE_, (s_), 2 * gp, (kt_), PS + 64 * (kt_)); NSA_TILE(MODE_, (s_) + 1, 2 * gp + 1, (kt_) + 1, PS + 64 * ((kt_) + 1)); NSA_WAITBAR(0); gp ^= 1; } while (0)
    int gp = 0;
    PSEG_MARK(1);
    {   int s = 0; for (; s + 1 < n1; s += 2) NSA_PAIR(0, s, s);
        if (s < n1) NSA_STEP(0, s, s, PS); }
#pragma unroll
    for (int nq = 0; nq < 2; ++nq) { const float lf = colsum4(S.l[nq]); S.invl[nq] = lf > 0.f ? 1.f / lf : 0.f; }
    {   int s = n1; for (; s + 1 < n2; s += 2) NSA_PAIR(1, s, s - n1);
        if (s < n2) NSA_STEP(1, s, s - n1, PS + 64 * (s - n1)); }
    PSEG_MARK(2);
    {
        unsigned uk[8], pref[8];
#pragma unroll
        for (int qi = 0; qi < 8; ++qi) { const int j = lane, qp = t0 + 8 * w + qi; const LAS float* base = PS + qi * 256;
            float imp = base[4 * j] + base[4 * j + 1] + base[4 * j + 2] + 0.5f * base[4 * j + 3]; if (j > 0) imp += 0.5f * base[4 * j - 1];
            const bool forced = (j == 0) || (j == cur) || (j == cur - 1), causal = (64 * j <= qp);
            const float val = forced ? BIGF : (causal ? imp : NEGF);
            const unsigned ub = __float_as_uint(val); uk[qi] = (ub & 0x80000000u) ? ~ub : (ub | 0x80000000u); pref[qi] = 0u; }
#pragma unroll 1
        for (int bit = 31; bit >= 0; --bit) { const unsigned bm = 1u << bit; unsigned long long bal[8];
#pragma unroll
            for (int qi = 0; qi < 8; ++qi) bal[qi] = __ballot(uk[qi] >= (pref[qi] | bm));
#pragma unroll
            for (int qi = 0; qi < 8; ++qi) { unsigned cnt_; const unsigned cand = pref[qi] | bm;
                asm("s_bcnt1_i32_b64 %0, %2\n\ts_cmp_gt_u32 %0, 15\n\ts_cselect_b32 %1, %3, %1" : "=&s"(cnt_), "+s"(pref[qi]) : "s"(bal[qi]), "s"(cand) : "scc"); } }
#pragma unroll
        for (int qi = 0; qi < 8; ++qi) { const int j = lane;
            const unsigned long long gt = __ballot(uk[qi] > pref[qi]), eq = __ballot(uk[qi] == pref[qi]); const int need = 16 - __popcll(gt);
            const unsigned long long below = eq & ((1ull << j) - 1ull);
            const unsigned long long mk = gt | __ballot(uk[qi] == pref[qi] && __popcll(below) < need);
            if (qi == (lr >> 2)) mym[0] = mk; if (qi == 4 + (lr >> 2)) mym[1] = mk; }
#pragma unroll
        for (int nq = 0; nq < 2; ++nq) { S.mhat[nq] = 0.f; S.l[nq] = 0.f; const float g0 = NSA_GATE(nq, 0);
#pragma unroll
            for (int ct = 0; ct < 4; ++ct) { OUTL[(ct * 2 + nq) * 64] = S.O[ct][nq] * g0; S.O[ct][nq] = (f32x4){0.f, 0.f, 0.f, 0.f}; } }
    }
    PSEG_MARK(3);
    {   int s = n2; for (; s + 1 < n3 - 1; s += 2) NSA_PAIR(3, s, s - n2);
        if (s < n3 - 1) NSA_STEP(3, s, s - n2, PS); }
    NSA_STEP(2, n3 - 1, cur, PS);
#pragma unroll
    for (int nq = 0; nq < 2; ++nq) { const float lf = colsum4(S.l[nq]); const float sc = NSA_GATE(nq, 1) / lf; S.mhat[nq] = 0.f; S.l[nq] = 0.f;
#pragma unroll
        for (int ct = 0; ct < 4; ++ct) { OUTL[(ct * 2 + nq) * 64] += S.O[ct][nq] * sc; S.O[ct][nq] = (f32x4){0.f, 0.f, 0.f, 0.f}; } }
    PSEG_MARK(4);
    {   int s = n3; if (cur >= 8) { NSA_STEP(2, s, lo, PS); ++s; }
        for (; s + 1 < n4 - 1; s += 2) NSA_PAIR(3, s, lo + s - n3);
        if (s < n4 - 1) NSA_STEP(3, s, lo + s - n3, PS);
        NSA_STEP(2, n4 - 1, cur, PS); }
#undef NSA_STEP
#undef NSA_PAIR
#undef NSA_NEXT
#undef NSA_TILE
#undef NSA_GSZ
#undef NSA_ISSUE
#undef NSA_GLDS
#undef NSA_WAITBAR
    PSEG_MARK(5);
#pragma unroll
    for (int nq = 0; nq < 2; ++nq) { const float lf = colsum4(S.l[nq]); const float sc = NSA_GATE(nq, 2) / lf; bf16* op = ATT + ((size_t)b * SEQ + NSA_QPOS(nq)) * 1024 + head * 64 + 4 * lq;
#pragma unroll
        for (int ct = 0; ct < 4; ++ct) { const f32x4 o = OUTL[(ct * 2 + nq) * 64] + S.O[ct][nq] * sc; v2u pk; pk.x = pk2(o[0], o[1]); pk.y = pk2(o[2], o[3]); *(v2u*)(op + 16 * ct) = pk; } }
#undef NSA_GATE
#undef NSA_QPOS
    PSEG_MARK(6);
}
#define XB_TMO      128
#define XB_XCNT(j)  (256  + 64 * (j))
#define XB_XSUB(j)  (1280 + 64 * (j))
#define XB_XGEN(j)  (2304 + 64 * (j))
#define XB_TOP      3328
#define XB_TOPGEN   3392
#define XCD_BAR_WORDS 3456
#define XB_SPIN_CAP (1u << 18)

__device__ __forceinline__ unsigned xb_ld(unsigned* p)              { return __hip_atomic_load(p, __ATOMIC_RELAXED, __HIP_MEMORY_SCOPE_AGENT); }
__device__ __forceinline__ unsigned xb_add(unsigned* p, unsigned v) { return __hip_atomic_fetch_add(p, v, __ATOMIC_RELAXED, __HIP_MEMORY_SCOPE_AGENT); }
__device__ __forceinline__ unsigned xb_xcc_id() { return (unsigned)__builtin_amdgcn_s_getreg((3 << 11) | 20) & 0xFu; }
#define XB_SPIN(cond, bar) do { unsigned _sp = 0; while (cond) { __builtin_amdgcn_s_sleep(1); \
    if ((++_sp & 255u) == 0u) { if (xb_ld(&(bar)[XB_TMO])) break; if (_sp > XB_SPIN_CAP) { atomicAdd(&(bar)[XB_TMO], 1u); break; } } } } while (0)

struct XcdBarrier {
    unsigned* bar; unsigned x;
    volatile LAS unsigned* st;
};

__device__ __forceinline__ XcdBarrier xcd_barrier_post(unsigned* bar, volatile LAS unsigned* st) {
    XcdBarrier b; b.bar = bar; b.x = xb_xcc_id(); b.st = st;
    if (threadIdx.x == 0) (void)xb_add(&bar[XB_XCNT(b.x)], 1u);
    return b;
}
__device__ __forceinline__ void xcd_barrier_complete(unsigned* bar, unsigned x, unsigned& nloc, unsigned& nx) {
    const unsigned G = gridDim.x * gridDim.y * gridDim.z;
    unsigned sum, cnt, mine, sp = 0u;
    for (;;) {
        sum = 0u; cnt = 0u; mine = 0u;
#pragma unroll
        for (unsigned j = 0; j < 16; ++j) { const unsigned c = xb_ld(&bar[XB_XCNT(j)]); sum += c; cnt += (c > 0u) ? 1u : 0u; mine = (j == x) ? c : mine; }
        if (sum == G) break;
        __builtin_amdgcn_s_sleep(1);
        if ((++sp & 255u) == 0u) { if (xb_ld(&bar[XB_TMO])) break; if (sp > XB_SPIN_CAP) { atomicAdd(&bar[XB_TMO], 1u); break; } }
    }
    nloc = mine > 0u ? mine : 1u; nx = cnt > 0u ? cnt : 1u;
}

__device__ __forceinline__ void xcd_barrier(const XcdBarrier& b) {
    asm volatile("s_waitcnt vmcnt(0)" ::: "memory");
    __syncthreads();
    if (threadIdx.x == 0) {
        unsigned* bar = b.bar;
        __builtin_amdgcn_s_waitcnt(0);
        unsigned nloc = b.st[0], nx = b.st[1];
        if (nloc == 0u) { xcd_barrier_complete(bar, b.x, nloc, nx); b.st[0] = nloc; b.st[1] = nx; }
        const unsigned old = xb_add(&bar[XB_XSUB(b.x)], 1u);
        const unsigned gen = old / nloc;
        if (old + 1u == (gen + 1u) * nloc) {
            __builtin_amdgcn_fence(__ATOMIC_RELEASE, "agent");
            asm volatile("s_waitcnt vmcnt(0)" ::: "memory");
            const unsigned og = xb_add(&bar[XB_TOP], 1u);
            const unsigned tg = og / nx;
            if (og + 1u == (tg + 1u) * nx) xb_add(&bar[XB_TOPGEN], 1u);
            else XB_SPIN(xb_ld(&bar[XB_TOPGEN]) == tg, bar);
            __builtin_amdgcn_fence(__ATOMIC_ACQUIRE, "agent");
            xb_add(&bar[XB_XGEN(b.x)], 1u);
            asm volatile("s_waitcnt vmcnt(0)" ::: "memory");
        } else {
            XB_SPIN(xb_ld(&bar[XB_XGEN(b.x)]) == gen, bar);
            __builtin_amdgcn_fence(__ATOMIC_ACQUIRE, "agent");
            asm volatile("s_waitcnt vmcnt(0)" ::: "memory");
        }
    }
    __syncthreads();
}
constexpr int LDS_BYTES = 147456;
constexpr int NPHASES = 14;
#ifndef PHMASK
#define PHMASK 0x3fff
#endif
#ifndef PHREP
#define PHREP 0
#endif
#ifndef RES_ALIGN
#define RES_ALIGN true
#endif
#ifndef MK_SINGLE
#define MK_SINGLE 1
#endif

constexpr int RS_OFF = 131072 + 256;
__device__ __forceinline__ void rs_table(LAS unsigned char* lds, const float* SS, int N) {
    pg8::StaticOrder S; S.init(MROWS, N, (int)gridDim.x, (int)blockIdx.x); LAS float* RS = (LAS float*)(lds + RS_OFF); pg8::Unit u;
    for (int idx = threadIdx.x; ; idx += NTHREADS) { const int ui = idx >> 8; if (ui >= 11 || !S.next(ui, u)) break; RS[idx] = pg8::row_rs_g(SS, u.pm * 256 + (idx & 255)); }
    __syncthreads();
}
template <class Epi, bool ALIGN = true> __device__ __forceinline__ void run_gemm(LAS unsigned char* lds, const bf16* Aop, const bf16* Bt, int N, int K, const Epi& E) {
    pg8::Gemm g{Aop, Bt, MROWS, N, K}; pg8::StaticOrder S; S.init(MROWS, N, (int)gridDim.x, (int)blockIdx.x);
    pg8::gemm_phase<Epi, pg8::StaticOrder, ALIGN, true>(lds, g, S, E);
}

__global__ void __launch_bounds__(NTHREADS, 2) mk_fwd(Args args) {
    extern __shared__ __attribute__((aligned(16))) unsigned char lds_raw[];
    LAS unsigned char* lds = (LAS unsigned char*)lds_raw;
    cg::grid_group grid = cg::this_grid();
    volatile LAS unsigned* MISC = (volatile LAS unsigned*)(lds + 131072);
    if (threadIdx.x < 32) MISC[threadIdx.x] = 0u;
    __syncthreads();
    XcdBarrier xbar = xcd_barrier_post((unsigned*)(args.ws + WS_CTL) + 4096, MISC + 8);
    const int tid = threadIdx.x, lane = tid & 63, wave = __builtin_amdgcn_readfirstlane(tid >> 6);
    const int gw = blockIdx.x * NWAVES + wave, NGW = gridDim.x * NWAVES;
    unsigned char* ws = args.ws;
    const int lo = args.ph_lo, hi = args.ph_hi;
#ifdef PROBE_T
#define PQ(x, q) (floorf((x) / (q) + 0.5f) * (q))
#define PT_STAMP(arr, k) do { if (blockIdx.x == PROBE_BLK && threadIdx.x == 0) { unsigned long long t_; asm volatile("s_memrealtime %0\n\ts_waitcnt lgkmcnt(0)" : "=s"(t_) :: "memory"); arr[k] = t_; } } while (0)
#define PT_MID(i) do { __syncthreads(); PT_STAMP(g_tm, i); } while (0)
#define PH_BEGIN(k) if (lo <= (k) && (k) < hi) { constexpr int phk_ = (k); if ((k) > lo) { if ((k) == lo + 1) grid.sync(); else xcd_barrier(xbar); } if (threadIdx.x == 0) MISC[16] = (k); PT_STAMP(g_ts, phk_); { __syncthreads(); if constexpr ((PHMASK >> (k)) & 1) {
#define PH_END } __syncthreads(); PT_STAMP(g_te, phk_); if (phk_ == 9 && blockIdx.x == PROBE_BLK && threadIdx.x == 0) g_pr[9 * 8 + 5] = (float)MISC[20] * 0.01f; }}
#else
#define PT_MID(i) do { } while (0)
#define PH_BEGIN(k) if (lo <= (k) && (k) < hi) { if ((k) > lo) { if ((k) == lo + 1) grid.sync(); else xcd_barrier(xbar); } for (int rep_ = 0; rep_ < ((((PHREP) >> (k)) & 1) ? 2 : 1); ++rep_) { __syncthreads(); if constexpr ((PHMASK >> (k)) & 1) {
#define PH_END }}}
#endif
    float* const SS = (float*)(ws + WS_SS); constexpr size_t SSN = (size_t)MROWS * 16;
    bf16* const XN = (bf16*)(ws + WS_XN);
    PH_BEGIN(0) p0_prologue(args, lds, wave, lane); PH_END
    const LAS float* RSL = (const LAS float*)(lds + RS_OFF);
    PH_BEGIN(1) { rs_table(lds, SS, AB_IN); pg8::EpiProj0 E{(bf16*)(ws + WS_PROJ0), (const float*)(ws + TAB_RCOS), (const float*)(ws + TAB_RSIN), RSL};
                  run_gemm(lds, XN, (const bf16*)(ws + W_ABIN), AB_IN, 1024, E); } PH_END
    PH_BEGIN(2) { ret_kv_run(args, lds, (int)blockIdx.x, (int)gridDim.x, 2048); } PH_END
    PH_BEGIN(3) {
                  for (int it = blockIdx.x; it < 1024; it += gridDim.x) lru_chain_item(args, lds, it);
                  PT_MID(1);
                  const int per = (2048 + (int)gridDim.x - 1) / (int)gridDim.x, i0 = (int)blockIdx.x * per;
                  const int i1 = (i0 + per < 2048) ? i0 + per : 2048;
                  if (i0 < i1) { RetPre R; ret_out_pre(args, i0, true, R);
                      for (int it = i0; it < i1; ++it) { const int nx = (it + 1 < i1) ? it + 1 : -1; ret_out_item(args, lds, it, it == i0 || (it & 31) == 0, R, nx, nx >= 0 && (nx & 31) == 0); } } } PH_END
    PH_BEGIN(4) { pg8::EpiResidB<false> E{XN, nullptr, XN, SS + SSN}; run_gemm<pg8::EpiResidB<false>, RES_ALIGN>(lds, (const bf16*)(ws + WS_CAT), (const bf16*)(ws + W_ABOUT), 1024, 1024, E); } PH_END
    PH_BEGIN(5) { rs_table(lds, SS + SSN, 2 * FFH); pg8::EpiFfnUp E{(bf16*)(ws + WS_ACT), FFH, RSL}; run_gemm(lds, XN, (const bf16*)(ws + W_F13), 2 * FFH, 1024, E); } PH_END
    PH_BEGIN(6) { pg8::EpiResidB<false> E{XN, nullptr, XN, SS + 2 * SSN}; run_gemm<pg8::EpiResidB<false>, RES_ALIGN>(lds, (const bf16*)(ws + WS_ACT), (const bf16*)(ws + W_F2), 1024, FFH, E); } PH_END
    PH_BEGIN(7) { rs_table(lds, SS + 2 * SSN, NSA_INP); pg8::EpiNsaIn E{(bf16*)(ws + WS_Q), (bf16*)(ws + WS_KV6), (float*)(ws + WS_GATES), (bf16*)(ws + WS_VTS), (bf16*)(ws + WS_VTW), (const float*)(ws + TAB_NCOS), (const float*)(ws + TAB_NSIN), RSL};
                  run_gemm(lds, XN, (const bf16*)(ws + W_NSAIN), NSA_INP, 1024, E); } PH_END
    PH_BEGIN(8) { cmp_bias_to_lds(args, lds); for (int it = blockIdx.x; it < 256; it += gridDim.x) cmp_item(args, lds, it); } PH_END
    PH_BEGIN(9) { if (gridDim.x == 256) {
                      const int grp = (int)blockIdx.x >> 5, bg = (int)blockIdx.x & 31;
                      for (int i = 0; i < 8; ++i) { const int qt = (i & 1) ? 8 * i + 7 - grp : 8 * i + grp; nsa_item2(args, lds, qt * 32 + bg); } }
                  else for (int it = blockIdx.x; it < 2048; it += gridDim.x) nsa_item2(args, lds, it); } PH_END
    PH_BEGIN(10) { pg8::EpiResidB<false> E{XN, nullptr, XN, SS + 3 * SSN}; run_gemm<pg8::EpiResidB<false>, RES_ALIGN>(lds, (const bf16*)(ws + WS_CAT), (const bf16*)(ws + W_NSAOUT), 1024, 1024, E); } PH_END
    PH_BEGIN(11) { rs_table(lds, SS + 3 * SSN, 2 * FFH); pg8::EpiFfnUp E{(bf16*)(ws + WS_ACT), FFH, RSL}; run_gemm(lds, XN, (const bf16*)(ws + W_F13) + (size_t)2 * FFH * 1024, 2 * FFH, 1024, E); } PH_END
    PH_BEGIN(12) { pg8::EpiResidB<false> E{XN, nullptr, XN, SS + 4 * SSN}; run_gemm<pg8::EpiResidB<false>, RES_ALIGN>(lds, (const bf16*)(ws + WS_ACT), (const bf16*)(ws + W_F2) + (size_t)1024 * FFH, 1024, FFH, E); } PH_END
    PH_BEGIN(13) final_norm_phase_b(XN, args.out, args.in[I_FINAL_NORM], gw, NGW, lane); PH_END
#ifdef PROBE_T
    xcd_barrier(xbar);
    if (blockIdx.x == PROBE_BLK) { const float pa = (PROBE_A), pb = (PROBE_B); if (tid == 0) args.out[0] += pa; if (tid == 0) args.out[8192] += pb; }
#endif
}

extern "C" void kernel_launch(void* const* d_in, const int* in_sizes, int n_in, void* d_out, int out_size, void* d_ws, size_t ws_size, hipStream_t stream) {
    static int grid = 0;
    if (grid == 0) {
        if (n_in != 24 || out_size != MROWS * DM || ws_size < WS_END) { fprintf(stderr, "kernel_launch: unexpected shapes (n_in %d out %d ws %zu)\n", n_in, out_size, ws_size); grid = -1; return; }
        int dev = 0, cus = 0, per_cu = 0;
        if (hipGetDevice(&dev) != hipSuccess || hipDeviceGetAttribute(&cus, hipDeviceAttributeMultiprocessorCount, dev) != hipSuccess) { grid = -1; return; }
        if (hipFuncSetAttribute((const void*)mk_fwd, hipFuncAttributeMaxDynamicSharedMemorySize, LDS_BYTES) != hipSuccess) { fprintf(stderr, "kernel_launch: hipFuncSetAttribute failed\n"); grid = -1; return; }
        if (hipOccupancyMaxActiveBlocksPerMultiprocessor(&per_cu, (const void*)mk_fwd, NTHREADS, LDS_BYTES) != hipSuccess || per_cu < 1) { fprintf(stderr, "kernel_launch: occupancy query says %d\n", per_cu); per_cu = 1; }
        (void)hipGetLastError();
        grid = cus;
    }
    if (grid < 0) return;
    if (hipMemsetAsync((char*)d_ws + WS_CTL, 0, 65536, stream) != hipSuccess || hipMemsetAsync((char*)d_ws + WS_CTL + 65536, 0xFF, 1024 * 64 * 8 + 256 * 64 * 8, stream) != hipSuccess) { fprintf(stderr, "kernel_launch: memset failed\n"); return; }
    Args a{};
    for (int i = 0; i < 24; ++i) a.in[i] = (const float*)d_in[i];
    a.out = (float*)d_out; a.ws = (unsigned char*)d_ws;
#if MK_SINGLE
    a.ph_lo = 0; a.ph_hi = NPHASES;
    void* kargs[] = {&a};
    hipError_t e = hipLaunchCooperativeKernel((const void*)mk_fwd, dim3(grid), dim3(NTHREADS), kargs, LDS_BYTES, stream);
    if (e != hipSuccess) fprintf(stderr, "kernel_launch: cooperative launch failed: %s (grid %d)\n", hipGetErrorString(e), grid);
#else
    for (int ph = 0; ph < NPHASES; ++ph) { a.ph_lo = ph; a.ph_hi = ph + 1; hipLaunchKernelGGL(mk_fwd, dim3(grid), dim3(NTHREADS), LDS_BYTES, stream, a); }
#endif
}
```

```cpp
#ifndef PLACE_G
#define PLACE_G 0
#endif
#ifndef PLACE_N
#define PLACE_N 0
#endif
#ifndef PLACE_B
#define PLACE_B 0
#endif
#ifndef PLACE_M
#define PLACE_M 0
#endif
#if PLACE_M
#define PLACE_MMA asm volatile(".p2align 3")
#else
#define PLACE_MMA do { } while (0)
#endif
#ifndef PLACE_P2
#define PLACE_P2 "3"
#endif
#define PLACE_ASM(k_) do { if ((k_) == 0) asm volatile(".p2align " PLACE_P2); else asm volatile(".p2align " PLACE_P2 "\n\ts_nop 0"); } while (0)
#include <hip/hip_runtime.h>
#include <hip/hip_cooperative_groups.h>
#include <cstdio>
#include <cstdint>
namespace cg = cooperative_groups;
#ifdef PROBE_T
#ifndef PROBE_BLK
#define PROBE_BLK 0
#endif
#ifndef PROBE_TID
#define PROBE_TID 0
#endif
__device__ float g_pr[16 * 8];
__device__ unsigned long long g_ts[16], g_te[16], g_tm[4];
#endif
namespace pg8 {
#define PG8_LAS __attribute__((address_space(3)))
typedef unsigned short bf16_t;
typedef short bf16x8 __attribute__((ext_vector_type(8)));
typedef float f32x4 __attribute__((ext_vector_type(4)));
typedef unsigned u32x4 __attribute__((ext_vector_type(4)));
constexpr int BM = 256, BK = 64, HALF = 128, HTB = HALF * BK * 2  , STAGE_BYTES = 8 * HTB, NXCD = 8, WGM = 8;

__host__ __device__ __forceinline__ int lds_byte(int r, int c) { const int st = (r >> 4) * 2 + (c >> 5), rr = r & 15, cc = c & 31, ob = rr * 64 + cc * 2; return st * 1024 + (ob ^ (((ob >> 9) & 1) << 5)); }
__host__ __device__ __forceinline__ void stage_rc(int b, int& R, int& C) { const int st = b / 1024, sb = b % 1024, swz = sb ^ (((sb >> 9) & 1) << 5); R = (st >> 1) * 16 + swz / 64; C = (st & 1) * 32 + (swz % 64) / 2; }
__host__ __device__ __forceinline__ int perm32(int rho) { const int n = rho >> 4, i = rho & 15; return 8 * (i >> 2) + 4 * n + (i & 3); }

struct Unit { int pm, pn, ui; };
struct Gemm { const bf16_t* A; const bf16_t* Bt; int M, N, K; };

struct StaticOrder {
    int nM, nN, nwg, G, c;
    __host__ __device__ void init(int M, int N, int G_, int c_) { nM = M / BM; nN = N / BM; nwg = nM * nN; G = G_; c = c_; }
    __host__ __device__ bool next(int i, Unit& u) const {
        const long L = (long)i * G + c; if (L >= nwg) return false;
        int wgid = (int)L; { const int q = nwg / NXCD, r = nwg % NXCD, xcd = wgid % NXCD, off = wgid / NXCD; wgid = (xcd < r ? xcd * (q + 1) : r * (q + 1) + (xcd - r) * q) + off; }
        const int nig = WGM * nN, gid = wgid / nig, fm = gid * WGM, gsz = (nM - fm) < WGM ? (nM - fm) : WGM;
        u.pm = fm + ((wgid % nig) % gsz); u.pn = (wgid % nig) / gsz; u.ui = i; return true;
    }
    __device__ __forceinline__ void a_ready(const Unit&) const {}
    __device__ __forceinline__ void done(const Unit&) const {}
};

__device__ __forceinline__ unsigned cvt_pk_bf16(float lo, float hi) { unsigned r; asm volatile("v_cvt_pk_bf16_f32 %0, %1, %2" : "=v"(r) : "v"(lo), "v"(hi)); return r; }
typedef unsigned u32x2 __attribute__((ext_vector_type(2)));
__device__ __forceinline__ float sigmoid_f(float x) { return __builtin_amdgcn_rcpf(1.f + __builtin_amdgcn_exp2f(-1.4426950408889634f * x)); }
__device__ __forceinline__ float silu_f(float x) { return x * __builtin_amdgcn_rcpf(1.f + __builtin_amdgcn_exp2f(-1.4426950408889634f * x)); }
__device__ __forceinline__ u32x4 pack8(const f32x4 a, const f32x4 b) { u32x4 w; w.x = cvt_pk_bf16(a[0], a[1]); w.y = cvt_pk_bf16(a[2], a[3]); w.z = cvt_pk_bf16(b[0], b[1]); w.w = cvt_pk_bf16(b[2], b[3]); return w; }
__device__ __forceinline__ u32x2 pack4(const f32x4 a) { u32x2 w; w.x = cvt_pk_bf16(a[0], a[1]); w.y = cvt_pk_bf16(a[2], a[3]); return w; }

__device__ __forceinline__ float row_rs_g(const float* SS, int row) { const f32x4* p = (const f32x4*)(SS + (size_t)row * 16); const f32x4 a = p[0], b = p[1], c = p[2], d = p[3];
    const float t = ((a[0] + a[1]) + (a[2] + a[3])) + ((b[0] + b[1]) + (b[2] + b[3])) + ((c[0] + c[1]) + (c[2] + c[3])) + ((d[0] + d[1]) + (d[2] + d[3])); return 1.f / sqrtf(t * (1.f / 1024.f) + 1e-6f); }
struct EpiProj0 {
    static constexpr bool PERM = true, AFTER_DRAIN = false;
    bf16_t* P; const float* cosT; const float* sinT; const PG8_LAS float* RS;
    __device__ __forceinline__ void operator()(const f32x4 (&acc)[2][2][4][2], const Unit& u, int wr, int wc, int fr, int fq) const {
        const int row0 = u.pm * BM + wr * 64 + fr, colt = u.pn * BM + wc * 32 + 8 * fq;
        const bool rot = (u.pn >= 4 && u.pn < 8); const float sc = (u.pn >= 6 && u.pn < 8) ? 0.125f : 1.f;
#pragma unroll
        for (int ai = 0; ai < 2; ++ai)
#pragma unroll
            for (int m = 0; m < 4; ++m) { const int row = row0 + ai * HALF + m * 16, pos = row & 4095; bf16_t* rowp = P + (size_t)row * 3072; const float rs = RS[u.ui * 256 + (row & 255)];
#pragma unroll
                for (int bj = 0; bj < 2; ++bj) { const int col = colt + bj * HALF; const f32x4 v0 = acc[ai][bj][m][0] * rs, v1 = acc[ai][bj][m][1] * rs;
                    if (rot) { const int hc = col & 63, gi = hc >> 3, hb = col - hc;
                        const f32x4 c = *(const f32x4*)(cosT + pos * 32 + 4 * gi), s = *(const f32x4*)(sinT + pos * 32 + 4 * gi);
                        const f32x4 o1 = (v0 * c - v1 * s) * sc, o2 = (v1 * c + v0 * s) * sc;
                        *(u32x2*)(rowp + hb + 4 * gi) = pack4(o1); *(u32x2*)(rowp + hb + 32 + 4 * gi) = pack4(o2);
                    } else { *(u32x4*)(rowp + col) = pack8(v0, v1); } } }
    }
};
struct EpiNsaIn {
    static constexpr bool PERM = true, AFTER_DRAIN = false;
    bf16_t* Q; bf16_t* KV; float* G; bf16_t* VTS; bf16_t* VTW; const float* cosT; const float* sinT; const PG8_LAS float* RS;
    __device__ __forceinline__ void operator()(const f32x4 (&acc)[2][2][4][2], const Unit& u, int wr, int wc, int fr, int fq) const {
        const int row0 = u.pm * BM + wr * 64 + fr, pn = u.pn;
#pragma unroll
        for (int ai = 0; ai < 2; ++ai)
#pragma unroll
            for (int m = 0; m < 4; ++m) { const int row = row0 + ai * HALF + m * 16, pos = row & 4095; const float rs = RS[u.ui * 256 + (row & 255)];
#pragma unroll
                for (int bj = 0; bj < 2; ++bj) { const int lc = bj * HALF + wc * 32 + 8 * fq; const f32x4 v0 = acc[ai][bj][m][0] * rs, v1 = acc[ai][bj][m][1] * rs;
                    if (pn < 10) {
                        bf16_t* dst; bool rot; float sc;
                        if (pn < 4) { dst = Q + (size_t)row * 1024 + pn * 256 + lc; rot = true; sc = 0.125f * 1.4426950408889634f; }
                        else { const int j = pn - 4;
                            if (j == 3 || j == 5) {
                                bf16_t* vt = (j == 3 ? VTS : VTW) + ((size_t)((row >> 12) * 4 + (lc >> 6)) * 64 + (lc & 63)) * 4096 + pos; const u32x4 w8 = pack8(v0, v1); const unsigned wv[4] = {w8.x, w8.y, w8.z, w8.w};
#pragma unroll
                                for (int i = 0; i < 4; ++i) { vt[(size_t)(2 * i) * 4096] = (bf16_t)(wv[i] & 0xffffu); vt[(size_t)(2 * i + 1) * 4096] = (bf16_t)(wv[i] >> 16); }
                                continue; }
                            dst = KV + (size_t)row * 1536 + j * 256 + lc; rot = (j == 2 || j == 4); sc = 1.f; }
                        const int hc = lc & 63;
                        if (rot && hc < 16) { const int gi = hc >> 3;
                            const f32x4 c = *(const f32x4*)(cosT + pos * 8 + 4 * gi), s = *(const f32x4*)(sinT + pos * 8 + 4 * gi);
                            const f32x4 o1 = (v0 * c - v1 * s) * sc, o2 = (v1 * c + v0 * s) * sc;
                            bf16_t* hbp = dst - hc; *(u32x2*)(hbp + 4 * gi) = pack4(o1); *(u32x2*)(hbp + 8 + 4 * gi) = pack4(o2);
                        } else { *(u32x4*)dst = pack8(v0 * sc, v1 * sc); }
                    } else if (lc < 48) {
                        float* gp = G + (size_t)row * 48 + lc; f32x4 a, b;
#pragma unroll
                        for (int i = 0; i < 4; ++i) { a[i] = sigmoid_f(v0[i]); b[i] = sigmoid_f(v1[i]); }
                        *(f32x4*)gp = a; *(f32x4*)(gp + 4) = b; } } }
    }
};
struct EpiFfnUp {
    static constexpr bool PERM = true, AFTER_DRAIN = false;
    bf16_t* ACT; int ld; const PG8_LAS float* RS;
    __device__ __forceinline__ void operator()(const f32x4 (&acc)[2][2][4][2], const Unit& u, int wr, int wc, int fr, int fq) const {
        const int row0 = u.pm * BM + wr * 64 + fr, col = u.pn * 128 + wc * 32 + 8 * fq;
#pragma unroll
        for (int ai = 0; ai < 2; ++ai)
#pragma unroll
            for (int m = 0; m < 4; ++m) { const int row = row0 + ai * HALF + m * 16; f32x4 h0, h1; const float rs = RS[u.ui * 256 + (row & 255)];
#pragma unroll
                for (int i = 0; i < 4; ++i) { h0[i] = silu_f(acc[ai][0][m][0][i] * rs) * (acc[ai][1][m][0][i] * rs); h1[i] = silu_f(acc[ai][0][m][1][i] * rs) * (acc[ai][1][m][1][i] * rs); }
                *(u32x4*)(ACT + (size_t)row * ld + col) = pack8(h0, h1); }
    }
};
struct EpiResid {
    static constexpr bool PERM = true, AFTER_DRAIN = false;
    const float* base; float* out; bf16_t* HB; float* SS;
    __device__ __forceinline__ void operator()(const f32x4 (&acc)[2][2][4][2], const Unit& u, int wr, int wc, int fr, int fq) const {
        const int row0 = u.pm * BM + wr * 64 + fr, col0 = u.pn * BM + wc * 32 + 8 * fq;
#pragma unroll
        for (int ai = 0; ai < 2; ++ai) {
            f32x4 pre[4][2][2];
#pragma unroll
            for (int m = 0; m < 4; ++m) { const size_t off = (size_t)(row0 + ai * HALF + m * 16) * 1024 + col0;
#pragma unroll
                for (int bj = 0; bj < 2; ++bj) { pre[m][bj][0] = *(const f32x4*)(base + off + bj * HALF); pre[m][bj][1] = *(const f32x4*)(base + off + bj * HALF + 4); } }
            asm volatile("" ::: "memory");
#pragma unroll
            for (int m = 0; m < 4; ++m) { const int row = row0 + ai * HALF + m * 16; const size_t off = (size_t)row * 1024 + col0; float ssq = 0.f;
#pragma unroll
                for (int bj = 0; bj < 2; ++bj) { const size_t o = off + bj * HALF; const f32x4 v0 = pre[m][bj][0] + acc[ai][bj][m][0], v1 = pre[m][bj][1] + acc[ai][bj][m][1];
                    if (out) { *(f32x4*)(out + o) = v0; *(f32x4*)(out + o + 4) = v1; }
                    if (HB) { *(u32x4*)(HB + o) = pack8(v0, v1); ssq += ((v0[0] * v0[0] + v0[1] * v0[1]) + (v0[2] * v0[2] + v0[3] * v0[3])) + ((v1[0] * v1[0] + v1[1] * v1[1]) + (v1[2] * v1[2] + v1[3] * v1[3])); } }
                if (HB) { ssq += __shfl_xor(ssq, 16); ssq += __shfl_xor(ssq, 32); if (fq == 0) SS[(size_t)row * 16 + u.pn * 4 + wc] = ssq; } }
            asm volatile("" ::: "memory");
        }
    }
};
template <bool OUT_F32> struct EpiResidB {
    static constexpr bool PERM = true, AFTER_DRAIN = false;
    const bf16_t* base; float* out; bf16_t* HB; float* SS;
    __device__ __forceinline__ void operator()(const f32x4 (&acc)[2][2][4][2], const Unit& u, int wr, int wc, int fr, int fq) const {
        const int row0 = u.pm * BM + wr * 64 + fr, col0 = u.pn * BM + wc * 32 + 8 * fq;
        u32x4 pre[2][4][2];
#pragma unroll
        for (int ai = 0; ai < 2; ++ai)
#pragma unroll
            for (int m = 0; m < 4; ++m) { const size_t off = (size_t)(row0 + ai * HALF + m * 16) * 1024 + col0;
#pragma unroll
                for (int bj = 0; bj < 2; ++bj) pre[ai][m][bj] = *(const u32x4*)(base + off + bj * HALF); }
        asm volatile("" ::: "memory");
#pragma unroll
        for (int ai = 0; ai < 2; ++ai)
#pragma unroll
            for (int m = 0; m < 4; ++m) { const int row = row0 + ai * HALF + m * 16; const size_t off = (size_t)row * 1024 + col0; float ssq = 0.f;
#pragma unroll
                for (int bj = 0; bj < 2; ++bj) { const size_t o = off + bj * HALF; const u32x4 w = pre[ai][m][bj];
                    const f32x4 b0 = {__uint_as_float(w.x << 16), __uint_as_float(w.x & 0xffff0000u), __uint_as_float(w.y << 16), __uint_as_float(w.y & 0xffff0000u)};
                    const f32x4 b1 = {__uint_as_float(w.z << 16), __uint_as_float(w.z & 0xffff0000u), __uint_as_float(w.w << 16), __uint_as_float(w.w & 0xffff0000u)};
                    const f32x4 v0 = b0 + acc[ai][bj][m][0], v1 = b1 + acc[ai][bj][m][1];
                    if constexpr (OUT_F32) { *(f32x4*)(out + o) = v0; *(f32x4*)(out + o + 4) = v1; }
                    else { *(u32x4*)(HB + o) = pack8(v0, v1); ssq += ((v0[0] * v0[0] + v0[1] * v0[1]) + (v0[2] * v0[2] + v0[3] * v0[3])) + ((v1[0] * v1[0] + v1[1] * v1[1]) + (v1[2] * v1[2] + v1[3] * v1[3])); } }
                if constexpr (!OUT_F32) { ssq += __shfl_xor(ssq, 16); ssq += __shfl_xor(ssq, 32); if (fq == 0) SS[(size_t)row * 16 + u.pn * 4 + wc] = ssq; } }
        asm volatile("" ::: "memory");
    }
};
template <class Epi, class Sched, bool ALIGN_EPI = false, bool SP2 = false>
__device__ __forceinline__ void gemm_phase(PG8_LAS unsigned char* lds, const Gemm g, const Sched& S, const Epi& E) {
    const int tid = threadIdx.x, wid = __builtin_amdgcn_readfirstlane(tid >> 6), lane = tid & 63, wr = wid >> 2, wc = wid & 3, fr = lane & 15, fq = lane >> 4;
    const int K = g.K, nt = K / BK;
    unsigned voffA[2], voffB[2];
#pragma unroll
    for (int i = 0; i < 2; ++i) { int R, C; stage_rc(tid * 16 + i * 8192, R, C); const int Rb = Epi::PERM ? ((R & ~31) + perm32(R & 31)) : R;
        voffA[i] = (unsigned)(R * K + C) * 2u; voffB[i] = (unsigned)(Rb * K + C) * 2u; }
    const size_t kstep = (size_t)(BK * 2);
    const size_t hstep = (size_t)HALF * K * 2;
    const size_t tstep = 2 * hstep;
    const unsigned ldsw = (unsigned)wid * 1024u;
    const int aoff = lds_byte(wr * 64 + fr, fq * 8), boff = lds_byte(wc * 32 + fr, fq * 8);
#define PG8_SA(b, h) (((b) * 2 + (h)) * HTB)
#define PG8_SB(b, h) ((4 + (b) * 2 + (h)) * HTB)
#define PG8_STAGE(bufoff, gbase, voff) do { _Pragma("unroll") for (int _i = 0; _i < 2; ++_i) \
        __builtin_amdgcn_global_load_lds((const unsigned*)((const char*)(gbase) + (voff)[_i]), (PG8_LAS unsigned*)(lds + (bufoff) + ldsw + _i * 8192), 16, 0, 0); } while (0)
#define PG8_LDA(dst, b, h) do { _Pragma("unroll") for (int m = 0; m < 4; ++m) _Pragma("unroll") for (int k = 0; k < 2; ++k) dst[m][k] = *(const PG8_LAS bf16x8*)(lds + PG8_SA(b, h) + aoff + m * 2048 + k * 1024); } while (0)
#define PG8_LDB(dst, b, h) do { _Pragma("unroll") for (int n = 0; n < 2; ++n) _Pragma("unroll") for (int k = 0; k < 2; ++k) dst[n][k] = *(const PG8_LAS bf16x8*)(lds + PG8_SB(b, h) + boff + n * 2048 + k * 1024); } while (0)
#define PG8_MMA(ai, bj, At, Bt) do { __builtin_amdgcn_s_setprio(1); PLACE_MMA; _Pragma("unroll") for (int m = 0; m < 4; ++m) _Pragma("unroll") for (int n = 0; n < 2; ++n) _Pragma("unroll") for (int k = 0; k < 2; ++k) \
        acc[ai][bj][m][n] = __builtin_amdgcn_mfma_f32_16x16x32_bf16(Bt[n][k], At[m][k], acc[ai][bj][m][n], 0, 0, 0); __builtin_amdgcn_s_setprio(0); } while (0)
#define PG8_WAIT_V(n) asm volatile("s_waitcnt vmcnt(" #n ")" ::: "memory")
#define PG8_WAIT_L(n) asm volatile("s_waitcnt lgkmcnt(" #n ")" ::: "memory")
#if PLACE_B
#define PG8_BAR do { asm volatile(".p2align 3\n\ts_nop 0"); __builtin_amdgcn_s_barrier(); } while (0)
#else
#define PG8_BAR __builtin_amdgcn_s_barrier()
#endif
#define PG8_SCHED __builtin_amdgcn_sched_barrier(0)
#ifdef PROBE_G
#define PT_NOW(t) asm volatile("s_memrealtime %0\n\ts_waitcnt lgkmcnt(0)" : "=s"(t) :: "memory")
    unsigned long long pt_start, pt0, pt1, pt_e = 0, pt_k0 = 0, pt_k4 = 0, pt_end; PT_NOW(pt_start);
#endif
    Unit cur, nxt; int ui = 0;
    if (!S.next(0, cur)) return;
    f32x4 acc[2][2][4][2];
#pragma unroll
    for (int a = 0; a < 2; ++a)
#pragma unroll
        for (int b = 0; b < 2; ++b)
#pragma unroll
            for (int m = 0; m < 4; ++m)
#pragma unroll
                for (int n = 0; n < 2; ++n) acc[a][b][m][n] = (f32x4){0.f, 0.f, 0.f, 0.f};
    bf16x8 At[4][2], B0[2][2], B1[2][2];
    const char* cA = (const char*)g.A + (size_t)cur.pm * tstep; const char* cB = (const char*)g.Bt + (size_t)cur.pn * tstep;
    S.a_ready(cur);
    if constexpr (SP2) {
        PG8_STAGE(PG8_SB(0, 0), cB, voffB); PG8_STAGE(PG8_SB(0, 1), cB + hstep, voffB); PG8_STAGE(PG8_SA(0, 0), cA, voffA); PG8_STAGE(PG8_SA(0, 1), cA + hstep, voffA);
        if (wr == 1) PG8_BAR;
        PG8_WAIT_V(2); PG8_BAR;
        PG8_STAGE(PG8_SB(1, 0), cB + kstep, voffB); PG8_STAGE(PG8_SA(1, 0), cA + kstep, voffA); PG8_STAGE(PG8_SB(1, 1), cB + hstep + kstep, voffB);
        PG8_WAIT_V(6); PG8_BAR;
    } else {
        PG8_STAGE(PG8_SB(0, 0), cB, voffB); PG8_STAGE(PG8_SA(0, 0), cA, voffA); PG8_STAGE(PG8_SB(0, 1), cB + hstep, voffB); PG8_STAGE(PG8_SA(0, 1), cA + hstep, voffA);
        if (wr == 1) PG8_BAR;
        PG8_WAIT_V(4); PG8_BAR;
        PG8_STAGE(PG8_SB(1, 0), cB + kstep, voffB); PG8_STAGE(PG8_SA(1, 0), cA + kstep, voffA); PG8_STAGE(PG8_SB(1, 1), cB + hstep + kstep, voffB);
        PG8_WAIT_V(6); PG8_BAR;
    }
    for (;;) {
        const bool has_next = S.next(ui + 1, nxt);
        const char* nA = has_next ? (const char*)g.A + (size_t)nxt.pm * tstep : cA; const char* nB = has_next ? (const char*)g.Bt + (size_t)nxt.pn * tstep : cB;
        for (int t = 0; t < nt; t += 2) {
            PLACE_ASM(PLACE_G);
            const bool last = (t == nt - 2);
#ifdef PROBE_G
            PT_NOW(pt0);
#endif
            const char* a1 = cA + (size_t)(t + 1) * kstep;
            const char* a2 = last ? nA : cA + (size_t)(t + 2) * kstep; const char* b2 = last ? nB : cB + (size_t)(t + 2) * kstep;
            const char* a3 = a2 + kstep; const char* b3 = b2 + kstep;
            if (last && has_next) S.a_ready(nxt);
            if constexpr (SP2) {
            PG8_LDB(B0, 0, 0); PG8_LDB(B1, 0, 1); PG8_SCHED; PG8_LDA(At, 0, 0); PG8_STAGE(PG8_SA(1, 1), a1 + hstep, voffA);
            PG8_WAIT_V(8); PG8_WAIT_L(0); PG8_BAR; PG8_MMA(0, 0, At, B0); PG8_MMA(0, 1, At, B1); PG8_BAR; PG8_SCHED;
            PG8_LDA(At, 0, 1); PG8_STAGE(PG8_SB(0, 0), b2, voffB); PG8_STAGE(PG8_SB(0, 1), b2 + hstep, voffB); PG8_STAGE(PG8_SA(0, 0), a2, voffA);
            PG8_WAIT_V(8); PG8_WAIT_L(0); PG8_BAR; PG8_MMA(1, 0, At, B0); PG8_MMA(1, 1, At, B1); PG8_BAR; PG8_SCHED;
            PG8_LDB(B0, 1, 0); PG8_LDB(B1, 1, 1); PG8_SCHED; PG8_LDA(At, 1, 0); PG8_STAGE(PG8_SA(0, 1), a2 + hstep, voffA);
            PG8_WAIT_V(8); PG8_WAIT_L(0); PG8_BAR; PG8_MMA(0, 0, At, B0); PG8_MMA(0, 1, At, B1); PG8_BAR; PG8_SCHED;
            PG8_LDA(At, 1, 1); PG8_STAGE(PG8_SB(1, 0), b3, voffB); PG8_STAGE(PG8_SB(1, 1), b3 + hstep, voffB); PG8_STAGE(PG8_SA(1, 0), a3, voffA);
            PG8_WAIT_V(8); PG8_WAIT_L(0); PG8_BAR; PG8_MMA(1, 0, At, B0); PG8_MMA(1, 1, At, B1); PG8_BAR; PG8_SCHED;
            } else {
            PG8_LDB(B0, 0, 0); PG8_SCHED; PG8_LDA(At, 0, 0); PG8_STAGE(PG8_SA(1, 1), a1 + hstep, voffA);
            PG8_WAIT_L(8); PG8_BAR; PG8_WAIT_L(0); PG8_MMA(0, 0, At, B0); PG8_BAR; PG8_SCHED;
            PG8_LDB(B1, 0, 1); PG8_STAGE(PG8_SB(0, 0), b2, voffB);
            PG8_BAR; PG8_WAIT_L(0); PG8_MMA(0, 1, At, B1); PG8_BAR;
            PG8_LDA(At, 0, 1); PG8_STAGE(PG8_SA(0, 0), a2, voffA);
            PG8_BAR; PG8_WAIT_L(0); PG8_MMA(1, 0, At, B0); PG8_BAR; PG8_SCHED;
            PG8_STAGE(PG8_SB(0, 1), b2 + hstep, voffB);
            PG8_WAIT_V(6); PG8_BAR; PG8_MMA(1, 1, At, B1); PG8_BAR;
            PG8_LDB(B0, 1, 0); PG8_SCHED; PG8_LDA(At, 1, 0); PG8_STAGE(PG8_SA(0, 1), a2 + hstep, voffA);
            PG8_WAIT_L(8); PG8_BAR; PG8_WAIT_L(0); PG8_MMA(0, 0, At, B0); PG8_BAR; PG8_SCHED;
            PG8_LDB(B1, 1, 1); PG8_STAGE(PG8_SB(1, 0), b3, voffB);
            PG8_BAR; PG8_WAIT_L(0); PG8_MMA(0, 1, At, B1); PG8_BAR;
            PG8_LDA(At, 1, 1); PG8_STAGE(PG8_SA(1, 0), a3, voffA);
            PG8_BAR; PG8_WAIT_L(0); PG8_MMA(1, 0, At, B0); PG8_BAR; PG8_SCHED;
            PG8_STAGE(PG8_SB(1, 1), b3 + hstep, voffB);
            PG8_WAIT_V(6); PG8_BAR; PG8_MMA(1, 1, At, B1); PG8_BAR;
            }
#ifdef PROBE_G
            PT_NOW(pt1); if (t == 0 && ui > 0) pt_k0 += pt1 - pt0; if (t == 4) pt_k4 += pt1 - pt0;
#endif
        }
#ifdef PROBE_G
        PT_NOW(pt0);
#endif
        if constexpr (ALIGN_EPI) { if (wr == 0) PG8_BAR; }
        if constexpr (!Epi::AFTER_DRAIN) { E(acc, cur, wr, wc, fr, fq); S.done(cur); }
#ifdef PROBE_G
        PT_NOW(pt1); pt_e += pt1 - pt0;
#endif
        if (!has_next) break;
#pragma unroll
        for (int a = 0; a < 2; ++a)
#pragma unroll
            for (int b = 0; b < 2; ++b)
#pragma unroll
                for (int m = 0; m < 4; ++m)
#pragma unroll
                    for (int n = 0; n < 2; ++n) acc[a][b][m][n] = (f32x4){0.f, 0.f, 0.f, 0.f};
        cur = nxt; cA = nA; cB = nB; ++ui;
        if constexpr (ALIGN_EPI) { if (wr == 1) PG8_BAR; }
    }
    PG8_WAIT_V(0);
    if constexpr (!ALIGN_EPI) { if (wr == 0) PG8_BAR; }
    PG8_BAR;
    if constexpr (Epi::AFTER_DRAIN) { E.fused(acc, cur, wr, wc, fr, fq, lds, wid, lane); S.done(cur); }
#ifdef PROBE_G
    PT_NOW(pt_end);
    if (blockIdx.x == PROBE_BLK && tid == PROBE_TID) { const unsigned ph = *(volatile PG8_LAS unsigned*)(lds + 131072 + 64); float* q = g_pr + ph * 8;
        q[0] = (float)(pt_end - pt_start) * 0.01f; q[1] = (float)pt_e * 0.01f; q[2] = (float)pt_k0 * 0.01f; q[3] = (float)pt_k4 * 0.01f; q[4] = (float)(ui + 1); }
#undef PT_NOW
#endif
#undef PG8_SA
#undef PG8_SB
#undef PG8_STAGE
#undef PG8_LDA
#undef PG8_LDB
#undef PG8_MMA
#undef PG8_WAIT_V
#undef PG8_WAIT_L
#undef PG8_BAR
#undef PG8_SCHED
}
}
#define LAS __attribute__((address_space(3)))
typedef unsigned short bf16;
typedef unsigned v4u __attribute__((ext_vector_type(4)));
typedef unsigned v2u __attribute__((ext_vector_type(2)));
typedef float f32x4 __attribute__((ext_vector_type(4)));
typedef short bf16x8 __attribute__((ext_vector_type(8)));

constexpr int NWAVES = 8, NTHREADS = 512;
constexpr int BATCH = 8, SEQ = 4096, DM = 1024, MROWS = BATCH * SEQ;
constexpr int AB_IN = 3072, FFH = 2816, NSA_IN = 2608, NSA_INP = 2816;
constexpr float EPSF = 1e-6f, NEGF = -1e30f, BIGF = 1e30f, LOG2E = 1.4426950408889634f;

constexpr size_t MiB = 1u << 20;
constexpr size_t WS_CTL = 0;
constexpr size_t WS_TAB = 1 * MiB;
constexpr size_t TAB_RCOS = WS_TAB, TAB_RSIN = TAB_RCOS + 4096 * 32 * 4, TAB_NCOS = TAB_RSIN + 4096 * 32 * 4, TAB_NSIN = TAB_NCOS + 4096 * 8 * 4, TAB_CB = TAB_NSIN + 4096 * 8 * 4;
constexpr size_t WS_W = 4 * MiB;
constexpr size_t W_ABIN = WS_W, W_ABOUT = W_ABIN + 6 * MiB, W_NSAIN = W_ABOUT + 2 * MiB, W_NSAOUT = W_NSAIN + 6 * MiB, W_F13 = W_NSAOUT + 2 * MiB  , W_F2 = W_F13 + 22 * MiB  ,
                 W_CK1 = W_F2 + 11 * MiB  , W_CV1 = W_CK1 + 256 * 1024, W_CK2 = W_CV1 + 256 * 1024  , W_CV2 = W_CK2 + 8192, W_GATE = W_CV2 + 8192  , W_END = W_GATE + 131072;
static_assert(W_END <= 64 * MiB, "weights");
constexpr size_t WS_XN = 64 * MiB;
constexpr size_t WS_CAT = 128 * MiB;
constexpr size_t WS_BIG = 192 * MiB;
constexpr size_t WS_PROJ0 = WS_BIG, WS_ACT = WS_BIG;
constexpr size_t WS_Q = WS_BIG, WS_KV6 = WS_BIG + 64 * MiB, WS_GATES = WS_KV6 + 96 * MiB, WS_KC = WS_GATES + 6 * MiB, WS_VCT = WS_KC + 1 * MiB, WS_VTS = WS_VCT + 1 * MiB, WS_VTW = WS_VTS + 16 * MiB;
constexpr size_t WS_KVT = 384 * MiB;
constexpr size_t WS_LSUM = 416 * MiB;
constexpr size_t WS_SS = 418 * MiB;
constexpr size_t WS_END = 428 * MiB;
static_assert(WS_VTW + 16 * MiB <= WS_KVT + 32 * MiB && WS_LSUM + 2 * MiB <= WS_SS && WS_PROJ0 + (size_t)MROWS * AB_IN * 2 <= WS_KVT, "ws map");

__device__ __forceinline__ float bf2f(bf16 v) { return __uint_as_float((unsigned)v << 16); }
__device__ __forceinline__ unsigned f2bf(float f) { unsigned u = __float_as_uint(f); return (u + 0x7fffu + ((u >> 16) & 1u)) >> 16; }
__device__ __forceinline__ unsigned pk2(float lo, float hi) { return f2bf(lo) | (f2bf(hi) << 16); }

__device__ __forceinline__ float gelu_tanh(float x) { const float u = 0.7978845608028654f * (x + 0.044715f * x * x * x); const float e = __expf(2.f * u); const float th = 1.f - 2.f / (e + 1.f); return 0.5f * x * (1.f + th); }
__device__ __forceinline__ float sigm(float x) { return 1.f / (1.f + __expf(-x)); }
__device__ __forceinline__ f32x4 mfma16(bf16x8 a, bf16x8 b, f32x4 c) { return __builtin_amdgcn_mfma_f32_16x16x32_bf16(a, b, c, 0, 0, 0); }
#define DPPF(x_, ctrl_) __int_as_float(__builtin_amdgcn_update_dpp(0, __float_as_int(x_), (ctrl_), 0xF, 0xF, true))
__device__ __forceinline__ float qsum4(float v) { v += DPPF(v, 0xB1); v += DPPF(v, 0x4E); return v; }
__device__ __forceinline__ float gsum16(float v) { v += DPPF(v, 0x128); v += DPPF(v, 0x124); v += DPPF(v, 0x122); v += DPPF(v, 0x121); return v; }
__device__ __forceinline__ float rows4_sum(float v) {
    auto a = __builtin_amdgcn_permlane16_swap(__float_as_uint(v), __float_as_uint(v), false, false); v = __uint_as_float(a[0]) + __uint_as_float(a[1]);
    auto c = __builtin_amdgcn_permlane32_swap(__float_as_uint(v), __float_as_uint(v), false, false); return __uint_as_float(c[0]) + __uint_as_float(c[1]); }
__device__ __forceinline__ float wave_sum(float v) { return rows4_sum(gsum16(v)); }

struct Args { const float* in[24]; float* out; unsigned char* ws; int ph_lo, ph_hi; };
enum { I_X = 0, I_ATTN_NORM, I_AB_W_IN, I_CONV_W, I_CONV_B, I_GA_W, I_GA_B, I_GX_W, I_GX_B, I_LAM, I_AB_W_OUT, I_NSA_W_IN, I_PE_K, I_K_W1, I_K_W2, I_PE_V, I_V_W1, I_V_W2, I_NSA_W_OUT,
       I_FFN_NORM, I_FFN_W1, I_FFN_W3, I_FFN_W2, I_FINAL_NORM };

struct P0Desc { const float* colp; const float* gain; bf16* wt; int ld, K, k0, d0; };
__device__ __forceinline__ void p0_decode(const Args& A, unsigned char* ws, int it, int lane, P0Desc& D) {
    constexpr int I_ABIN = 16 * (AB_IN / 32), I_SQ = 16 * 32, I_NSAIN = 16 * (NSA_INP / 32), I_F13 = 16 * (FFH / 32), I_F2 = (FFH / 64) * 32, I_C1 = 32 * 2, I_C2 = 2;
    int r = it, mapk = 0, Ndst = 1024, half = 0; const float* W; D.gain = nullptr; D.K = 1024;
    if (r < I_ABIN) { W = A.in[I_AB_W_IN]; D.ld = AB_IN; Ndst = AB_IN; D.wt = (bf16*)(ws + W_ABIN); D.gain = A.in[I_ATTN_NORM]; mapk = 1; }
    else if ((r -= I_ABIN) < I_SQ) { W = A.in[I_AB_W_OUT]; D.ld = 1024; D.wt = (bf16*)(ws + W_ABOUT); }
    else if ((r -= I_SQ) < I_NSAIN) { W = A.in[I_NSA_W_IN]; D.ld = NSA_IN; Ndst = NSA_INP; D.wt = (bf16*)(ws + W_NSAIN); D.gain = A.in[I_ATTN_NORM] + DM; mapk = 2; }
    else if ((r -= I_NSAIN) < I_SQ) { W = A.in[I_NSA_W_OUT]; D.ld = 1024; D.wt = (bf16*)(ws + W_NSAOUT); }
    else if ((r -= I_SQ) < 4 * I_F13) { const int q = r / I_F13; r -= q * I_F13; const int L = q & 1; half = q >> 1;
        W = A.in[half ? I_FFN_W3 : I_FFN_W1] + (size_t)L * 1024 * FFH; D.ld = FFH; Ndst = FFH; D.wt = (bf16*)(ws + W_F13) + (size_t)L * 2 * FFH * 1024; D.gain = A.in[I_FFN_NORM] + L * DM; mapk = 3; }
    else if ((r -= 4 * I_F13) < 2 * I_F2) { const int L = r / I_F2; r -= L * I_F2; W = A.in[I_FFN_W2] + (size_t)L * FFH * 1024; D.ld = 1024; D.K = FFH; D.wt = (bf16*)(ws + W_F2) + (size_t)L * 1024 * FFH; }
    else if ((r -= 2 * I_F2) < 2 * I_C1) { const int v = r / I_C1; r -= v * I_C1; W = A.in[v ? I_V_W1 : I_K_W1]; D.ld = 64; Ndst = 64; D.K = 2048; D.wt = (bf16*)(ws + (v ? W_CV1 : W_CK1)); }
    else { r -= 2 * I_C1; const int v = r / I_C2; r -= v * I_C2; W = A.in[v ? I_V_W2 : I_K_W2]; D.ld = 64; Ndst = 64; D.K = 64; D.wt = (bf16*)(ws + (v ? W_CV2 : W_CK2)); }
    const int nblk = Ndst / 32, kb = r / nblk, nb = r % nblk, n0 = 32 * nb, c = n0 + (lane & 31); D.k0 = 64 * kb; D.d0 = n0; int sc = c;
    if (mapk == 1) { if (c >= 1024 && c < 2048) { const int hc = c & 63, gi = hc >> 3, e = hc & 7; sc = (c - hc) + (e < 4 ? 4 * gi + e : 32 + 4 * gi + (e - 4)); } }
    else if (mapk == 2) { if (c >= NSA_IN) sc = -1; else if (c < 1024 || (c >= 1536 && c < 1792) || (c >= 2048 && c < 2304)) { const int hc = c & 63; if (hc < 16) { const int gi = hc >> 3, e = hc & 7; sc = (c - hc) + (e < 4 ? 4 * gi + e : 8 + 4 * gi + (e - 4)); } } }
    else if (mapk == 3) D.d0 = 256 * (n0 >> 7) + (n0 & 127) + 128 * half;
    D.colp = (sc < 0) ? nullptr : W + sc;
}
__device__ __forceinline__ void p0_load(const P0Desc& D, float (&tv)[32], int lane) {
#pragma unroll
    for (int i = 0; i < 32; ++i) { const int kk = 2 * i + (lane >> 5); tv[i] = D.colp ? D.colp[(size_t)(D.k0 + kk) * D.ld] : 0.f; }
}
__device__ __forceinline__ void p0_store(const P0Desc& D, const float (&tv)[32], LAS float* scr, int lane) {
    if (D.gain) {
#pragma unroll
        for (int i = 0; i < 32; ++i) { const int kk = 2 * i + (lane >> 5); scr[kk * 33 + (lane & 31)] = tv[i] * D.gain[D.k0 + kk]; }
    } else {
#pragma unroll
        for (int i = 0; i < 32; ++i) { const int kk = 2 * i + (lane >> 5); scr[kk * 33 + (lane & 31)] = tv[i]; } }
    asm volatile("s_waitcnt lgkmcnt(0)" ::: "memory");
    const int c = lane & 7;
#pragma unroll
    for (int j = 0; j < 4; ++j) { const int n = (lane >> 3) + 8 * j; const LAS float* s = scr + (8 * c) * 33 + n;
        v4u o; o.x = pk2(s[0 * 33], s[1 * 33]); o.y = pk2(s[2 * 33], s[3 * 33]); o.z = pk2(s[4 * 33], s[5 * 33]); o.w = pk2(s[6 * 33], s[7 * 33]);
        *(v4u*)(D.wt + (size_t)(D.d0 + n) * D.K + D.k0 + 8 * c) = o; }
    asm volatile("s_waitcnt lgkmcnt(0)" ::: "memory");
}

__device__ __forceinline__ void final_norm_phase_b(const bf16* hb, float* out, const float* gain, int gw, int NGW, int lane) {
    for (int m = gw; m < MROWS; m += 8 * NGW) {
        pg8::u32x4 v[8][2]; float ss[8];
#pragma unroll
        for (int u = 0; u < 8; ++u) { const pg8::u32x4* xr = (const pg8::u32x4*)(hb + (size_t)(m + u * NGW) * DM) + lane;
#pragma unroll
            for (int j = 0; j < 2; ++j) v[u][j] = xr[64 * j]; }
#pragma unroll
        for (int u = 0; u < 8; ++u) { float s = 0.f;
#pragma unroll
            for (int j = 0; j < 2; ++j)
#pragma unroll
                for (int e = 0; e < 4; ++e) { const float a = __uint_as_float(v[u][j][e] << 16), b = __uint_as_float(v[u][j][e] & 0xffff0000u); s += a * a + b * b; }
            ss[u] = 1.f / sqrtf(wave_sum(s) * (1.f / DM) + EPSF); }
        f32x4 g[2][2];
#pragma unroll
        for (int j = 0; j < 2; ++j) { g[j][0] = ((const f32x4*)gain)[(lane + 64 * j) * 2]; g[j][1] = ((const f32x4*)gain)[(lane + 64 * j) * 2 + 1]; }
#pragma unroll
        for (int u = 0; u < 8; ++u) { f32x4* o = (f32x4*)(out + (size_t)(m + u * NGW) * DM); const float rs = ss[u];
#pragma unroll
            for (int j = 0; j < 2; ++j) { const pg8::u32x4 w = v[u][j];
                const f32x4 a0 = {__uint_as_float(w.x << 16), __uint_as_float(w.x & 0xffff0000u), __uint_as_float(w.y << 16), __uint_as_float(w.y & 0xffff0000u)};
                const f32x4 a1 = {__uint_as_float(w.z << 16), __uint_as_float(w.z & 0xffff0000u), __uint_as_float(w.w << 16), __uint_as_float(w.w & 0xffff0000u)};
                o[(lane + 64 * j) * 2] = a0 * rs * g[j][0]; o[(lane + 64 * j) * 2 + 1] = a1 * rs * g[j][1]; } }
    }
}
__device__ __forceinline__ void final_norm_phase(float* h, const float* gain, int gw, int NGW, int lane) {
    for (int m = gw; m < MROWS; m += 8 * NGW) {
        f32x4 v[8][4]; float ss[8];
#pragma unroll
        for (int u = 0; u < 8; ++u) { const f32x4* xr = (const f32x4*)(h + (size_t)(m + u * NGW) * DM) + lane;
#pragma unroll
            for (int j = 0; j < 4; ++j) v[u][j] = xr[64 * j]; }
#pragma unroll
        for (int u = 0; u < 8; ++u) { float s = 0.f;
#pragma unroll
            for (int j = 0; j < 4; ++j) s += (v[u][j].x * v[u][j].x + v[u][j].y * v[u][j].y) + (v[u][j].z * v[u][j].z + v[u][j].w * v[u][j].w);
            ss[u] = 1.f / sqrtf(wave_sum(s) * (1.f / DM) + EPSF); }
        const f32x4* gr = (const f32x4*)gain + lane; f32x4 g[4];
#pragma unroll
        for (int j = 0; j < 4; ++j) g[j] = gr[64 * j];
#pragma unroll
        for (int u = 0; u < 8; ++u) { f32x4* o = (f32x4*)(h + (size_t)(m + u * NGW) * DM) + lane; const float rs = ss[u];
#pragma unroll
            for (int j = 0; j < 4; ++j) o[64 * j] = v[u][j] * rs * g[j]; }
    }
}

__device__ __forceinline__ void cast_stats_phase(const float* src, bf16* dst, float* SS, int gw, int NGW, int lane) {
    for (int m = gw; m < MROWS; m += 8 * NGW) {
        f32x4 v[8][4];
#pragma unroll
        for (int u = 0; u < 8; ++u) { const f32x4* xr = (const f32x4*)(src + (size_t)(m + u * NGW) * DM) + lane;
#pragma unroll
            for (int j = 0; j < 4; ++j) v[u][j] = xr[64 * j]; }
#pragma unroll
        for (int u = 0; u < 8; ++u) { float s = 0.f; unsigned long long* o8 = (unsigned long long*)(dst + (size_t)(m + u * NGW) * DM) + lane;
#pragma unroll
            for (int j = 0; j < 4; ++j) { s += (v[u][j].x * v[u][j].x + v[u][j].y * v[u][j].y) + (v[u][j].z * v[u][j].z + v[u][j].w * v[u][j].w);
                o8[64 * j] = (unsigned long long)pk2(v[u][j].x, v[u][j].y) | ((unsigned long long)pk2(v[u][j].z, v[u][j].w) << 32); }
            s = wave_sum(s); if (lane < 16) SS[(size_t)(m + u * NGW) * 16 + lane] = (lane == 0) ? s : 0.f; }
    }
}
__device__ __forceinline__ void p0_prologue(const Args& A, LAS unsigned char* lds, int wave, int lane) {
    unsigned char* ws = A.ws;
    LAS float* scr = (LAS float*)(lds + wave * 16384);
    const int gw = blockIdx.x * NWAVES + wave, NGW = gridDim.x * NWAVES;
    {   constexpr int I_ABIN = 16 * (AB_IN / 32), I_SQ = 16 * 32, I_NSAIN = 16 * (NSA_INP / 32), I_F13 = 16 * (FFH / 32), I_F2 = (FFH / 64) * 32, I_C1 = 32 * 2, I_C2 = 2;
        constexpr int NITEMS = I_ABIN + I_SQ + I_NSAIN + I_SQ + 4 * I_F13 + 2 * I_F2 + 2 * I_C1 + 2 * I_C2;
        P0Desc D0, D1; float ta[32], tb[32]; int it = gw;
        if (it < NITEMS) { p0_decode(A, ws, it, lane, D0); p0_load(D0, ta, lane); }
        while (it < NITEMS) {
            const int it1 = it + NGW; const bool has1 = it1 < NITEMS;
            if (has1) { p0_decode(A, ws, it1, lane, D1); p0_load(D1, tb, lane); }
            p0_store(D0, ta, scr, lane);
            if (!has1) break;
            const int it2 = it1 + NGW; const bool has2 = it2 < NITEMS;
            if (has2) { p0_decode(A, ws, it2, lane, D0); p0_load(D0, ta, lane); }
            p0_store(D1, tb, scr, lane);
            if (!has2) break;
            it = it2; } }
    {   const int gt = blockIdx.x * NTHREADS + threadIdx.x, NT = gridDim.x * NTHREADS;
        float* rc = (float*)(ws + TAB_RCOS); float* rsn = (float*)(ws + TAB_RSIN); float* nc = (float*)(ws + TAB_NCOS); float* ns = (float*)(ws + TAB_NSIN);
        for (int e = gt; e < 4096 * 40; e += NT) {
            const int pos = e / 40, i = e % 40; double inv;
            if (i < 32) inv = exp(-9.210340371976184 * ((double)i / 32.0));
            else inv = exp(-13.122363377404328 * ((double)(i - 32) / 8.0));
            double tr = (double)pos * inv * 0.15915494309189535; tr -= floor(tr);
            const float ft = (float)tr; const float sv = __builtin_amdgcn_sinf(ft), cv = __builtin_amdgcn_cosf(ft);
            if (i < 32) { rc[pos * 32 + i] = cv; rsn[pos * 32 + i] = sv; } else { nc[pos * 8 + (i - 32)] = cv; ns[pos * 8 + (i - 32)] = sv; }
        }
    }
    {   const int gt = blockIdx.x * NTHREADS + threadIdx.x, NT = gridDim.x * NTHREADS; bf16* GW = (bf16*)(ws + W_GATE);
        for (int e = gt; e < 2 * 8 * 4096; e += NT) { const int gate = e >> 15, r = e & 32767, n = r >> 12, jj = (r >> 6) & 63, ii = r & 63;
            GW[e] = (bf16)f2bf(A.in[gate ? I_GX_W : I_GA_W][n * 4096 + ii * 64 + jj]); } }
    for (int it = gw; it < 64; it += NGW) { const int which = it >> 5, ch = it & 31; const float* pe = A.in[which ? I_PE_V : I_PE_K] + ch * 64; const float* w1 = A.in[which ? I_V_W1 : I_K_W1] + (size_t)ch * 64 * 64 + lane;
        float s = 0.f;
#pragma unroll 16
        for (int k = 0; k < 64; ++k) s += pe[k] * w1[k * 64];
        ((float*)(ws + TAB_CB))[128 + it * 64 + lane] = s; }
    cast_stats_phase(A.in[I_X], (bf16*)(ws + WS_XN), (float*)(ws + WS_SS), gw, NGW, lane);
}

__device__ __forceinline__ float fsigm(float x) { return __builtin_amdgcn_rcpf(1.f + __builtin_amdgcn_exp2f(-LOG2E * x)); }
__device__ __forceinline__ void lru_chain_item(const Args& A, LAS unsigned char* lds, int item) {
    LAS float* RAW = (LAS float*)lds; LAS bf16* XB = (LAS bf16*)(lds + 33536); LAS float* G = (LAS float*)(lds + 33536 + 18432);
    LAS float* PH = G + 16384; LAS float* CAR = PH + 2048;
    const int tid = threadIdx.x, lane = tid & 63, j = tid & 63, tg = tid >> 6, w = tg, lr = lane & 15, lq = lane >> 4;
    const int chain = item & 63, b = chain >> 3, n = chain & 7, seg = item >> 6, c = n * 64 + j;
    const bf16* P0 = (const bf16*)(A.ws + WS_PROJ0); bf16* CAT = (bf16*)(A.ws + WS_CAT);
    unsigned long long* GR = (unsigned long long*)(A.ws + WS_CTL + 65536) + (size_t)(chain * 16) * 64;
    __syncthreads();
    const float gab = A.in[I_GA_B][c], gxb = A.in[I_GX_B][c], lam = A.in[I_LAM][c];
    const float sp8 = 8.f * LOG2E * log1pf(expf(-lam));
    const float cw0 = A.in[I_CONV_W][c], cw1 = A.in[I_CONV_W][512 + c], cw2 = A.in[I_CONV_W][1024 + c], cw3 = A.in[I_CONV_W][1536 + c], cb = A.in[I_CONV_B][c];
    bf16x8 bfr[4][2];
#pragma unroll
    for (int nt = 0; nt < 4; ++nt)
#pragma unroll
        for (int ks = 0; ks < 2; ++ks) bfr[nt][ks] = *(const bf16x8*)((const bf16*)(A.ws + W_GATE) + (size_t)(((w & 1) * 8 + n) * 64 + 16 * nt + lr) * 64 + 32 * ks + 8 * lq);
    const bf16* xrb = P0 + (size_t)(b * SEQ) * AB_IN + 512 + c;
    bf16 rawn[17];
#pragma unroll
    for (int i = 0; i < 17; ++i) { const int r = tg + 8 * i, t = seg * 256 - 3 + r; rawn[i] = (r < 131 && t >= 0) ? xrb[(size_t)t * AB_IN] : (bf16)0; }
    float av[2][16], uv[2][16]; unsigned yv[2][8];
#pragma unroll
    for (int sub = 0; sub < 2; ++sub) {
        const int t0 = seg * 256 + sub * 128;
#pragma unroll
        for (int i = 0; i < 17; ++i) { const int r = tg + 8 * i; if (r < 131) RAW[r * 64 + j] = bf2f(rawn[i]); }
        if (sub < 1) {
#pragma unroll
            for (int i = 0; i < 17; ++i) { const int r = tg + 8 * i, t = t0 + 128 - 3 + r; rawn[i] = (r < 131) ? xrb[(size_t)t * AB_IN] : (bf16)0; } }
#pragma unroll
        for (int q = 0; q < 8; ++q) { const bf16* yp = P0 + ((size_t)b * SEQ + t0 + tg * 16 + 2 * q) * AB_IN + c; yv[sub][q] = (unsigned)yp[0] | ((unsigned)yp[AB_IN] << 16); }
        __syncthreads();
        float xv[16];
#pragma unroll
        for (int q = 0; q < 16; ++q) { const int tt = tg * 16 + q; const float x = cb + cw0 * RAW[tt * 64 + j] + cw1 * RAW[(tt + 1) * 64 + j] + cw2 * RAW[(tt + 2) * 64 + j] + cw3 * RAW[(tt + 3) * 64 + j]; xv[q] = x; XB[tt * 72 + j] = (bf16)f2bf(x); }
        __syncthreads();
#pragma unroll
        for (int h = 0; h < 2; ++h) {
            const int mt = (w >> 1) + 4 * h; bf16x8 af[2];
#pragma unroll
            for (int ks = 0; ks < 2; ++ks) af[ks] = *(const LAS bf16x8*)(XB + (16 * mt + lr) * 72 + 32 * ks + 8 * lq);
            LAS float* Gw = G + (w & 1) * 8192 + (16 * mt + 4 * lq) * 64 + lr;
#pragma unroll
            for (int nt = 0; nt < 4; ++nt) { f32x4 acc = mfma16(af[0], bfr[nt][0], (f32x4){0.f, 0.f, 0.f, 0.f}); acc = mfma16(af[1], bfr[nt][1], acc);
#pragma unroll
                for (int r = 0; r < 4; ++r) Gw[r * 64 + 16 * nt] = acc[r]; } }
        __syncthreads();
        float Pl = 1.f, Hl = 0.f;
#pragma unroll
        for (int q = 0; q < 16; ++q) { const int tt = tg * 16 + q; const float r = fsigm(G[tt * 64 + j] + gab), ig = fsigm(G[8192 + tt * 64 + j] + gxb);
            const float a = __builtin_amdgcn_exp2f(-sp8 * r); const float mult = __builtin_amdgcn_sqrtf(fmaf(-a, a, 1.f));
            av[sub][q] = a; uv[sub][q] = mult * (ig * xv[q]); Hl = a * Hl + uv[sub][q]; Pl *= a; }
        PH[((sub * 8 + tg) * 64 + j) * 2] = Pl; PH[((sub * 8 + tg) * 64 + j) * 2 + 1] = Hl;
    }
    __syncthreads();
    if (tg == 7) {
        float P = 1.f, H = 0.f;
#pragma unroll
        for (int g2 = 0; g2 < 16; ++g2) { const float pg = PH[(g2 * 64 + j) * 2], hg = PH[(g2 * 64 + j) * 2 + 1]; H = pg * H + hg; P *= pg; }
        const int i4 = seg & 3, r4 = seg - i4;
        unsigned long long* GE = (unsigned long long*)(A.ws + WS_CTL + 65536 + 524288) + (size_t)(chain * 4) * 64;
        if (i4 < 3) __hip_atomic_store(GR + seg * 64 + j, ((unsigned long long)__float_as_uint(H) << 32) | (unsigned long long)__float_as_uint(P), __ATOMIC_RELAXED, __HIP_MEMORY_SCOPE_AGENT);
        unsigned long long xe = 0ull, xs[3] = {0ull, 0ull, 0ull};
        if (seg > 0) for (unsigned spins = 0; ; ) {
            bool ok0 = true;
            if (lane == 0) { if (r4 > 0) ok0 = ((unsigned)(__hip_atomic_load(GE + ((r4 >> 2) - 1) * 64, __ATOMIC_RELAXED, __HIP_MEMORY_SCOPE_AGENT) >> 32) != 0xffffffffu);
                if (i4 > 0) ok0 = ok0 && ((unsigned)__hip_atomic_load(GR + (seg - 1) * 64, __ATOMIC_RELAXED, __HIP_MEMORY_SCOPE_AGENT) != 0xffffffffu); }
            if (__all(ok0)) { bool ok = true;
                if (r4 > 0) { xe = __hip_atomic_load(GE + ((r4 >> 2) - 1) * 64 + j, __ATOMIC_RELAXED, __HIP_MEMORY_SCOPE_AGENT); ok = ok && ((unsigned)(xe >> 32) != 0xffffffffu); }
#pragma unroll
                for (int k = 0; k < 3; ++k) if (k < i4) { xs[k] = __hip_atomic_load(GR + (r4 + k) * 64 + j, __ATOMIC_RELAXED, __HIP_MEMORY_SCOPE_AGENT); ok = ok && ((unsigned)xs[k] != 0xffffffffu); }
                if (__all(ok)) break; }
            __builtin_amdgcn_s_sleep(2);
            if (++spins > (1u << 18)) break; }
        float hin = (r4 > 0) ? __uint_as_float((unsigned)xe) : 0.f;
#pragma unroll
        for (int k = 0; k < 3; ++k) if (k < i4) hin = __uint_as_float((unsigned)xs[k]) * hin + __uint_as_float((unsigned)(xs[k] >> 32));
        if (i4 == 3 && seg < 15) __hip_atomic_store(GE + (seg >> 2) * 64 + j, (unsigned long long)__float_as_uint(P * hin + H), __ATOMIC_RELAXED, __HIP_MEMORY_SCOPE_AGENT);
        CAR[j] = hin; }
    __syncthreads();
    float cin = CAR[j];
#pragma unroll
    for (int sub = 0; sub < 2; ++sub) {
        const int t0 = seg * 256 + sub * 128;
        {   float pp[7], hh[7];
#pragma unroll
            for (int g2 = 0; g2 < 7; ++g2) { pp[g2] = PH[((sub * 8 + g2) * 64 + j) * 2]; hh[g2] = PH[((sub * 8 + g2) * 64 + j) * 2 + 1]; }
#pragma unroll
            for (int g2 = 0; g2 < 7; ++g2) if (g2 < tg) cin = pp[g2] * cin + hh[g2]; }
#pragma unroll
        for (int q = 0; q < 16; ++q) { cin = av[sub][q] * cin + uv[sub][q];
            const size_t row = (size_t)b * SEQ + t0 + tg * 16 + q; const float y = __uint_as_float((q & 1) ? (yv[sub][q >> 1] & 0xffff0000u) : (yv[sub][q >> 1] << 16)); const float u = 0.7978845608028654f * (y + 0.044715f * y * y * y);
            CAT[row * DM + c] = (bf16)f2bf(cin * y * fsigm(2.f * u)); }
        if (sub == 0) {
            float pp[8], hh[8];
#pragma unroll
            for (int g2 = 1; g2 < 8; ++g2) { pp[g2] = PH[((g2) * 64 + j) * 2]; hh[g2] = PH[((g2) * 64 + j) * 2 + 1]; }
#pragma unroll
            for (int g2 = 1; g2 < 8; ++g2) if (g2 > tg) cin = pp[g2] * cin + hh[g2]; }
    }
}
__device__ __forceinline__ void lru_item(const Args& A, LAS unsigned char* lds, int item, int mode) {
    LAS float* RAW = (LAS float*)lds; LAS bf16* XB = (LAS bf16*)(lds + 33536); LAS float* G = (LAS float*)(lds + 33536 + 18432);
    LAS float* PH = G + 16384; LAS float* CAR = PH + 1024;
    const int tid = threadIdx.x, lane = tid & 63, j = tid & 63, tg = tid >> 6, w = tg, lr = lane & 15, lq = lane >> 4;
    const int b = item >> 7, n = (item >> 4) & 7, seg = item & 15, c = n * 64 + j;
    const bf16* P0 = (const bf16*)(A.ws + WS_PROJ0); bf16* CAT = (bf16*)(A.ws + WS_CAT); float* LS = (float*)(A.ws + WS_LSUM);
    __syncthreads();
    const float gab = A.in[I_GA_B][c], gxb = A.in[I_GX_B][c], lam = A.in[I_LAM][c];
    const float sp8 = 8.f * LOG2E * log1pf(expf(-lam));
    const float cw0 = A.in[I_CONV_W][c], cw1 = A.in[I_CONV_W][512 + c], cw2 = A.in[I_CONV_W][1024 + c], cw3 = A.in[I_CONV_W][1536 + c], cb = A.in[I_CONV_B][c];
    float carry = 0.f, ptot = 1.f;
    if (mode == 1) { float pp[15], hh[15];
#pragma unroll
        for (int s2 = 0; s2 < 15; ++s2) { pp[s2] = 1.f; hh[s2] = 0.f; if (s2 < seg) { const float* q = LS + ((size_t)(b * 16 + s2) * 512 + c) * 2; pp[s2] = q[0]; hh[s2] = q[1]; } }
#pragma unroll
        for (int s2 = 0; s2 < 15; ++s2) carry = pp[s2] * carry + hh[s2]; }
    if (tg == 0) CAR[j] = carry;
    __syncthreads();
    bf16x8 bfr[4][2];
#pragma unroll
    for (int nt = 0; nt < 4; ++nt)
#pragma unroll
        for (int ks = 0; ks < 2; ++ks) bfr[nt][ks] = *(const bf16x8*)((const bf16*)(A.ws + W_GATE) + (size_t)(((w & 1) * 8 + n) * 64 + 16 * nt + lr) * 64 + 32 * ks + 8 * lq);
    const bf16* xrb = P0 + (size_t)(b * SEQ) * AB_IN + 512 + c;
    bf16 rawn[17];
#pragma unroll
    for (int i = 0; i < 17; ++i) { const int r = tg + 8 * i, t = seg * 256 - 3 + r; rawn[i] = (r < 131 && t >= 0) ? xrb[(size_t)t * AB_IN] : (bf16)0; }
    for (int sub = 0; sub < 2; ++sub) {
        const int t0 = seg * 256 + sub * 128;
        bf16 yv[16];
        if (mode == 1) {
#pragma unroll
            for (int q = 0; q < 16; ++q) yv[q] = P0[((size_t)b * SEQ + t0 + tg * 16 + q) * AB_IN + c]; }
#pragma unroll
        for (int i = 0; i < 17; ++i) { const int r = tg + 8 * i; if (r < 131) RAW[r * 64 + j] = bf2f(rawn[i]); }
        if (sub < 1) {
#pragma unroll
            for (int i = 0; i < 17; ++i) { const int r = tg + 8 * i, t = t0 + 128 - 3 + r; rawn[i] = (r < 131) ? xrb[(size_t)t * AB_IN] : (bf16)0; } }
        __syncthreads();
        float xv[16];
#pragma unroll
        for (int q = 0; q < 16; ++q) { const int tt = tg * 16 + q; const float x = cb + cw0 * RAW[tt * 64 + j] + cw1 * RAW[(tt + 1) * 64 + j] + cw2 * RAW[(tt + 2) * 64 + j] + cw3 * RAW[(tt + 3) * 64 + j]; xv[q] = x; XB[tt * 72 + j] = (bf16)f2bf(x); }
        __syncthreads();
#pragma unroll
        for (int h = 0; h < 2; ++h) {
            const int mt = (w >> 1) + 4 * h; bf16x8 af[2];
#pragma unroll
            for (int ks = 0; ks < 2; ++ks) af[ks] = *(const LAS bf16x8*)(XB + (16 * mt + lr) * 72 + 32 * ks + 8 * lq);
            LAS float* Gw = G + (w & 1) * 8192 + (16 * mt + 4 * lq) * 64 + lr;
#pragma unroll
            for (int nt = 0; nt < 4; ++nt) { f32x4 acc = mfma16(af[0], bfr[nt][0], (f32x4){0.f, 0.f, 0.f, 0.f}); acc = mfma16(af[1], bfr[nt][1], acc);
#pragma unroll
                for (int r = 0; r < 4; ++r) Gw[r * 64 + 16 * nt] = acc[r]; } }
        __syncthreads();
        float av[16], uv[16]; float Pl = 1.f, Hl = 0.f;
#pragma unroll
        for (int q = 0; q < 16; ++q) { const int tt = tg * 16 + q; const float r = fsigm(G[tt * 64 + j] + gab), ig = fsigm(G[8192 + tt * 64 + j] + gxb);
            const float a = __builtin_amdgcn_exp2f(-sp8 * r); const float mult = __builtin_amdgcn_sqrtf(fmaf(-a, a, 1.f));
            av[q] = a; uv[q] = mult * (ig * xv[q]); Hl = a * Hl + uv[q]; Pl *= a; }
        PH[(tg * 64 + j) * 2] = Pl; PH[(tg * 64 + j) * 2 + 1] = Hl;
        __syncthreads();
        float cin = CAR[j];
        {   float pp[7], hh[7];
#pragma unroll
            for (int g2 = 0; g2 < 7; ++g2) { pp[g2] = PH[(g2 * 64 + j) * 2]; hh[g2] = PH[(g2 * 64 + j) * 2 + 1]; }
#pragma unroll
            for (int g2 = 0; g2 < 7; ++g2) if (g2 < tg) cin = pp[g2] * cin + hh[g2]; }
#pragma unroll
        for (int q = 0; q < 16; ++q) { cin = av[q] * cin + uv[q];
            if (mode == 1) { const size_t row = (size_t)b * SEQ + t0 + tg * 16 + q; const float y = bf2f(yv[q]); const float u = 0.7978845608028654f * (y + 0.044715f * y * y * y);
                CAT[row * DM + c] = (bf16)f2bf(cin * y * fsigm(2.f * u)); } }
        __syncthreads();
        if (tg == 7) { CAR[j] = cin; if (mode == 0) { float pt = 1.f;
#pragma unroll
                for (int g2 = 0; g2 < 8; ++g2) pt *= PH[(g2 * 64 + j) * 2]; ptot *= pt; } }
    }
    if (mode == 0 && tg == 7) { float* q = LS + ((size_t)(b * 16 + seg) * 512 + c) * 2; q[0] = ptot; q[1] = CAR[j]; }
}

__device__ __forceinline__ float ret_log_g(int h) { return log1pf(-exp2f(-5.f - (float)h)); }
__device__ __forceinline__ void ret_kv_load(const bf16* P0, int item, int tid, v4u (&kraw)[2], v4u (&vraw)[2]) {
    const int b = item >> 8, h = (item >> 5) & 7, m = item & 31; const size_t row0 = (size_t)b * SEQ + m * 128;
#pragma unroll
    for (int rep = 0; rep < 2; ++rep) { const bf16* rp = P0 + (row0 + (tid >> 3) + 64 * rep) * AB_IN + h * 64 + 8 * (tid & 7); kraw[rep] = *(const v4u*)(rp + 1536); vraw[rep] = *(const v4u*)(rp + 2048); }
}
__device__ __forceinline__ void ret_kv_run(const Args& A, LAS unsigned char* lds, int first, int stride, int end) {
    LAS bf16* VT = (LAS bf16*)lds; LAS bf16* KT = VT + 64 * 136;
    const int tid = threadIdx.x, lane = tid & 63, w = tid >> 6, lr = lane & 15, lq = lane >> 4;
    const bf16* P0 = (const bf16*)(A.ws + WS_PROJ0); float* KVT = (float*)(A.ws + WS_KVT);
    v4u kraw[2], vraw[2];
    if (first < end) ret_kv_load(P0, first, tid, kraw, vraw);
    for (int item = first; item < end; item += stride) {
        const int b = item >> 8, h = (item >> 5) & 7, m = item & 31; const float l2g = ret_log_g(h) * LOG2E;
        __syncthreads();
#pragma unroll
        for (int rep = 0; rep < 2; ++rep) { const int jj = (tid >> 3) + 64 * rep, e8 = tid & 7; const float dec = __builtin_amdgcn_exp2f((float)(127 - jj) * l2g);
            const unsigned kw[4] = {kraw[rep].x, kraw[rep].y, kraw[rep].z, kraw[rep].w}, vw[4] = {vraw[rep].x, vraw[rep].y, vraw[rep].z, vraw[rep].w};
#pragma unroll
            for (int i = 0; i < 4; ++i) { VT[(8 * e8 + 2 * i) * 136 + jj] = (bf16)(vw[i] & 0xffffu); VT[(8 * e8 + 2 * i + 1) * 136 + jj] = (bf16)(vw[i] >> 16);
                KT[(8 * e8 + 2 * i) * 136 + jj] = (bf16)f2bf(bf2f((bf16)(kw[i] & 0xffffu)) * dec); KT[(8 * e8 + 2 * i + 1) * 136 + jj] = (bf16)f2bf(bf2f((bf16)(kw[i] >> 16)) * dec); } }
        if (item + stride < end) ret_kv_load(P0, item + stride, tid, kraw, vraw);
        __syncthreads();
        const int et = w >> 1, dt0 = (w & 1) * 2; f32x4 acc[2] = {(f32x4){0.f, 0.f, 0.f, 0.f}, (f32x4){0.f, 0.f, 0.f, 0.f}};
#pragma unroll
        for (int ks = 0; ks < 4; ++ks) { const bf16x8 af = *(const LAS bf16x8*)(VT + (16 * et + lr) * 136 + 32 * ks + 8 * lq);
#pragma unroll
            for (int dd = 0; dd < 2; ++dd) { const bf16x8 bfr = *(const LAS bf16x8*)(KT + (16 * (dt0 + dd) + lr) * 136 + 32 * ks + 8 * lq); acc[dd] = mfma16(af, bfr, acc[dd]); } }
        float* o = KVT + ((size_t)((b * 8 + h) * 32 + m)) * 4096;
#pragma unroll
        for (int dd = 0; dd < 2; ++dd)
#pragma unroll
            for (int r = 0; r < 4; ++r) o[(16 * et + 4 * lq + r) * 64 + 16 * (dt0 + dd) + lr] = acc[dd][r];
    }
}
constexpr int VT_LD = 136, ST_LD = 72, PW_LD = 72;
struct RetPre { v4u vraw[2]; f32x4 ka, kc; };
__device__ __forceinline__ void ret_out_pre(const Args& A, int item, bool first, RetPre& R) {
    const int tid = threadIdx.x, b = item >> 8, h = (item >> 5) & 7, n = item & 31; const bf16* P0 = (const bf16*)(A.ws + WS_PROJ0); const float* KVT = (const float*)(A.ws + WS_KVT); const size_t row0 = (size_t)b * SEQ + n * 128;
#pragma unroll
    for (int rep = 0; rep < 2; ++rep) R.vraw[rep] = *(const v4u*)(P0 + (row0 + (tid >> 3) + 64 * rep) * AB_IN + 2048 + h * 64 + 8 * (tid & 7));
    const float* kp = KVT + ((size_t)((b * 8 + h) * 32)) * 4096 + tid * 8; R.ka = (f32x4){0.f, 0.f, 0.f, 0.f}; R.kc = R.ka;
    if (!first) { R.ka = *(const f32x4*)(kp + (size_t)(n - 1) * 4096); R.kc = *(const f32x4*)(kp + (size_t)(n - 1) * 4096 + 4); }
}
__device__ __forceinline__ void ret_out_item(const Args& A, LAS unsigned char* lds, int item, bool first, RetPre& R, int next_item, bool next_first) {
    LAS bf16* VT = (LAS bf16*)lds;
    LAS bf16* STT = VT + 64 * VT_LD;
    LAS bf16* PWall = STT + 64 * ST_LD;
    const int tid = threadIdx.x, lane = tid & 63, w = tid >> 6, lr = lane & 15, lq = lane >> 4, b = item >> 8, h = (item >> 5) & 7, n = item & 31;
    const bf16* P0 = (const bf16*)(A.ws + WS_PROJ0); const float* KVT = (const float*)(A.ws + WS_KVT); bf16* CAT = (bf16*)(A.ws + WS_CAT);
    const float lg = ret_log_g(h), l2g = lg * LOG2E;
    const size_t row0 = (size_t)b * SEQ + n * 128;
    const v4u vraw[2] = {R.vraw[0], R.vraw[1]}; const f32x4 ka = R.ka, kc = R.kc;
    const float* kp = KVT + ((size_t)((b * 8 + h) * 32)) * 4096 + tid * 8;
    bf16x8 qa[2], kf[2][4][2];
#pragma unroll
    for (int ks = 0; ks < 2; ++ks) qa[ks] = *(const bf16x8*)(P0 + (row0 + 16 * w + lr) * AB_IN + 1024 + h * 64 + 32 * ks + 8 * lq);
    const int ntile = (w >= 4) ? 2 : 1;
#pragma unroll
    for (int jt = 0; jt < 2; ++jt) if (jt < ntile) {
#pragma unroll
        for (int nt = 0; nt < 4; ++nt) { const bf16* kq = P0 + (row0 + 64 * jt + 16 * nt + lr) * AB_IN + 1536 + h * 64 + 8 * lq; kf[jt][nt][0] = *(const bf16x8*)kq; kf[jt][nt][1] = *(const bf16x8*)(kq + 32); } }
    bf16 gv[4][4];
#pragma unroll
    for (int r = 0; r < 4; ++r)
#pragma unroll
        for (int ct = 0; ct < 4; ++ct) gv[r][ct] = P0[(row0 + 16 * w + lq * 4 + r) * AB_IN + 2560 + h * 64 + 16 * ct + lr];
    __syncthreads();
#pragma unroll
    for (int rep = 0; rep < 2; ++rep) { const int jj = (tid >> 3) + 64 * rep, e8 = tid & 7; const unsigned wv[4] = {vraw[rep].x, vraw[rep].y, vraw[rep].z, vraw[rep].w};
#pragma unroll
        for (int i = 0; i < 4; ++i) { VT[(8 * e8 + 2 * i) * VT_LD + jj] = (bf16)(wv[i] & 0xffffu); VT[(8 * e8 + 2 * i + 1) * VT_LD + jj] = (bf16)(wv[i] >> 16); } }
    {   LAS float* SF = (LAS float*)(PWall + 8 * 16 * PW_LD);
        float st[8]; const float cd = expf(128.f * lg);
        if (first) {
#pragma unroll
            for (int i = 0; i < 8; ++i) st[i] = 0.f;
            int m = 0;
            for (; m + 4 <= n; m += 4) { f32x4 a[4], c[4];
#pragma unroll
                for (int u = 0; u < 4; ++u) { a[u] = *(const f32x4*)(kp + (size_t)(m + u) * 4096); c[u] = *(const f32x4*)(kp + (size_t)(m + u) * 4096 + 4); }
#pragma unroll
                for (int u = 0; u < 4; ++u) { st[0] = st[0] * cd + a[u].x; st[1] = st[1] * cd + a[u].y; st[2] = st[2] * cd + a[u].z; st[3] = st[3] * cd + a[u].w; st[4] = st[4] * cd + c[u].x; st[5] = st[5] * cd + c[u].y; st[6] = st[6] * cd + c[u].z; st[7] = st[7] * cd + c[u].w; } }
            for (; m < n; ++m) { const f32x4 a = *(const f32x4*)(kp + (size_t)m * 4096), c = *(const f32x4*)(kp + (size_t)m * 4096 + 4);
                st[0] = st[0] * cd + a.x; st[1] = st[1] * cd + a.y; st[2] = st[2] * cd + a.z; st[3] = st[3] * cd + a.w; st[4] = st[4] * cd + c.x; st[5] = st[5] * cd + c.y; st[6] = st[6] * cd + c.z; st[7] = st[7] * cd + c.w; }
        } else {
            const f32x4 p0 = *(const LAS f32x4*)(SF + tid * 8), p1 = *(const LAS f32x4*)(SF + tid * 8 + 4);
            st[0] = p0.x * cd + ka.x; st[1] = p0.y * cd + ka.y; st[2] = p0.z * cd + ka.z; st[3] = p0.w * cd + ka.w; st[4] = p1.x * cd + kc.x; st[5] = p1.y * cd + kc.y; st[6] = p1.z * cd + kc.z; st[7] = p1.w * cd + kc.w; }
        *(LAS f32x4*)(SF + tid * 8) = (f32x4){st[0], st[1], st[2], st[3]}; *(LAS f32x4*)(SF + tid * 8 + 4) = (f32x4){st[4], st[5], st[6], st[7]};
        const int e = tid >> 3, d0 = (tid & 7) * 8; v4u o; o.x = pk2(st[0], st[1]); o.y = pk2(st[2], st[3]); o.z = pk2(st[4], st[5]); o.w = pk2(st[6], st[7]);
        *(LAS v4u*)(STT + e * ST_LD + d0) = o; }
    __syncthreads();
    if (next_item >= 0) ret_out_pre(A, next_item, next_first, R);
    LAS bf16* PW = PWall + w * 16 * PW_LD;
    f32x4 O1[4], O2[4];
#pragma unroll
    for (int ct = 0; ct < 4; ++ct) { O1[ct] = (f32x4){0.f, 0.f, 0.f, 0.f}; O2[ct] = (f32x4){0.f, 0.f, 0.f, 0.f}; }
#pragma unroll
    for (int jt = 0; jt < 2; ++jt) if (jt < ntile) {
        f32x4 s[4];
#pragma unroll
        for (int nt = 0; nt < 4; ++nt) { s[nt] = mfma16(qa[0], kf[jt][nt][0], (f32x4){0.f, 0.f, 0.f, 0.f}); s[nt] = mfma16(qa[1], kf[jt][nt][1], s[nt]); }
#pragma unroll
        for (int nt = 0; nt < 4; ++nt)
#pragma unroll
            for (int r = 0; r < 4; ++r) { const int i = 16 * w + lq * 4 + r, jj = 64 * jt + 16 * nt + lr, dd = i - jj;
                const float p = (dd >= 0) ? s[nt][r] * __builtin_amdgcn_exp2f((float)dd * l2g) : 0.f; PW[(lq * 4 + r) * PW_LD + 16 * nt + lr] = (bf16)f2bf(p); }
        bf16x8 pa[2];
#pragma unroll
        for (int ks = 0; ks < 2; ++ks) pa[ks] = *(const LAS bf16x8*)(PW + lr * PW_LD + 32 * ks + 8 * lq);
#pragma unroll
        for (int ct = 0; ct < 4; ++ct)
#pragma unroll
            for (int ks = 0; ks < 2; ++ks) { const bf16x8 vb = *(const LAS bf16x8*)(VT + (16 * ct + lr) * VT_LD + 64 * jt + 32 * ks + 8 * lq); O1[ct] = mfma16(pa[ks], vb, O1[ct]); }
    }
#pragma unroll
    for (int ct = 0; ct < 4; ++ct)
#pragma unroll
        for (int ks = 0; ks < 2; ++ks) { const bf16x8 sb = *(const LAS bf16x8*)(STT + (16 * ct + lr) * ST_LD + 32 * ks + 8 * lq); O2[ct] = mfma16(qa[ks], sb, O2[ct]); }
#pragma unroll
    for (int r = 0; r < 4; ++r) { const int i = 16 * w + lq * 4 + r; const float qd = __builtin_amdgcn_exp2f((float)(i + 1) * l2g);
        float o[4]; float sm = 0.f;
#pragma unroll
        for (int ct = 0; ct < 4; ++ct) { o[ct] = O1[ct][r] + qd * O2[ct][r]; sm += o[ct]; }
        const float mean = gsum16(sm) * (1.f / 64.f); float vs = 0.f;
#pragma unroll
        for (int ct = 0; ct < 4; ++ct) { o[ct] -= mean; vs += o[ct] * o[ct]; }
        const float rstd = __builtin_amdgcn_rsqf(gsum16(vs) * (1.f / 64.f) + EPSF);
        const size_t row = row0 + i;
#pragma unroll
        for (int ct = 0; ct < 4; ++ct) { const int e = 16 * ct + lr; const float g = bf2f(gv[r][ct]); CAT[row * DM + 512 + h * 64 + e] = (bf16)f2bf(o[ct] * rstd * (g * fsigm(g))); } }
}
__device__ __forceinline__ void cmp_bias_to_lds(const Args& A, LAS unsigned char* lds) {
    const float* CB = (const float*)(A.ws + TAB_CB); const int tid = threadIdx.x;
    if (tid < 128) { float s = 0.f;
#pragma unroll
        for (int ch = 0; ch < 32; ++ch) s += CB[128 + ((tid >> 6) * 32 + ch) * 64 + (tid & 63)];
        ((LAS float*)(lds + 40960))[tid] = s; }
    __syncthreads();
}
__device__ __forceinline__ void cmp_item(const Args& A, LAS unsigned char* lds, int item) {
    LAS float* RED = (LAS float*)lds; LAS bf16* HID = (LAS bf16*)(lds + 32768);
    const int tid = threadIdx.x, lane = tid & 63, w = tid >> 6, lr = lane & 15, lq = lane >> 4;
    const int cgrp = item & 3, kv = (item >> 2) & 1, g = (item >> 3) & 3, b = item >> 5;
    const bf16* W1T = (const bf16*)(A.ws + (kv ? W_CV1 : W_CK1)); const bf16* W2T = (const bf16*)(A.ws + (kv ? W_CV2 : W_CK2)); const bf16* KV6 = (const bf16*)(A.ws + WS_KV6);
    bf16* KC = (bf16*)(A.ws + WS_KC); bf16* VCT = (bf16*)(A.ws + WS_VCT); const float* NC = (const float*)(A.ws + TAB_NCOS); const float* NS = (const float*)(A.ws + TAB_NSIN);
    bf16x8 bw[4][2][4];
#pragma unroll
    for (int lt = 0; lt < 4; ++lt)
#pragma unroll
        for (int ks = 0; ks < 2; ++ks)
#pragma unroll
            for (int nt = 0; nt < 4; ++nt) bw[lt][ks][nt] = *(const bf16x8*)(W1T + (size_t)(16 * nt + lr) * 2048 + (4 * w + lt) * 64 + 32 * ks + 8 * lq);
    bf16x8 w2f[2] = {(bf16x8){0, 0, 0, 0, 0, 0, 0, 0}, (bf16x8){0, 0, 0, 0, 0, 0, 0, 0}};
    if (w < 4) {
#pragma unroll
        for (int ks = 0; ks < 2; ++ks) w2f[ks] = *(const bf16x8*)(W2T + (16 * w + lr) * 64 + 32 * ks + 8 * lq); }
    bf16x8 af[4][2];
#define CMP_LOADA(ct_) do { const int c_ = 16 * (ct_) + lr; _Pragma("unroll") for (int lt = 0; lt < 4; ++lt) { int tok = 16 * c_ + 4 * w + lt; tok = tok > SEQ - 1 ? SEQ - 1 : tok; \
        const bf16* arow = KV6 + ((size_t)b * SEQ + tok) * 1536 + kv * 256 + g * 64; _Pragma("unroll") for (int ks = 0; ks < 2; ++ks) af[lt][ks] = *(const bf16x8*)(arow + 32 * ks + 8 * lq); } } while (0)
    CMP_LOADA(4 * cgrp);
    for (int ti = 0; ti < 4; ++ti) { const int ctile = 4 * cgrp + ti;
        f32x4 acc[4];
#pragma unroll
        for (int nt = 0; nt < 4; ++nt) acc[nt] = (f32x4){0.f, 0.f, 0.f, 0.f};
#pragma unroll
        for (int lt = 0; lt < 4; ++lt)
#pragma unroll
            for (int ks = 0; ks < 2; ++ks)
#pragma unroll
                for (int nt = 0; nt < 4; ++nt) acc[nt] = mfma16(af[lt][ks], bw[lt][ks][nt], acc[nt]);
        __syncthreads();
        if (ti < 3) CMP_LOADA(ctile + 1);
#pragma unroll
        for (int nt = 0; nt < 4; ++nt)
#pragma unroll
            for (int r = 0; r < 4; ++r) RED[(w * 16 + lq * 4 + r) * 64 + 16 * nt + lr] = acc[nt][r];
        __syncthreads();
#pragma unroll
        for (int rep = 0; rep < 2; ++rep) { const int e = tid + rep * NTHREADS, row = e >> 6, col = e & 63; float s = ((const LAS float*)(lds + 40960))[kv * 64 + col];
#pragma unroll
            for (int w2 = 0; w2 < 8; ++w2) s += RED[(w2 * 16 + row) * 64 + col];
            HID[row * 72 + col] = (bf16)f2bf(gelu_tanh(s)); }
        __syncthreads();
        if (w < 4) {
            f32x4 o = (f32x4){0.f, 0.f, 0.f, 0.f};
#pragma unroll
            for (int ks = 0; ks < 2; ++ks) { const bf16x8 a = *(const LAS bf16x8*)(HID + lr * 72 + 32 * ks + 8 * lq); o = mfma16(a, w2f[ks], o); }
#pragma unroll
            for (int r = 0; r < 4; ++r) { const int cc = 16 * ctile + lq * 4 + r, dim = 16 * w + lr; float val = o[r];
                if (kv == 0) {
                    if (w == 0) { const float partner = DPPF(val, 0x128);   int pos = 16 * cc + 31; pos = pos > SEQ - 1 ? SEQ - 1 : pos; const int f = lr & 7; const float cs = NC[pos * 8 + f], sn = NS[pos * 8 + f];
                        val = (lr < 8) ? (val * cs - partner * sn) : (val * cs + partner * sn); }
                    KC[((size_t)(b * 256 + cc) * 4 + g) * 64 + dim] = (bf16)f2bf(val);
                } else VCT[((size_t)(b * 4 + g) * 64 + dim) * 256 + cc] = (bf16)f2bf(val); }
        }
    }
#undef CMP_LOADA
}
typedef float f32x2 __attribute__((ext_vector_type(2))); typedef __bf16 bf16x2_t __attribute__((ext_vector_type(2)));
__device__ __forceinline__ unsigned cvtpk(float lo, float hi) { f32x2 v = {lo, hi}; bf16x2_t b = __builtin_convertvector(v, bf16x2_t); return __builtin_bit_cast(unsigned, b); }
__device__ __forceinline__ float vmax3(float a, float b, float c) { float r; asm("v_max3_f32 %0, %1, %2, %3" : "=v"(r) : "v"(a), "v"(b), "v"(c)); return r; }
__device__ __forceinline__ float vmax2(float a, float b) { float r; asm("v_max_f32_e32 %0, %1, %2" : "=v"(r) : "v"(a), "v"(b)); return r; }
__device__ __forceinline__ float colmax4(float v) {
    auto a = __builtin_amdgcn_permlane16_swap(__float_as_uint(v), __float_as_uint(v), false, false); v = vmax2(__uint_as_float(a[0]), __uint_as_float(a[1]));
    auto c = __builtin_amdgcn_permlane32_swap(__float_as_uint(v), __float_as_uint(v), false, false); return vmax2(__uint_as_float(c[0]), __uint_as_float(c[1])); }
__device__ __forceinline__ float colsum4(float v) { return rows4_sum(v); }
struct NsaSt { float mhat[2], l[2], invl[2]; f32x4 O[4][2]; };
template <int MODE>
__device__ __forceinline__ void nsa_softmax(NsaSt& S, f32x4 (&st)[4], const int nq, const int klo, const int khi, const bool colok, const int kb, LAS float* PSrow, const int lr, const int lq, bf16x8& p0, bf16x8& p1) {
    if (MODE <= 2) {
        const unsigned span = (khi >= klo) ? (unsigned)(khi - klo) : 0u; const int base = (khi >= klo) ? kb - klo : -0x40000000;
#pragma unroll
        for (int mt = 0; mt < 4; ++mt)
#pragma unroll
            for (int r = 0; r < 4; ++r) { const bool ok = (unsigned)(base + 32 * (mt >> 1) + 4 * (mt & 1) + r) <= span; st[mt][r] = ok ? st[mt][r] : NEGF; } }
    if (MODE != 1) {
        float a = st[0][0];
        asm volatile("s_nop 15\n\ts_nop 1\n\tv_max3_f32 %0, %0, %1, %2\n\tv_max3_f32 %0, %0, %3, %4\n\tv_max3_f32 %0, %0, %5, %6\n\tv_max3_f32 %0, %0, %7, %8\n\tv_max3_f32 %0, %0, %9, %10\n\tv_max3_f32 %0, %0, %11, %12\n\tv_max3_f32 %0, %0, %13, %14\n\tv_max_f32_e32 %0, %0, %15"
                     : "+v"(a) : "v"(st[0][1]), "v"(st[0][2]), "v"(st[0][3]), "v"(st[1][0]), "v"(st[1][1]), "v"(st[1][2]), "v"(st[1][3]), "v"(st[2][0]), "v"(st[2][1]), "v"(st[2][2]),
                       "v"(st[2][3]), "v"(st[3][0]), "v"(st[3][1]), "v"(st[3][2]), "v"(st[3][3]));
        a = colok ? a : NEGF; const float tmax = colmax4(a);
        if (__any(tmax > 8.f)) { const float dl = (tmax > 8.f) ? tmax : 0.f, f = __builtin_amdgcn_exp2f(-dl); S.mhat[nq] += dl; S.l[nq] *= f;
#pragma unroll
            for (int mt = 0; mt < 4; ++mt) st[mt] -= dl;
            if (MODE >= 2) {
#pragma unroll
                for (int ct = 0; ct < 4; ++ct) S.O[ct][nq] *= f; } }
    }
#pragma unroll
    for (int mt = 0; mt < 4; ++mt)
#pragma unroll
        for (int r = 0; r < 4; ++r) st[mt][r] = __builtin_amdgcn_exp2f(st[mt][r]);
    if (MODE == 1) {
#pragma unroll
        for (int mt = 0; mt < 4; ++mt) st[mt] *= S.invl[nq];
#pragma unroll
        for (int mt = 0; mt < 4; ++mt) { f32x4 hs = st[mt];
#pragma unroll
            for (int r = 0; r < 4; ++r) hs[r] = qsum4(hs[r]);
            if ((lr & 3) == 0) *(LAS f32x4*)(PSrow + (4 * nq + (lr >> 2)) * 256 + 32 * (mt >> 1) + 4 * (mt & 1) + 8 * lq) = hs; }
    } else { f32x2 a2 = (f32x2){st[0][0], st[0][1]} + (f32x2){st[0][2], st[0][3]};
#pragma unroll
        for (int mt = 1; mt < 4; ++mt) { a2 += (f32x2){st[mt][0], st[mt][1]}; a2 += (f32x2){st[mt][2], st[mt][3]}; }
        const float ls = a2.x + a2.y; S.l[nq] += colok ? ls : 0.f; }
    if (MODE >= 1) {
#pragma unroll
        for (int kk = 0; kk < 2; ++kk) { const f32x4 a = st[2 * kk], c = st[2 * kk + 1]; v4u pk; pk.x = cvtpk(a[0], a[1]); pk.y = cvtpk(a[2], a[3]); pk.z = cvtpk(c[0], c[1]); pk.w = cvtpk(c[2], c[3]);
            if (MODE >= 2 && !colok) pk = (v4u){0u, 0u, 0u, 0u};
            if (kk == 0) p0 = __builtin_bit_cast(bf16x8, pk); else p1 = __builtin_bit_cast(bf16x8, pk); } }
}
template <int MODE>
__device__ __forceinline__ bool nsa_softmax_fast(NsaSt& S, f32x4 (&st)[4], const int nq, const int klo, const int khi, const int kb, bf16x8& p0, bf16x8& p1) {
    if (MODE <= 2) {
        const unsigned span = (khi >= klo) ? (unsigned)(khi - klo) : 0u; const int base = (khi >= klo) ? kb - klo : -0x40000000;
#pragma unroll
        for (int mt = 0; mt < 4; ++mt)
#pragma unroll
            for (int r = 0; r < 4; ++r) { const bool ok = (unsigned)(base + 32 * (mt >> 1) + 4 * (mt & 1) + r) <= span; st[mt][r] = ok ? st[mt][r] : NEGF; } }
#pragma unroll
    for (int mt = 0; mt < 4; ++mt)
#pragma unroll
        for (int r = 0; r < 4; ++r) st[mt][r] = __builtin_amdgcn_exp2f(st[mt][r]);
    f32x2 a2 = (f32x2){st[0][0], st[0][1]} + (f32x2){st[0][2], st[0][3]};
#pragma unroll
    for (int mt = 1; mt < 4; ++mt) { a2 += (f32x2){st[mt][0], st[mt][1]}; a2 += (f32x2){st[mt][2], st[mt][3]}; }
    const float ls = a2.x + a2.y;
    if (__any(ls > 1.0995116e12f)) return true;
    S.l[nq] += ls;
    if (MODE >= 1) {
#pragma unroll
        for (int kk = 0; kk < 2; ++kk) { const f32x4 a = st[2 * kk], c = st[2 * kk + 1]; v4u pk; pk.x = cvtpk(a[0], a[1]); pk.y = cvtpk(a[2], a[3]); pk.z = cvtpk(c[0], c[1]); pk.w = cvtpk(c[2], c[3]);
            if (kk == 0) p0 = __builtin_bit_cast(bf16x8, pk); else p1 = __builtin_bit_cast(bf16x8, pk); } }
    return false;
}
template <int MODE>
__device__ __forceinline__ void nsa_full(NsaSt& S, const bf16x8 (&qf)[2][2], const LAS unsigned char* kbuf, const int koff, const int voff, const int klo0, const int klo1, const int khi0, const int khi1, const bool col0, const bool col1,
                                          const int kb, LAS float* PSrow, const int lr, const int lq) {
    bf16x8 kf[4][2];
#pragma unroll
    for (int mt = 0; mt < 4; ++mt) { kf[mt][0] = *(const LAS bf16x8*)(kbuf + 4096 * (mt >> 1) + 512 * (mt & 1) + koff); kf[mt][1] = *(const LAS bf16x8*)(kbuf + 4096 * (mt >> 1) + 512 * (mt & 1) + (koff ^ 64)); }
    f32x4 st0[4], st1[4];
    const float NINF = -__builtin_inff();
    {   const float n0 = col0 ? -S.mhat[0] : NINF, n1 = col1 ? -S.mhat[1] : NINF; const f32x4 negm0 = (f32x4){n0, n0, n0, n0}, negm1 = (f32x4){n1, n1, n1, n1};
#pragma unroll
        for (int mt = 0; mt < 4; ++mt) st0[mt] = mfma16(kf[mt][0], qf[0][0], negm0);
#pragma unroll
        for (int mt = 0; mt < 4; ++mt) st0[mt] = mfma16(kf[mt][1], qf[0][1], st0[mt]);
#pragma unroll
        for (int mt = 0; mt < 4; ++mt) st1[mt] = mfma16(kf[mt][0], qf[1][0], negm1);
#pragma unroll
        for (int mt = 0; mt < 4; ++mt) st1[mt] = mfma16(kf[mt][1], qf[1][1], st1[mt]); }
    __builtin_amdgcn_sched_barrier(0);
    bf16x8 p0, p1; bf16x8 vf[4][2];
#define NSA_SOFTMAX(st_, nq_, klo_, khi_, col_) do { \
        if constexpr (MODE == 1) nsa_softmax<MODE>(S, st_, nq_, klo_, khi_, col_, kb, PSrow, lr, lq, p0, p1); \
        else if (nsa_softmax_fast<MODE>(S, st_, nq_, klo_, khi_, kb, p0, p1)) {        \
            const float nn_ = (col_) ? -S.mhat[nq_] : NINF; const f32x4 ng_ = (f32x4){nn_, nn_, nn_, nn_}; \
            _Pragma("unroll") for (int mt = 0; mt < 4; ++mt) { const bf16x8 k0_ = *(const LAS bf16x8*)(kbuf + 4096 * (mt >> 1) + 512 * (mt & 1) + koff), k1_ = *(const LAS bf16x8*)(kbuf + 4096 * (mt >> 1) + 512 * (mt & 1) + (koff ^ 64)); \
                st_[mt] = mfma16(k0_, qf[nq_][0], ng_); st_[mt] = mfma16(k1_, qf[nq_][1], st_[mt]); } \
            nsa_softmax<MODE>(S, st_, nq_, klo_, khi_, col_, kb, PSrow, lr, lq, p0, p1); } } while (0)
    NSA_SOFTMAX(st0, 0, klo0, khi0, col0);
    if (MODE >= 1) {
        const LAS unsigned char* vbuf = kbuf + 8192;
#pragma unroll
        for (int ct = 0; ct < 4; ++ct)
#pragma unroll
            for (int kk = 0; kk < 2; ++kk) vf[ct][kk] = *(const LAS bf16x8*)(vbuf + 2048 * ct + (voff ^ (64 * kk)));
#pragma unroll
        for (int ct = 0; ct < 4; ++ct) { S.O[ct][0] = mfma16(vf[ct][0], p0, S.O[ct][0]); S.O[ct][0] = mfma16(vf[ct][1], p1, S.O[ct][0]); } }
    __builtin_amdgcn_sched_barrier(0);
    NSA_SOFTMAX(st1, 1, klo1, khi1, col1);
    if (MODE >= 1) {
#pragma unroll
        for (int ct = 0; ct < 4; ++ct) { S.O[ct][1] = mfma16(vf[ct][0], p0, S.O[ct][1]); S.O[ct][1] = mfma16(vf[ct][1], p1, S.O[ct][1]); } }
#undef NSA_SOFTMAX
}
#if defined(PROBE_T) && defined(PSEG)
#define PSEG_MARK(k) do { if ((k) == PSEG || (k) == PSEG + 1) { unsigned d_; asm volatile("s_waitcnt lgkmcnt(0)\n\ts_memrealtime s[90:91]\n\ts_waitcnt lgkmcnt(0)\n\ts_mov_b32 %0, s90" : "=s"(d_) :: "s90", "s91", "memory"); \
        if (threadIdx.x == 0) { volatile LAS unsigned* mw_ = (volatile LAS unsigned*)(lds + 131072); if ((k) == PSEG) mw_[21] = d_; else mw_[20] += d_ - mw_[21]; } } } while (0)
#else
#define PSEG_MARK(k) do { } while (0)
#endif
__device__ __forceinline__ void nsa_item2(const Args& A, LAS unsigned char* lds, int item) {
    const int tid = threadIdx.x, lane = tid & 63, w = tid >> 6, lr = lane & 15, lq = lane >> 4;
    const int qt = item >> 5, b = (item >> 2) & 7, g = item & 3, t0 = qt * 64, cur = qt;
    PSEG_MARK(0);
    const bf16* Qb = (const bf16*)(A.ws + WS_Q); const bf16* KV6 = (const bf16*)(A.ws + WS_KV6); const bf16* KC = (const bf16*)(A.ws + WS_KC); const bf16* VCT = (const bf16*)(A.ws + WS_VCT);
    const bf16* VTS = (const bf16*)(A.ws + WS_VTS); const bf16* VTW = (const bf16*)(A.ws + WS_VTW); const float* GT = (const float*)(A.ws + WS_GATES); bf16* ATT = (bf16*)(A.ws + WS_CAT);
    LAS float* PS = (LAS float*)(lds + 65536) + w * 2048;
    const int head = 4 * g + (lr & 3);
#define NSA_QPOS(nq_) (t0 + 8 * w + 4 * (nq_) + (lr >> 2))
    bf16x8 qf[2][2]; float gtv[2][3];
    const int ncv = ((t0 + 63 - 31) >> 4) + 1, ncmp = (ncv + 63) >> 6;
    const int lo = cur >= 8 ? cur - 8 : 0;
    const bool fuse = (cur < 16);
    const int n1 = fuse ? 0 : ncmp, n2 = fuse ? 1 : 2 * ncmp, n3 = n2 + cur + 1, n4 = n3 + (cur - lo + 1);
    const int srow = 8 * w + (lane >> 3), schv = (lane & 7) ^ ((srow >> 1) & 7), schk = (lane & 7) ^ (((srow & 3) >> 1) | (((srow >> 3) & 3) << 1));
    const bf16* kcb = KC + ((size_t)(b * 256) * 4 + g) * 64; const bf16* vcb = VCT + (size_t)((b * 4 + g) * 64) * 256;
    const bf16* ksb = KV6 + (size_t)b * SEQ * 1536 + 2 * 256 + g * 64; const bf16* kwb = ksb + 2 * 256;
    const bf16* vsb = VTS + (size_t)((b * 4 + g) * 64) * SEQ; const bf16* vwb = VTW + (size_t)((b * 4 + g) * 64) * SEQ;
    const unsigned sk16 = (unsigned)schk * 16u, sv16 = (unsigned)schv * 16u, srw = (unsigned)srow;
    const unsigned lds0 = (unsigned)(unsigned long)lds + (unsigned)w * 1024u;
#define NSA_GATE(nq_, i_) (gtv[nq_][i_])
#define NSA_GLDS(gp_, vo_, la_) do { unsigned keep_; asm volatile("s_mov_b32 %0, m0\n\ts_mov_b32 m0, %3\n\ts_nop 0\n\tglobal_load_lds_dwordx4 %1, %2\n\ts_mov_b32 m0, %0" : "=&s"(keep_) : "v"(vo_), "s"(gp_), "s"(la_) : "memory"); } while (0)
#define NSA_ISSUE(s_, slot_) do { const int s__ = (s_); const bf16* kp_; const bf16* vp_; unsigned ko_, vo_; \
        if (s__ < n2) { const int kt_ = s__ < n1 ? s__ : s__ - n1; kp_ = kcb + (size_t)(64 * kt_) * 256; vp_ = vcb + 64 * kt_; ko_ = srw * 512u + sk16; vo_ = srw * 512u + sv16; } \
        else if (s__ < n3) { const int kt_ = s__ - n2; kp_ = ksb + (size_t)(64 * kt_) * 1536; vp_ = vsb + 64 * kt_; ko_ = srw * 3072u + sk16; vo_ = srw * 8192u + sv16; } \
        else { const int kt_ = lo + s__ - n3; kp_ = kwb + (size_t)(64 * kt_) * 1536; vp_ = vwb + 64 * kt_; ko_ = srw * 3072u + sk16; vo_ = srw * 8192u + sv16; } \
        const unsigned la_ = (unsigned)__builtin_amdgcn_readfirstlane(lds0 + (unsigned)(slot_) * 16384u); NSA_GLDS(kp_, ko_, la_); NSA_GLDS(vp_, vo_, la_ + 8192u); } while (0)
#if defined(PROBE_T) && !defined(PSEG)
#ifndef PWSEL
#define PWSEL 2
#endif
#define PW_T0 "s_waitcnt lgkmcnt(0)\n\ts_memrealtime s[90:91]\n\ts_waitcnt lgkmcnt(0)\n\t"
#define PW_T1 "\n\ts_memrealtime s[92:93]\n\ts_waitcnt lgkmcnt(0)\n\ts_sub_u32 %0, s92, s90"
#define NSA_WAITBAR(N) do { unsigned d_; \
        if (PWSEL == 0) asm volatile(PW_T0 "s_waitcnt vmcnt(" #N ")" PW_T1 "\n\ts_barrier" : "=s"(d_) :: "s90", "s91", "s92", "s93", "memory"); \
        else if (PWSEL == 1) asm volatile("s_waitcnt vmcnt(" #N ")\n\t" PW_T0 "s_barrier" PW_T1 : "=s"(d_) :: "s90", "s91", "s92", "s93", "memory"); \
        else asm volatile(PW_T0 "s_waitcnt vmcnt(" #N ")\n\ts_barrier" PW_T1 : "=s"(d_) :: "s90", "s91", "s92", "s93", "memory"); if (tid == 0) ((volatile LAS unsigned*)(lds + 131072))[20] += d_; } while (0)
#else
#ifndef NSA_LAG
#define NSA_LAG 0
#endif
#define NSA_WAITBAR(N) do { asm volatile("s_waitcnt vmcnt(" #N ") lgkmcnt(0)\n\ts_barrier" ::: "memory"); if (NSA_LAG > 0 && w >= 4) __builtin_amdgcn_s_sleep(NSA_LAG); } while (0)
#endif
    NSA_ISSUE(0, 0); if (n1 >= 2) NSA_ISSUE(1, 1);
#pragma unroll
    for (int nq = 0; nq < 2; ++nq) { const size_t row = (size_t)b * SEQ + NSA_QPOS(nq);
#pragma unroll
        for (int ks = 0; ks < 2; ++ks) qf[nq][ks] = *(const bf16x8*)(Qb + row * 1024 + head * 64 + 32 * ks + 8 * lq);
#pragma unroll
        for (int i = 0; i < 3; ++i) gtv[nq][i] = GT[row * 48 + head * 3 + i]; }
#pragma unroll
    for (int i = 0; i < 8; ++i) *(LAS f32x4*)(PS + (i * 64 + lane) * 4) = (f32x4){0.f, 0.f, 0.f, 0.f};
    NsaSt S;
    LAS f32x4* OUTL = (LAS f32x4*)PS + lane;
#pragma unroll
    for (int nq = 0; nq < 2; ++nq) { S.mhat[nq] = 0.f; S.l[nq] = 0.f; S.invl[nq] = 0.f;
#pragma unroll
        for (int ct = 0; ct < 4; ++ct) S.O[ct][nq] = (f32x4){0.f, 0.f, 0.f, 0.f}; }
    unsigned long long mym[2] = {0ull, 0ull};
#pragma unroll
    for (int nq = 0; nq < 2; ++nq)
#pragma unroll
        for (int ks = 0; ks < 2; ++ks) asm volatile("" : "+v"(qf[nq][ks]));
#pragma unroll
    for (int nq = 0; nq < 2; ++nq)
#pragma unroll
        for (int i = 0; i < 3; ++i) asm volatile("" : "+v"(gtv[nq][i]));
    NSA_WAITBAR(0);
    const int xk = ((lr & 3) >> 1) | ((lr >> 2) << 1), xv = (lr >> 1) & 7;
    const int koff = (8 * (lr >> 2) + (lr & 3)) * 128 + ((lq ^ xk) << 4);
    const int voff = lr * 128 + ((lq ^ xv) << 4);
    const int wi0 = n3 + (cur >= 8 ? 1 : 0);
#define NSA_GSZ(t_) (((t_) >= n4) ? 0 : ((t_) < n1) ? (((t_) + 1 < n1) ? 2 : 1) : ((t_) < n2) ? (((t_) + 1 < n2) ? 2 : 1) : (((t_) < n3 - 1) ? (((t_) + 1 < n3 - 1) ? 2 : 1) : (((t_) >= wi0 && (t_) < n4 - 1) ? (((t_) + 1 < n4 - 1) ? 2 : 1) : 1)))
#define NSA_TILE(MODE_, s_, slot_, kt_, PSrow_) do { const int s__s = (s_), kt__ = (kt_); const LAS unsigned char* kbuf = lds + (slot_) * 16384; const int kb = 64 * kt__ + 8 * lq; \
        int klo0, klo1, khi0, khi1; bool col0 = true, col1 = true; { const int qp0 = NSA_QPOS(0), qp1 = NSA_QPOS(1); \
            if (s__s < n2) { klo0 = 0; klo1 = 0; khi0 = (qp0 >= 31) ? ((qp0 - 31) >> 4) : -1; khi1 = (qp1 >= 31) ? ((qp1 - 31) >> 4) : -1; } \
            else if (s__s < n3) { col0 = (mym[0] >> kt__) & 1ull; col1 = (mym[1] >> kt__) & 1ull; klo0 = 0; klo1 = 0; khi0 = qp0; khi1 = qp1; } \
            else { klo0 = qp0 - 511; klo1 = qp1 - 511; khi0 = qp0; khi1 = qp1; } } \
        nsa_full<MODE_>(S, qf, kbuf, koff, voff, klo0, klo1, khi0, khi1, col0, col1, kb, (PSrow_), lr, lq); } while (0)
#define NSA_NEXT(t_, z_) do { const int nt_ = (t_) + (z_), z2_ = NSA_GSZ(nt_); if (z2_ >= 1) NSA_ISSUE(nt_, 2 * (gp ^ 1)); if (z2_ >= 2) NSA_ISSUE(nt_ + 1, 2 * (gp ^ 1) + 1); } while (0)
#define NSA_STEP(MODE_, s_, kt_, PSrow_) do { PLACE_ASM(PLACE_N); NSA_NEXT((s_), 1); NSA_TILE(MODE_, (s_), 2 * gp, (kt_), (PSrow_)); NSA_WAITBAR(0); gp ^= 1; } while (0)
#define NSA_PAIR(MODE_, s_, kt_) do { PLACE_ASM(PLACE_N); NSA_NEXT((s_), 2); NSA_TILE(MODE_, (s_), 2 * gp, (kt_), PS + 64 * (kt_)); NSA_TILE(MODE_, (s_) + 1, 2 * gp + 1, (kt_) + 1, PS + 64 * ((kt_) + 1)); NSA_WAITBAR(0); gp ^= 1; } while (0)
    int gp = 0;
    PSEG_MARK(1);
    if (fuse) { NSA_STEP(2, 0, 0, PS); }
    else {
    {   int s = 0; for (; s + 1 < n1; s += 2) NSA_PAIR(0, s, s);
        if (s < n1) NSA_STEP(0, s, s, PS); }
#pragma unroll
    for (int nq = 0; nq < 2; ++nq) { const float lf = colsum4(S.l[nq]); S.invl[nq] = lf > 0.f ? 1.f / lf : 0.f; }
    {   int s = n1; for (; s + 1 < n2; s += 2) NSA_PAIR(1, s, s - n1);
        if (s < n2) NSA_STEP(1, s, s - n1, PS + 64 * (s - n1)); }
    }
    PSEG_MARK(2);
    {
        if (cur < 16) { mym[0] = ~0ull; mym[1] = ~0ull; }
        else {
        unsigned uk[8], pref[8];
#pragma unroll
        for (int qi = 0; qi < 8; ++qi) { const int j = lane, qp = t0 + 8 * w + qi; const LAS float* base = PS + qi * 256;
            float imp = base[4 * j] + base[4 * j + 1] + base[4 * j + 2] + 0.5f * base[4 * j + 3]; if (j > 0) imp += 0.5f * base[4 * j - 1];
            const bool forced = (j == 0) || (j == cur) || (j == cur - 1), causal = (64 * j <= qp);
            const float val = forced ? BIGF : (causal ? imp : NEGF);
            const unsigned ub = __float_as_uint(val); uk[qi] = (ub & 0x80000000u) ? ~ub : (ub | 0x80000000u); pref[qi] = 0u; }
#pragma unroll 1
        for (int bit = 31; bit >= 0; --bit) { const unsigned bm = 1u << bit; unsigned long long bal[8];
#pragma unroll
            for (int qi = 0; qi < 8; ++qi) bal[qi] = __ballot(uk[qi] >= (pref[qi] | bm));
#pragma unroll
            for (int qi = 0; qi < 8; ++qi) { unsigned cnt_; const unsigned cand = pref[qi] | bm;
                asm("s_bcnt1_i32_b64 %0, %2\n\ts_cmp_gt_u32 %0, 15\n\ts_cselect_b32 %1, %3, %1" : "=&s"(cnt_), "+s"(pref[qi]) : "s"(bal[qi]), "s"(cand) : "scc"); } }
#pragma unroll
        for (int qi = 0; qi < 8; ++qi) { const int j = lane;
            const unsigned long long gt = __ballot(uk[qi] > pref[qi]), eq = __ballot(uk[qi] == pref[qi]); const int need = 16 - __popcll(gt);
            const unsigned long long below = eq & ((1ull << j) - 1ull);
            const unsigned long long mk = gt | __ballot(uk[qi] == pref[qi] && __popcll(below) < need);
            if (qi == (lr >> 2)) mym[0] = mk; if (qi == 4 + (lr >> 2)) mym[1] = mk; }
        }
#pragma unroll
        for (int nq = 0; nq < 2; ++nq) { const float lf0 = colsum4(S.l[nq]); const float g0 = fuse ? (lf0 > 0.f ? NSA_GATE(nq, 0) / lf0 : 0.f) : NSA_GATE(nq, 0); S.mhat[nq] = 0.f; S.l[nq] = 0.f;
#pragma unroll
            for (int ct = 0; ct < 4; ++ct) { OUTL[(ct * 2 + nq) * 64] = S.O[ct][nq] * g0; S.O[ct][nq] = (f32x4){0.f, 0.f, 0.f, 0.f}; } }
    }
    PSEG_MARK(3);
    {   int s = n2; for (; s + 1 < n3 - 1; s += 2) NSA_PAIR(3, s, s - n2);
        if (s < n3 - 1) NSA_STEP(3, s, s - n2, PS); }
    NSA_STEP(2, n3 - 1, cur, PS);
#pragma unroll
    for (int nq = 0; nq < 2; ++nq) { const float lf = colsum4(S.l[nq]); const float sc = NSA_GATE(nq, 1) / lf; S.mhat[nq] = 0.f; S.l[nq] = 0.f;
#pragma unroll
        for (int ct = 0; ct < 4; ++ct) { OUTL[(ct * 2 + nq) * 64] += S.O[ct][nq] * sc; S.O[ct][nq] = (f32x4){0.f, 0.f, 0.f, 0.f}; } }
    PSEG_MARK(4);
    {   int s = n3; if (cur >= 8) { NSA_STEP(2, s, lo, PS); ++s; }
        for (; s + 1 < n4 - 1; s += 2) NSA_PAIR(3, s, lo + s - n3);
        if (s < n4 - 1) NSA_STEP(3, s, lo + s - n3, PS);
        NSA_STEP(2, n4 - 1, cur, PS); }
#undef NSA_STEP
#undef NSA_PAIR
#undef NSA_NEXT
#undef NSA_TILE
#undef NSA_GSZ
#undef NSA_ISSUE
#undef NSA_GLDS
#undef NSA_WAITBAR
    PSEG_MARK(5);
#pragma unroll
    for (int nq = 0; nq < 2; ++nq) { const float lf = colsum4(S.l[nq]); const float sc = NSA_GATE(nq, 2) / lf; bf16* op = ATT + ((size_t)b * SEQ + NSA_QPOS(nq)) * 1024 + head * 64 + 4 * lq;
#pragma unroll
        for (int ct = 0; ct < 4; ++ct) { const f32x4 o = OUTL[(ct * 2 + nq) * 64] + S.O[ct][nq] * sc; v2u pk; pk.x = pk2(o[0], o[1]); pk.y = pk2(o[2], o[3]); *(v2u*)(op + 16 * ct) = pk; } }
#undef NSA_GATE
#undef NSA_QPOS
    PSEG_MARK(6);
}
#define XB_TMO      128
#define XB_XCNT(j)  (256  + 64 * (j))
#define XB_XSUB(j)  (1280 + 64 * (j))
#define XB_XGEN(j)  (2304 + 64 * (j))
#define XB_TOP      3328
#define XB_TOPGEN   3392
#define XCD_BAR_WORDS 3456
#define XB_SPIN_CAP (1u << 18)

__device__ __forceinline__ unsigned xb_ld(unsigned* p)              { return __hip_atomic_load(p, __ATOMIC_RELAXED, __HIP_MEMORY_SCOPE_AGENT); }
__device__ __forceinline__ unsigned xb_add(unsigned* p, unsigned v) { return __hip_atomic_fetch_add(p, v, __ATOMIC_RELAXED, __HIP_MEMORY_SCOPE_AGENT); }
__device__ __forceinline__ unsigned xb_xcc_id() { return (unsigned)__builtin_amdgcn_s_getreg((3 << 11) | 20) & 0xFu; }
#define XB_SPIN(cond, bar) do { unsigned _sp = 0; while (cond) { __builtin_amdgcn_s_sleep(1); \
    if ((++_sp & 255u) == 0u) { if (xb_ld(&(bar)[XB_TMO])) break; if (_sp > XB_SPIN_CAP) { atomicAdd(&(bar)[XB_TMO], 1u); break; } } } } while (0)

struct XcdBarrier {
    unsigned* bar; unsigned x;
    volatile LAS unsigned* st;
};

__device__ __forceinline__ XcdBarrier xcd_barrier_post(unsigned* bar, volatile LAS unsigned* st) {
    XcdBarrier b; b.bar = bar; b.x = xb_xcc_id(); b.st = st;
    if (threadIdx.x == 0) (void)xb_add(&bar[XB_XCNT(b.x)], 1u);
    return b;
}
__device__ __forceinline__ void xcd_barrier_complete(unsigned* bar, unsigned x, unsigned& nloc, unsigned& nx) {
    const unsigned G = gridDim.x * gridDim.y * gridDim.z;
    unsigned sum, cnt, mine, sp = 0u;
    for (;;) {
        sum = 0u; cnt = 0u; mine = 0u;
#pragma unroll
        for (unsigned j = 0; j < 16; ++j) { const unsigned c = xb_ld(&bar[XB_XCNT(j)]); sum += c; cnt += (c > 0u) ? 1u : 0u; mine = (j == x) ? c : mine; }
        if (sum == G) break;
        __builtin_amdgcn_s_sleep(1);
        if ((++sp & 255u) == 0u) { if (xb_ld(&bar[XB_TMO])) break; if (sp > XB_SPIN_CAP) { atomicAdd(&bar[XB_TMO], 1u); break; } }
    }
    nloc = mine > 0u ? mine : 1u; nx = cnt > 0u ? cnt : 1u;
}

__device__ __forceinline__ void xcd_barrier(const XcdBarrier& b) {
    asm volatile("s_waitcnt vmcnt(0)" ::: "memory");
    __syncthreads();
    if (threadIdx.x == 0) {
        unsigned* bar = b.bar;
        __builtin_amdgcn_s_waitcnt(0);
        unsigned nloc = b.st[0], nx = b.st[1];
        if (nloc == 0u) { xcd_barrier_complete(bar, b.x, nloc, nx); b.st[0] = nloc; b.st[1] = nx; }
        const unsigned old = xb_add(&bar[XB_XSUB(b.x)], 1u);
        const unsigned gen = old / nloc;
        if (old + 1u == (gen + 1u) * nloc) {
            __builtin_amdgcn_fence(__ATOMIC_RELEASE, "agent");
            asm volatile("s_waitcnt vmcnt(0)" ::: "memory");
            const unsigned og = xb_add(&bar[XB_TOP], 1u);
            const unsigned tg = og / nx;
            if (og + 1u == (tg + 1u) * nx) xb_add(&bar[XB_TOPGEN], 1u);
            else XB_SPIN(xb_ld(&bar[XB_TOPGEN]) == tg, bar);
            __builtin_amdgcn_fence(__ATOMIC_ACQUIRE, "agent");
            xb_add(&bar[XB_XGEN(b.x)], 1u);
            asm volatile("s_waitcnt vmcnt(0)" ::: "memory");
        } else {
            XB_SPIN(xb_ld(&bar[XB_XGEN(b.x)]) == gen, bar);
            __builtin_amdgcn_fence(__ATOMIC_ACQUIRE, "agent");
            asm volatile("s_waitcnt vmcnt(0)" ::: "memory");
        }
    }
    __syncthreads();
}
constexpr int LDS_BYTES = 147456;
constexpr int NPHASES = 14;
#ifndef PHMASK
#define PHMASK 0x3fff
#endif
#ifndef PHREP
#define PHREP 0
#endif
#ifndef RES_ALIGN
#define RES_ALIGN true
#endif
#ifndef GEMM_SP2
#define GEMM_SP2 true
#endif
#ifndef MK_SINGLE
#define MK_SINGLE 1
#endif

constexpr int RS_OFF = 131072 + 256;
__device__ __forceinline__ void rs_table(LAS unsigned char* lds, const float* SS, int N) {
    pg8::StaticOrder S; S.init(MROWS, N, (int)gridDim.x, (int)blockIdx.x); LAS float* RS = (LAS float*)(lds + RS_OFF); pg8::Unit u;
    for (int idx = threadIdx.x; ; idx += NTHREADS) { const int ui = idx >> 8; if (ui >= 11 || !S.next(ui, u)) break; RS[idx] = pg8::row_rs_g(SS, u.pm * 256 + (idx & 255)); }
    __syncthreads();
}
template <class Epi, bool ALIGN = true> __device__ __forceinline__ void run_gemm(LAS unsigned char* lds, const bf16* Aop, const bf16* Bt, int N, int K, const Epi& E) {
    pg8::Gemm g{Aop, Bt, MROWS, N, K}; pg8::StaticOrder S; S.init(MROWS, N, (int)gridDim.x, (int)blockIdx.x);
    pg8::gemm_phase<Epi, pg8::StaticOrder, ALIGN, GEMM_SP2>(lds, g, S, E);
}

__global__ void __launch_bounds__(NTHREADS, 2) mk_fwd(Args args) {
    extern __shared__ __attribute__((aligned(16))) unsigned char lds_raw[];
    LAS unsigned char* lds = (LAS unsigned char*)lds_raw;
    cg::grid_group grid = cg::this_grid();
    volatile LAS unsigned* MISC = (volatile LAS unsigned*)(lds + 131072);
    if (threadIdx.x < 32) MISC[threadIdx.x] = 0u;
    __syncthreads();
    XcdBarrier xbar = xcd_barrier_post((unsigned*)(args.ws + WS_CTL) + 4096, MISC + 8);
    const int tid = threadIdx.x, lane = tid & 63, wave = __builtin_amdgcn_readfirstlane(tid >> 6);
    const int gw = blockIdx.x * NWAVES + wave, NGW = gridDim.x * NWAVES;
    unsigned char* ws = args.ws;
    const int lo = args.ph_lo, hi = args.ph_hi;
#ifdef PROBE_T
#define PQ(x, q) (floorf((x) / (q) + 0.5f) * (q))
#define PT_STAMP(arr, k) do { if (blockIdx.x == PROBE_BLK && threadIdx.x == 0) { unsigned long long t_; asm volatile("s_memrealtime %0\n\ts_waitcnt lgkmcnt(0)" : "=s"(t_) :: "memory"); arr[k] = t_; } } while (0)
#define PT_MID(i) do { __syncthreads(); PT_STAMP(g_tm, i); } while (0)
#define PH_BEGIN(k) if (lo <= (k) && (k) < hi) { constexpr int phk_ = (k); if ((k) > lo) { if ((k) == lo + 1) grid.sync(); else xcd_barrier(xbar); } if (threadIdx.x == 0) MISC[16] = (k); PT_STAMP(g_ts, phk_); { __syncthreads(); if constexpr ((PHMASK >> (k)) & 1) {
#define PH_END } __syncthreads(); PT_STAMP(g_te, phk_); if (phk_ == 9 && blockIdx.x == PROBE_BLK && threadIdx.x == 0) g_pr[9 * 8 + 5] = (float)MISC[20] * 0.01f; }}
#else
#define PT_MID(i) do { } while (0)
#define PH_BEGIN(k) if (lo <= (k) && (k) < hi) { if ((k) > lo) { if ((k) == lo + 1) grid.sync(); else xcd_barrier(xbar); } for (int rep_ = 0; rep_ < ((((PHREP) >> (k)) & 1) ? 2 : 1); ++rep_) { __syncthreads(); if constexpr ((PHMASK >> (k)) & 1) {
#define PH_END }}}
#endif
    float* const SS = (float*)(ws + WS_SS); constexpr size_t SSN = (size_t)MROWS * 16;
    bf16* const XN = (bf16*)(ws + WS_XN);
    PH_BEGIN(0) p0_prologue(args, lds, wave, lane); PH_END
    const LAS float* RSL = (const LAS float*)(lds + RS_OFF);
    PH_BEGIN(1) { rs_table(lds, SS, AB_IN); pg8::EpiProj0 E{(bf16*)(ws + WS_PROJ0), (const float*)(ws + TAB_RCOS), (const float*)(ws + TAB_RSIN), RSL};
                  run_gemm(lds, XN, (const bf16*)(ws + W_ABIN), AB_IN, 1024, E); } PH_END
#ifdef PLACE_L
    asm volatile("s_nop 0");
#endif
    PH_BEGIN(2) { ret_kv_run(args, lds, (int)blockIdx.x, (int)gridDim.x, 2048); } PH_END
    PH_BEGIN(3) {
                  for (int it = blockIdx.x; it < 1024; it += gridDim.x) lru_chain_item(args, lds, it);
                  PT_MID(1);
                  const int kb_ = (int)blockIdx.x, run_ = (gridDim.x == 256) ? (((kb_ & 63) << 2) | (3 - (kb_ >> 6))) : kb_;
                  const int per = (2048 + (int)gridDim.x - 1) / (int)gridDim.x, i0 = run_ * per;
                  const int i1 = (i0 + per < 2048) ? i0 + per : 2048;
                  if (i0 < i1) { RetPre R; ret_out_pre(args, i0, true, R);
                      for (int it = i0; it < i1; ++it) { const int nx = (it + 1 < i1) ? it + 1 : -1; ret_out_item(args, lds, it, it == i0 || (it & 31) == 0, R, nx, nx >= 0 && (nx & 31) == 0); } } } PH_END
    PH_BEGIN(4) { pg8::EpiResidB<false> E{XN, nullptr, XN, SS + SSN}; run_gemm<pg8::EpiResidB<false>, RES_ALIGN>(lds, (const bf16*)(ws + WS_CAT), (const bf16*)(ws + W_ABOUT), 1024, 1024, E); } PH_END
    PH_BEGIN(5) { rs_table(lds, SS + SSN, 2 * FFH); pg8::EpiFfnUp E{(bf16*)(ws + WS_ACT), FFH, RSL}; run_gemm(lds, XN, (const bf16*)(ws + W_F13), 2 * FFH, 1024, E); } PH_END
    PH_BEGIN(6) { pg8::EpiResidB<false> E{XN, nullptr, XN, SS + 2 * SSN}; run_gemm<pg8::EpiResidB<false>, RES_ALIGN>(lds, (const bf16*)(ws + WS_ACT), (const bf16*)(ws + W_F2), 1024, FFH, E); } PH_END
    PH_BEGIN(7) { rs_table(lds, SS + 2 * SSN, NSA_INP); pg8::EpiNsaIn E{(bf16*)(ws + WS_Q), (bf16*)(ws + WS_KV6), (float*)(ws + WS_GATES), (bf16*)(ws + WS_VTS), (bf16*)(ws + WS_VTW), (const float*)(ws + TAB_NCOS), (const float*)(ws + TAB_NSIN), RSL};
                  run_gemm(lds, XN, (const bf16*)(ws + W_NSAIN), NSA_INP, 1024, E); } PH_END
    PH_BEGIN(8) { cmp_bias_to_lds(args, lds); for (int it = blockIdx.x; it < 256; it += gridDim.x) cmp_item(args, lds, it); } PH_END
    PH_BEGIN(9) { if (gridDim.x == 256) {
                      const int grp = (int)blockIdx.x >> 5, bg = (int)blockIdx.x & 31;
                      for (int i = 0; i < 8; ++i) { const int qt = (i & 1) ? 8 * i + 7 - grp : 8 * i + grp; nsa_item2(args, lds, qt * 32 + bg); } }
                  else for (int it = blockIdx.x; it < 2048; it += gridDim.x) nsa_item2(args, lds, it); } PH_END
    PH_BEGIN(10) { pg8::EpiResidB<false> E{XN, nullptr, XN, SS + 3 * SSN}; run_gemm<pg8::EpiResidB<false>, RES_ALIGN>(lds, (const bf16*)(ws + WS_CAT), (const bf16*)(ws + W_NSAOUT), 1024, 1024, E); } PH_END
    PH_BEGIN(11) { rs_table(lds, SS + 3 * SSN, 2 * FFH); pg8::EpiFfnUp E{(bf16*)(ws + WS_ACT), FFH, RSL}; run_gemm(lds, XN, (const bf16*)(ws + W_F13) + (size_t)2 * FFH * 1024, 2 * FFH, 1024, E); } PH_END
    PH_BEGIN(12) { pg8::EpiResidB<false> E{XN, nullptr, XN, SS + 4 * SSN}; run_gemm<pg8::EpiResidB<false>, RES_ALIGN>(lds, (const bf16*)(ws + WS_ACT), (const bf16*)(ws + W_F2) + (size_t)1024 * FFH, 1024, FFH, E); } PH_END
    PH_BEGIN(13) final_norm_phase_b(XN, args.out, args.in[I_FINAL_NORM], gw, NGW, lane); PH_END
#ifdef PROBE_T
    xcd_barrier(xbar);
    if (blockIdx.x == PROBE_BLK) { const float pa = (PROBE_A), pb = (PROBE_B); if (tid == 0) args.out[0] += pa; if (tid == 0) args.out[8192] += pb; }
#endif
}

extern "C" void kernel_launch(void* const* d_in, const int* in_sizes, int n_in, void* d_out, int out_size, void* d_ws, size_t ws_size, hipStream_t stream) {
    static int grid = 0;
    if (grid == 0) {
        if (n_in != 24 || out_size != MROWS * DM || ws_size < WS_END) { fprintf(stderr, "kernel_launch: unexpected shapes (n_in %d out %d ws %zu)\n", n_in, out_size, ws_size); grid = -1; return; }
        int dev = 0, cus = 0, per_cu = 0;
        if (hipGetDevice(&dev) != hipSuccess || hipDeviceGetAttribute(&cus, hipDeviceAttributeMultiprocessorCount, dev) != hipSuccess) { grid = -1; return; }
        if (hipFuncSetAttribute((const void*)mk_fwd, hipFuncAttributeMaxDynamicSharedMemorySize, LDS_BYTES) != hipSuccess) { fprintf(stderr, "kernel_launch: hipFuncSetAttribute failed\n"); grid = -1; return; }
        if (hipOccupancyMaxActiveBlocksPerMultiprocessor(&per_cu, (const void*)mk_fwd, NTHREADS, LDS_BYTES) != hipSuccess || per_cu < 1) { fprintf(stderr, "kernel_launch: occupancy query says %d\n", per_cu); per_cu = 1; }
        (void)hipGetLastError();
        grid = cus;
    }
    if (grid < 0) return;
    if (hipMemsetAsync((char*)d_ws + WS_CTL, 0, 65536, stream) != hipSuccess || hipMemsetAsync((char*)d_ws + WS_CTL + 65536, 0xFF, 1024 * 64 * 8 + 256 * 64 * 8, stream) != hipSuccess) { fprintf(stderr, "kernel_launch: memset failed\n"); return; }
    Args a{};
    for (int i = 0; i < 24; ++i) a.in[i] = (const float*)d_in[i];
    a.out = (float*)d_out; a.ws = (unsigned char*)d_ws;
#if MK_SINGLE
    a.ph_lo = 0; a.ph_hi = NPHASES;
    void* kargs[] = {&a};
    hipError_t e = hipLaunchCooperativeKernel((const void*)mk_fwd, dim3(grid), dim3(NTHREADS), kargs, LDS_BYTES, stream);
    if (e != hipSuccess) fprintf(stderr, "kernel_launch: cooperative launch failed: %s (grid %d)\n", hipGetErrorString(e), grid);
#else
    for (int ph = 0; ph < NPHASES; ++ph) { a.ph_lo = ph; a.ph_hi = ph + 1; hipLaunchKernelGGL(mk_fwd, dim3(grid), dim3(NTHREADS), LDS_BYTES, stream, a); }
#endif
}
```
